# Optimizing an MI355X kernel written in HIP

```python
import jax, jax.numpy as jnp
from jax import lax
import numpy as np

D_MODEL = 1024
BATCH = 4
SEQ = 8192
DEPTH = 4
DEC_BATCH = 8
DEC_SEQ = 64
PAST_LEN = 2048

CHUNK = 64
N_MIXERS = 2
N_ATTN = (DEPTH + 1) // 2
N_HGRN = DEPTH // 2
N_HEADS = 16
N_KV = 4
HEAD_DIM = 64
GROUP = N_HEADS // N_KV
ROT_DIM = HEAD_DIM // 4
ROPE_THETA = 500000.0
WINDOW = 128
WIN_CHUNKS = WINDOW // CHUNK
Q_DIM = N_HEADS * HEAD_DIM
KV_DIM = N_KV * HEAD_DIM
HG_EXPAND = 128
HG_HEADS = D_MODEL // HG_EXPAND
HG_DK = HG_EXPAND
HG_DV = D_MODEL // HG_HEADS
HG_F = HG_HEADS * HG_DK
D_FF = 4 * D_MODEL
EPS = 1e-5

kernel_name = "hybrid_swa_sink_hgrn2_stream_step"


def rmsnorm(x, g):
    xf = x.astype(jnp.float32)
    y = xf * lax.rsqrt(jnp.mean(xf * xf, axis=-1, keepdims=True) + EPS)
    return (y * g.astype(jnp.float32)).astype(x.dtype)


def rope_partial(x, pos):
    half = ROT_DIM // 2
    inv_freq = ROPE_THETA ** (-(jnp.arange(half, dtype=jnp.float32) * 2.0) / ROT_DIM)
    ang = pos[:, None] * inv_freq[None, :]
    cos = jnp.cos(ang)[None, :, None, :]
    sin = jnp.sin(ang)[None, :, None, :]
    xf = x.astype(jnp.float32)
    x1, x2, rest = xf[..., :half], xf[..., half:ROT_DIM], xf[..., ROT_DIM:]
    out = jnp.concatenate([x1 * cos - x2 * sin, x2 * cos + x1 * sin, rest], axis=-1)
    return out.astype(x.dtype)


def attn_project(h, w_qkv, pos):
    B, T, _ = h.shape
    qkv = h @ w_qkv
    q, k, v = jnp.split(qkv, [Q_DIM, Q_DIM + KV_DIM], axis=-1)
    q = rope_partial(q.reshape(B, T, N_HEADS, HEAD_DIM), pos)
    k = rope_partial(k.reshape(B, T, N_KV, HEAD_DIM), pos)
    v = v.reshape(B, T, N_KV, HEAD_DIM)
    return q, k, v


def banded_sink_attention(q, k, v, valid, sinks):
    B, N, Q = q.shape[:3]
    qg = q.reshape(B, N, Q, N_KV, GROUP, HEAD_DIM)
    s = jnp.einsum('bnqkgd,bnskd->bnkgqs', qg, k,
                   preferred_element_type=jnp.float32) * (HEAD_DIM ** -0.5)
    s = jnp.where(valid[None, :, None, None, None, :], s, -jnp.inf)
    sink = sinks.astype(jnp.float32).reshape(N_KV, GROUP)[None, None, :, :, None, None]
    m = jnp.maximum(jnp.max(s, axis=-1, keepdims=True), sink)
    e = jnp.exp(s - m)
    p = e / (jnp.sum(e, axis=-1, keepdims=True) + jnp.exp(sink - m))
    o = jnp.einsum('bnkgqs,bnskd->bnqkgd', p.astype(v.dtype), v)
    return o.reshape(B, N, Q, N_HEADS, HEAD_DIM)


def swa_prompt(h, w_qkv, w_o, sinks):
    B, T, _ = h.shape
    pos = jnp.arange(T, dtype=jnp.float32)
    q, k, v = attn_project(h, w_qkv, pos)
    nc = T // CHUNK
    qc = q.reshape(B, nc, CHUNK, N_HEADS, HEAD_DIM)
    pad = ((0, 0), (WIN_CHUNKS, 0), (0, 0), (0, 0), (0, 0))
    kp = jnp.pad(k.reshape(B, nc, CHUNK, N_KV, HEAD_DIM), pad)
    vp = jnp.pad(v.reshape(B, nc, CHUNK, N_KV, HEAD_DIM), pad)
    kb = jnp.concatenate([kp[:, w:w + nc] for w in range(WIN_CHUNKS + 1)], axis=2)
    vb = jnp.concatenate([vp[:, w:w + nc] for w in range(WIN_CHUNKS + 1)], axis=2)
    key_chunk = jnp.repeat(jnp.arange(WIN_CHUNKS + 1), CHUNK)
    valid = (jnp.arange(nc)[:, None] + key_chunk[None, :] - WIN_CHUNKS) >= 0
    o = banded_sink_attention(qc, kb, vb, valid, sinks)
    out = o.reshape(B, T, Q_DIM) @ w_o
    return out, k[:, T - WINDOW:], v[:, T - WINDOW:]


def swa_sample(h, cache_k, cache_v, w_qkv, w_o, sinks):
    B, T, _ = h.shape
    pos = PAST_LEN + jnp.arange(T, dtype=jnp.float32)
    q, k, v = attn_project(h, w_qkv, pos)
    keys = jnp.concatenate([cache_k.astype(k.dtype), k], axis=1)
    vals = jnp.concatenate([cache_v.astype(v.dtype), v], axis=1)
    valid = jnp.ones((1, keys.shape[1]), dtype=bool)
    o = banded_sink_attention(q[:, None], keys[:, None], vals[:, None], valid, sinks)
    out = o.reshape(B, T, Q_DIM) @ w_o
    W = cache_k.shape[1]
    return out, keys[:, T:].astype(cache_k.dtype), vals[:, T:].astype(cache_v.dtype)


def hgrn_scan(q, k, v, logf, s0):
    B, T, H, DK = q.shape
    DV = v.shape[-1]
    L = CHUNK if T % CHUNK == 0 else T
    n = T // L

    def to_blocks(a):
        return a.reshape(B, n, L, H, a.shape[-1]).transpose(1, 0, 3, 2, 4)

    causal = jnp.tril(jnp.ones((L, L), dtype=bool))[:, :, None]

    def step(S, blk):
        qb, kb, vb, gb = blk
        b = jnp.cumsum(gb, axis=2)
        diff = b[:, :, :, None, :] - b[:, :, None, :, :]
        decay = jnp.where(causal, jnp.exp(jnp.where(causal, diff, 0.0)), 0.0)
        scores = jnp.einsum('bhtk,bhsk,bhtsk->bhts', qb, kb, decay)
        o = (jnp.einsum('bhts,bhsv->bhtv', scores, vb)
             + jnp.einsum('bhtk,bhkv->bhtv', qb * jnp.exp(b), S))
        b_last = b[:, :, -1:, :]
        S_new = (jnp.exp(b_last[:, :, 0, :])[..., None] * S
                 + jnp.einsum('bhsk,bhsv->bhkv', kb * jnp.exp(b_last - b), vb))
        return S_new, o

    S_fin, o = lax.scan(step, s0, (to_blocks(q), to_blocks(k), to_blocks(v), to_blocks(logf)))
    o = o.transpose(1, 0, 3, 2, 4).reshape(B, T, H, DV)
    return o, S_fin


def hgrn2_mix(h, s0, w_in, lb, out_norm, w_o):
    B, T, _ = h.shape
    z = h @ w_in
    zq, zf, zi, zg = jnp.split(z, [HG_F, 2 * HG_F, 2 * HG_F + D_MODEL], axis=-1)
    q = jax.nn.silu(zq.astype(jnp.float32)).reshape(B, T, HG_HEADS, HG_DK)
    zf = zf.astype(jnp.float32).reshape(B, T, HG_HEADS, HG_DK)
    lbh = lb.reshape(HG_HEADS, HG_DK)
    logf = jnp.log(lbh + (1.0 - lbh) * jax.nn.sigmoid(zf))
    k = (1.0 - lbh) * jax.nn.sigmoid(-zf)
    v = zi.astype(jnp.float32).reshape(B, T, HG_HEADS, HG_DV)
    o, S = hgrn_scan(q, k, v, logf, s0)
    o = rmsnorm(o, out_norm) * jax.nn.silu(zg.astype(jnp.float32).reshape(B, T, HG_HEADS, HG_DV))
    out = o.reshape(B, T, D_MODEL).astype(h.dtype) @ w_o
    return out, S


def sqrelu_mlp(h, w_up, w_down):
    return jnp.square(jax.nn.relu(h @ w_up)) @ w_down


def setup_inputs(seed: int = 0) -> dict:
    key = jax.random.key(seed)
    ks = jax.random.split(key, 20)
    f32 = jnp.float32

    def nrm(k, shape, scale):
        return jax.random.normal(k, shape, f32) * scale

    cache_rows = min(WINDOW, PAST_LEN)
    return {
        "x_prompt": nrm(ks[0], (BATCH, SEQ, D_MODEL), 1.0),
        "x_sample": nrm(ks[1], (DEC_BATCH, DEC_SEQ, D_MODEL), 1.0),
        "cache_k": nrm(ks[2], (N_ATTN, DEC_BATCH, cache_rows, N_KV, HEAD_DIM), 1.0),
        "cache_v": nrm(ks[3], (N_ATTN, DEC_BATCH, cache_rows, N_KV, HEAD_DIM), 1.0),
        "state_s": nrm(ks[4], (N_HGRN, DEC_BATCH, HG_HEADS, HG_DK, HG_DV), 0.5),
        "mixer_norm": 1.0 + nrm(ks[5], (DEPTH, D_MODEL), 0.01),
        "mlp_norm": 1.0 + nrm(ks[6], (DEPTH, D_MODEL), 0.01),
        "attn_w_qkv": nrm(ks[7], (N_ATTN, D_MODEL, Q_DIM + 2 * KV_DIM), D_MODEL ** -0.5),
        "attn_w_o": nrm(ks[8], (N_ATTN, Q_DIM, D_MODEL), Q_DIM ** -0.5),
        "attn_sinks": nrm(ks[9], (N_ATTN, N_HEADS), 0.5),
        "hgrn_w_in": nrm(ks[10], (N_HGRN, D_MODEL, 2 * HG_F + 2 * D_MODEL), D_MODEL ** -0.5),
        "hgrn_lb": nrm(ks[11], (N_HGRN, HG_F), 1.0),
        "hgrn_out_norm": 1.0 + nrm(ks[12], (N_HGRN, HG_DV), 0.01),
        "hgrn_w_o": nrm(ks[13], (N_HGRN, D_MODEL, D_MODEL), D_MODEL ** -0.5),
        "mlp_w_up": nrm(ks[14], (DEPTH, D_MODEL, D_FF), D_MODEL ** -0.5),
        "mlp_w_down": nrm(ks[15], (DEPTH, D_FF, D_MODEL), D_FF ** -0.5),
        "final_norm": 1.0 + nrm(ks[16], (D_MODEL,), 0.01),
    }


def reference(x_prompt, x_sample, cache_k, cache_v, state_s, mixer_norm, mlp_norm,
              attn_w_qkv, attn_w_o, attn_sinks, hgrn_w_in, hgrn_lb, hgrn_out_norm,
              hgrn_w_o, mlp_w_up, mlp_w_down, final_norm):
    yp, ys = x_prompt, x_sample
    lb_all = jnp.cumsum(jax.nn.softmax(hgrn_lb.astype(jnp.float32), axis=0), axis=0)
    lb_all = lb_all - lb_all[0:1]
    kp_l, vp_l, sp_l, ks_l, vs_l, ss_l = [], [], [], [], [], []
    for i in range(DEPTH):
        j = i // N_MIXERS
        hp = rmsnorm(yp, mixer_norm[i])
        hs = rmsnorm(ys, mixer_norm[i])
        if i % N_MIXERS == 0:
            op, kp, vp = swa_prompt(hp, attn_w_qkv[j], attn_w_o[j], attn_sinks[j])
            os_, kn, vn = swa_sample(hs, cache_k[j], cache_v[j], attn_w_qkv[j], attn_w_o[j], attn_sinks[j])
            kp_l.append(kp.astype(cache_k.dtype))
            vp_l.append(vp.astype(cache_v.dtype))
            ks_l.append(kn)
            vs_l.append(vn)
        else:
            s0 = jnp.zeros((yp.shape[0], HG_HEADS, HG_DK, HG_DV), jnp.float32)
            op, sp = hgrn2_mix(hp, s0, hgrn_w_in[j], lb_all[j], hgrn_out_norm[j], hgrn_w_o[j])
            os_, sn = hgrn2_mix(hs, state_s[j].astype(jnp.float32), hgrn_w_in[j], lb_all[j],
                                hgrn_out_norm[j], hgrn_w_o[j])
            sp_l.append(sp.astype(state_s.dtype))
            ss_l.append(sn.astype(state_s.dtype))
        yp = yp + op
        ys = ys + os_
        yp = yp + sqrelu_mlp(rmsnorm(yp, mlp_norm[i]), mlp_w_up[i], mlp_w_down[i])
        ys = ys + sqrelu_mlp(rmsnorm(ys, mlp_norm[i]), mlp_w_up[i], mlp_w_down[i])
    yp = rmsnorm(yp, final_norm)
    ys = rmsnorm(ys, final_norm)
    return (yp, ys, jnp.stack(kp_l), jnp.stack(vp_l), jnp.stack(sp_l),
            jnp.stack(ks_l), jnp.stack(vs_l), jnp.stack(ss_l))
```

```cpp
#include <hip/hip_runtime.h>
#include <hip/hip_cooperative_groups.h>
#include <cstdio>
#include <cstdint>
namespace cg = cooperative_groups;
namespace pg8 {
#define PG8_LAS __attribute__((address_space(3)))
typedef unsigned short bf16_t;
typedef short bf16x8 __attribute__((ext_vector_type(8)));
typedef float f32x4 __attribute__((ext_vector_type(4)));
typedef unsigned u32x4 __attribute__((ext_vector_type(4)));
constexpr int BM = 256, BK = 64, HALF = 128, HTB = HALF * BK * 2  , STAGE_BYTES = 8 * HTB, NXCD = 8, WGM = 8;

__host__ __device__ __forceinline__ int lds_byte(int r, int c) { const int st = (r >> 4) * 2 + (c >> 5), rr = r & 15, cc = c & 31, ob = rr * 64 + cc * 2; return st * 1024 + (ob ^ (((ob >> 9) & 1) << 5)); }
__host__ __device__ __forceinline__ void stage_rc(int b, int& R, int& C) { const int st = b / 1024, sb = b % 1024, swz = sb ^ (((sb >> 9) & 1) << 5); R = (st >> 1) * 16 + swz / 64; C = (st & 1) * 32 + (swz % 64) / 2; }
__host__ __device__ __forceinline__ int perm32(int rho) { const int n = rho >> 4, i = rho & 15; return 8 * (i >> 2) + 4 * n + (i & 3); }

struct Unit { int pm, pn; };
struct Gemm { const bf16_t* A; const bf16_t* Bt; int M, N, K; };

struct StaticOrder {
    int nM, nN, nwg, G, c;
    __host__ __device__ void init(int M, int N, int G_, int c_) { nM = M / BM; nN = N / BM; nwg = nM * nN; G = G_; c = c_; }
    __host__ __device__ bool next(int i, Unit& u) const {
        const long L = (long)i * G + c; if (L >= nwg) return false;
        int wgid = (int)L; { const int q = nwg / NXCD, r = nwg % NXCD, xcd = wgid % NXCD, off = wgid / NXCD; wgid = (xcd < r ? xcd * (q + 1) : r * (q + 1) + (xcd - r) * q) + off; }
        const int nig = WGM * nN, gid = wgid / nig, fm = gid * WGM, gsz = (nM - fm) < WGM ? (nM - fm) : WGM;
        u.pm = fm + ((wgid % nig) % gsz); u.pn = (wgid % nig) / gsz; return true;
    }
    __device__ __forceinline__ void a_ready(const Unit&) const {}
    __device__ __forceinline__ void done(const Unit&) const {}
};

__device__ __forceinline__ unsigned cvt_pk_bf16(float lo, float hi) { unsigned r; asm volatile("v_cvt_pk_bf16_f32 %0, %1, %2" : "=v"(r) : "v"(lo), "v"(hi)); return r; }
typedef float f32x2 __attribute__((ext_vector_type(2)));
template <class Epi, class Sched, bool ALIGN_EPI = false, bool SP2 = false>
__device__ __forceinline__ void gemm_phase(PG8_LAS unsigned char* lds, const Gemm g, const Sched& S, const Epi& E) {
    int tid_ = threadIdx.x; asm volatile("" : "+v"(tid_)); const int tid = tid_, wid = __builtin_amdgcn_readfirstlane(tid >> 6), lane = tid & 63, wr = wid >> 2, wc = wid & 3, fr = lane & 15, fq = lane >> 4;
    const int K = g.K, nt = K / BK;
    unsigned voffA[2], voffB[2];
#pragma unroll
    for (int i = 0; i < 2; ++i) { int R, C; stage_rc(tid * 16 + i * 8192, R, C); const int Rb = Epi::PERM ? ((R & ~31) + perm32(R & 31)) : R;
        voffA[i] = (unsigned)(R * K + C) * 2u; voffB[i] = (unsigned)(Rb * K + C) * 2u; }
    const size_t kstep = (size_t)(BK * 2);
    const size_t hstep = (size_t)HALF * K * 2;
    const size_t tstep = 2 * hstep;
    const unsigned ldsw = (unsigned)wid * 1024u;
    const int aoff = lds_byte(wr * 64 + fr, fq * 8), boff = lds_byte(wc * 32 + fr, fq * 8);
#define PG8_SA(b, h) (((b) * 2 + (h)) * HTB)
#define PG8_SB(b, h) ((4 + (b) * 2 + (h)) * HTB)
#define PG8_STAGE(bufoff, gbase, voff) do { _Pragma("unroll") for (int _i = 0; _i < 2; ++_i) \
        __builtin_amdgcn_global_load_lds((const unsigned*)((const char*)(gbase) + (voff)[_i]), (PG8_LAS unsigned*)(lds + (bufoff) + ldsw + _i * 8192), 16, 0, 0); } while (0)
#define PG8_LDA(dst, b, h) do { _Pragma("unroll") for (int m = 0; m < 4; ++m) _Pragma("unroll") for (int k = 0; k < 2; ++k) dst[m][k] = *(const PG8_LAS bf16x8*)(lds + PG8_SA(b, h) + aoff + m * 2048 + k * 1024); } while (0)
#define PG8_LDB(dst, b, h) do { _Pragma("unroll") for (int n = 0; n < 2; ++n) _Pragma("unroll") for (int k = 0; k < 2; ++k) dst[n][k] = *(const PG8_LAS bf16x8*)(lds + PG8_SB(b, h) + boff + n * 2048 + k * 1024); } while (0)
#define PG8_MMA(ai, bj, At, Bt) do { __builtin_amdgcn_s_setprio(1); _Pragma("unroll") for (int m = 0; m < 4; ++m) _Pragma("unroll") for (int n = 0; n < 2; ++n) _Pragma("unroll") for (int k = 0; k < 2; ++k) \
        acc[ai][bj][m][n] = __builtin_amdgcn_mfma_f32_16x16x32_bf16(Bt[n][k], At[m][k], acc[ai][bj][m][n], 0, 0, 0); __builtin_amdgcn_s_setprio(0); } while (0)
#define PG8_WAIT_V(n) asm volatile("s_waitcnt vmcnt(" #n ")" ::: "memory")
#define PG8_WAIT_L(n) asm volatile("s_waitcnt lgkmcnt(" #n ")" ::: "memory")
#define PG8_BAR __builtin_amdgcn_s_barrier()
#define PG8_SCHED __builtin_amdgcn_sched_barrier(0)
    Unit cur, nxt; int ui = 0;
    if (!S.next(0, cur)) return;
    f32x4 acc[2][2][4][2];
#pragma unroll
    for (int a = 0; a < 2; ++a)
#pragma unroll
        for (int b = 0; b < 2; ++b)
#pragma unroll
            for (int m = 0; m < 4; ++m)
#pragma unroll
                for (int n = 0; n < 2; ++n) acc[a][b][m][n] = (f32x4){0.f, 0.f, 0.f, 0.f};
    bf16x8 At[4][2], B0[2][2], B1[2][2];
    const char* cA = (const char*)g.A + (size_t)cur.pm * tstep; const char* cB = (const char*)g.Bt + (size_t)cur.pn * tstep;
    S.a_ready(cur);
    if constexpr (SP2) {
        PG8_STAGE(PG8_SB(0, 0), cB, voffB); PG8_STAGE(PG8_SB(0, 1), cB + hstep, voffB); PG8_STAGE(PG8_SA(0, 0), cA, voffA); PG8_STAGE(PG8_SA(0, 1), cA + hstep, voffA);
        if (wr == 1) PG8_BAR;
        PG8_WAIT_V(2); PG8_BAR;
        PG8_STAGE(PG8_SB(1, 0), cB + kstep, voffB); PG8_STAGE(PG8_SA(1, 0), cA + kstep, voffA); PG8_STAGE(PG8_SB(1, 1), cB + hstep + kstep, voffB);
        PG8_WAIT_V(6); PG8_BAR;
    } else {
        PG8_STAGE(PG8_SB(0, 0), cB, voffB); PG8_STAGE(PG8_SA(0, 0), cA, voffA); PG8_STAGE(PG8_SB(0, 1), cB + hstep, voffB); PG8_STAGE(PG8_SA(0, 1), cA + hstep, voffA);
        if (wr == 1) PG8_BAR;
        PG8_WAIT_V(4); PG8_BAR;
        PG8_STAGE(PG8_SB(1, 0), cB + kstep, voffB); PG8_STAGE(PG8_SA(1, 0), cA + kstep, voffA); PG8_STAGE(PG8_SB(1, 1), cB + hstep + kstep, voffB);
        PG8_WAIT_V(6); PG8_BAR;
    }
    for (;;) {
        const bool has_next = S.next(ui + 1, nxt);
        const char* nA = has_next ? (const char*)g.A + (size_t)nxt.pm * tstep : cA; const char* nB = has_next ? (const char*)g.Bt + (size_t)nxt.pn * tstep : cB;
        for (int t = 0; t < nt; t += 2) {
            const bool last = (t == nt - 2);
            const char* a1 = cA + (size_t)(t + 1) * kstep;
            const char* a2 = last ? nA : cA + (size_t)(t + 2) * kstep; const char* b2 = last ? nB : cB + (size_t)(t + 2) * kstep;
            const char* a3 = a2 + kstep; const char* b3 = b2 + kstep;
            if (last && has_next) S.a_ready(nxt);
            if constexpr (SP2) {
            PG8_LDB(B0, 0, 0); PG8_LDB(B1, 0, 1); PG8_SCHED; PG8_LDA(At, 0, 0); PG8_STAGE(PG8_SA(1, 1), a1 + hstep, voffA);
            PG8_WAIT_V(8); PG8_WAIT_L(0); PG8_BAR; PG8_MMA(0, 0, At, B0); PG8_MMA(0, 1, At, B1); PG8_BAR; PG8_SCHED;
            PG8_LDA(At, 0, 1); PG8_STAGE(PG8_SB(0, 0), b2, voffB); PG8_STAGE(PG8_SB(0, 1), b2 + hstep, voffB); PG8_STAGE(PG8_SA(0, 0), a2, voffA);
            PG8_WAIT_V(8); PG8_WAIT_L(0); PG8_BAR; PG8_MMA(1, 0, At, B0); PG8_MMA(1, 1, At, B1); PG8_BAR; PG8_SCHED;
            PG8_LDB(B0, 1, 0); PG8_LDB(B1, 1, 1); PG8_SCHED; PG8_LDA(At, 1, 0); PG8_STAGE(PG8_SA(0, 1), a2 + hstep, voffA);
            PG8_WAIT_V(8); PG8_WAIT_L(0); PG8_BAR; PG8_MMA(0, 0, At, B0); PG8_MMA(0, 1, At, B1); PG8_BAR; PG8_SCHED;
            PG8_LDA(At, 1, 1); PG8_STAGE(PG8_SB(1, 0), b3, voffB); PG8_STAGE(PG8_SB(1, 1), b3 + hstep, voffB); PG8_STAGE(PG8_SA(1, 0), a3, voffA);
            PG8_WAIT_V(8); PG8_WAIT_L(0); PG8_BAR; PG8_MMA(1, 0, At, B0); PG8_MMA(1, 1, At, B1); PG8_BAR; PG8_SCHED;
            } else {
            PG8_LDB(B0, 0, 0); PG8_SCHED; PG8_LDA(At, 0, 0); PG8_STAGE(PG8_SA(1, 1), a1 + hstep, voffA);
            PG8_WAIT_L(8); PG8_BAR; PG8_WAIT_L(0); PG8_MMA(0, 0, At, B0); PG8_BAR; PG8_SCHED;
            PG8_LDB(B1, 0, 1); PG8_STAGE(PG8_SB(0, 0), b2, voffB);
            PG8_BAR; PG8_WAIT_L(0); PG8_MMA(0, 1, At, B1); PG8_BAR;
            PG8_LDA(At, 0, 1); PG8_STAGE(PG8_SA(0, 0), a2, voffA);
            PG8_BAR; PG8_WAIT_L(0); PG8_MMA(1, 0, At, B0); PG8_BAR; PG8_SCHED;
            PG8_STAGE(PG8_SB(0, 1), b2 + hstep, voffB);
            PG8_WAIT_V(6); PG8_BAR; PG8_MMA(1, 1, At, B1); PG8_BAR;
            PG8_LDB(B0, 1, 0); PG8_SCHED; PG8_LDA(At, 1, 0); PG8_STAGE(PG8_SA(0, 1), a2 + hstep, voffA);
            PG8_WAIT_L(8); PG8_BAR; PG8_WAIT_L(0); PG8_MMA(0, 0, At, B0); PG8_BAR; PG8_SCHED;
            PG8_LDB(B1, 1, 1); PG8_STAGE(PG8_SB(1, 0), b3, voffB);
            PG8_BAR; PG8_WAIT_L(0); PG8_MMA(0, 1, At, B1); PG8_BAR;
            PG8_LDA(At, 1, 1); PG8_STAGE(PG8_SA(1, 0), a3, voffA);
            PG8_BAR; PG8_WAIT_L(0); PG8_MMA(1, 0, At, B0); PG8_BAR; PG8_SCHED;
            PG8_STAGE(PG8_SB(1, 1), b3 + hstep, voffB);
            PG8_WAIT_V(6); PG8_BAR; PG8_MMA(1, 1, At, B1); PG8_BAR;
            }
        }
        if constexpr (ALIGN_EPI) { if (wr == 0) PG8_BAR; }
        if constexpr (!Epi::AFTER_DRAIN) { E(acc, cur, wr, wc, fr, fq); S.done(cur); }
        if (!has_next) break;
#pragma unroll
        for (int a = 0; a < 2; ++a)
#pragma unroll
            for (int b = 0; b < 2; ++b)
#pragma unroll
                for (int m = 0; m < 4; ++m)
#pragma unroll
                    for (int n = 0; n < 2; ++n) acc[a][b][m][n] = (f32x4){0.f, 0.f, 0.f, 0.f};
        cur = nxt; cA = nA; cB = nB; ++ui;
        if constexpr (ALIGN_EPI) { if (wr == 1) PG8_BAR; }
    }
    PG8_WAIT_V(0);
    if constexpr (!ALIGN_EPI) { if (wr == 0) PG8_BAR; }
    PG8_BAR;
    if constexpr (Epi::AFTER_DRAIN) { E.fused(acc, cur, wr, wc, fr, fq, lds, wid, lane); S.done(cur); }
#undef PG8_SA
#undef PG8_SB
#undef PG8_STAGE
#undef PG8_LDA
#undef PG8_LDB
#undef PG8_MMA
#undef PG8_WAIT_V
#undef PG8_WAIT_L
#undef PG8_BAR
#undef PG8_SCHED
}
}

using pg8::bf16_t; using pg8::bf16x8; using pg8::f32x4; using pg8::u32x4; using pg8::Unit;
typedef unsigned u32x2 __attribute__((ext_vector_type(2)));
typedef unsigned short u16;
constexpr int DM = 1024, MP = 32768, MS = 512, MT = MP + MS, SEQ = 8192;
constexpr float EPS = 1e-5f, LOG2E = 1.4426950408889634f, C2 = 0.125f * 1.4426950408889634f;
constexpr size_t MiB = 1u << 20;
constexpr size_t WS_SS = 492 * MiB, SS_SLOT = (size_t)MT * 16;
constexpr size_t WS_ROPE = 2 * MiB;
constexpr size_t WS_DB = 3 * MiB;
constexpr size_t WS_W = 6 * MiB;
constexpr size_t WS_XB = 100 * MiB;
constexpr size_t WS_UB = 100 * MiB;
constexpr size_t WS_POOL = 232 * MiB;
constexpr size_t ACT = (size_t)MT * DM * 2;
constexpr size_t WS_END = WS_POOL + 4 * ACT;
constexpr size_t OY = 0, OKP = 34078720, OVP = 34340864, OSP = 34603008, OKS = 35651584, OVS = 36175872, OSS = 36700160;
constexpr size_t WM = 1048576;
struct Params { const float* in[17]; float* out; unsigned char* ws; int ph_lo, ph_hi; };
typedef const __attribute__((address_space(4))) Params* KP;
__device__ __forceinline__ KP kargs() { KP k = (KP)__builtin_amdgcn_kernarg_segment_ptr(); asm volatile("" : "+s"(k)); return k; }

__device__ __forceinline__ unsigned pkbf(float lo, float hi) { typedef float f2 __attribute__((ext_vector_type(2))); typedef __bf16 b2 __attribute__((ext_vector_type(2))); f2 v = {lo, hi}; b2 b = __builtin_convertvector(v, b2); return __builtin_bit_cast(unsigned, b); }
__device__ __forceinline__ float bflo(unsigned u) { return __uint_as_float(u << 16); }
__device__ __forceinline__ float bfhi(unsigned u) { return __uint_as_float(u & 0xffff0000u); }
__device__ __forceinline__ float bf2f(u16 u) { return __uint_as_float((unsigned)u << 16); }
__device__ __forceinline__ u16 f2bf(float f) { return (u16)(pkbf(f, 0.f) & 0xffffu); }
__device__ __forceinline__ unsigned pkh(float lo, float hi) { _Float16 a = (_Float16)lo, b = (_Float16)hi; return (unsigned)__builtin_bit_cast(u16, a) | ((unsigned)__builtin_bit_cast(u16, b) << 16); }
__device__ __forceinline__ f32x4 mfma16(bf16x8 a, bf16x8 b, f32x4 c) { return __builtin_amdgcn_mfma_f32_16x16x32_bf16(a, b, c, 0, 0, 0); }
__device__ __forceinline__ int row_pos(int r) { return r < MP ? (r & (SEQ - 1)) : 2048 + ((r - MP) & 63); }
__device__ __forceinline__ float row_rs(const float* ss, int r) { const f32x4* q = (const f32x4*)(ss + (size_t)r * 16); f32x4 a = q[0], b = q[1], c = q[2], d = q[3]; a = (a + b) + (c + d); return rsqrtf(((a[0] + a[1]) + (a[2] + a[3])) * (1.f / 1024.f) + EPS); }
__device__ __forceinline__ float silu(float v) { return v / (1.f + __expf(-v)); }

struct EpiQKV {
    static constexpr bool PERM = true, AFTER_DRAIN = false;
    const float* ss; bf16_t* Q; bf16_t* K; bf16_t* V; const float* rope; float* nkp; float* nvp; float* nks; float* nvs;
    __device__ __forceinline__ void operator()(const f32x4 (&acc)[2][2][4][2], const Unit& u, int wr, int wc, int fr, int fq) const {
        const int pn = u.pn; const bool rot = (pn <= 4) && ((wc & 1) == 0); const float qs = pn < 4 ? C2 : 1.f;
#pragma unroll
        for (int ai = 0; ai < 2; ++ai)
#pragma unroll
            for (int m = 0; m < 4; ++m) {
                int rl = ai * 128 + wr * 64 + m * 16 + fr; asm volatile("" : "+v"(rl)); const int r = u.pm * 256 + rl;
                const float rs = row_rs(ss, r);
                f32x4 cs0 = {1.f, 1.f, 1.f, 1.f}, cs1 = cs0, sn0 = {0.f, 0.f, 0.f, 0.f}, sn1 = sn0;
                if (rot && fq < 2) { const float* t = rope + row_pos(r) * 16; cs0 = *(const f32x4*)t; cs1 = *(const f32x4*)(t + 4); sn0 = *(const f32x4*)(t + 8); sn1 = *(const f32x4*)(t + 12); }
                if (fq == 0) { sn0 = -sn0; sn1 = -sn1; }
                float* nk = nullptr;
                if (pn >= 4) {
                    if (u.pm < 128) { const int t = (u.pm & 31) * 256 + rl; if (t >= 8064) nk = (pn == 4 ? nkp : nvp) + ((size_t)(u.pm >> 5) * 128 + (t - 8064)) * 256; }
                    else { const int rr = r - MP; nk = (pn == 4 ? nks : nvs) + ((size_t)(rr >> 6) * 128 + 64 + (rr & 63)) * 256; }
                }
#pragma unroll
                for (int bj = 0; bj < 2; ++bj) {
                    f32x4 v0 = acc[ai][bj][m][0] * rs, v1 = acc[ai][bj][m][1] * rs;
                    if (rot) {
                        f32x4 p0, p1;
#pragma unroll
                        for (int e = 0; e < 4; ++e) { p0[e] = __shfl_xor(v0[e], 16); p1[e] = __shfl_xor(v1[e], 16); }
                        v0 = v0 * cs0 + p0 * sn0; v1 = v1 * cs1 + p1 * sn1;
                    }
                    v0 = v0 * qs; v1 = v1 * qs;
                    const int cw = bj * 128 + wc * 32 + 8 * fq;
                    bf16_t* dst = pn < 4 ? Q + (size_t)r * 1024 + pn * 256 + cw : (pn == 4 ? K : V) + (size_t)r * 256 + cw;
                    u32x4 w; w.x = pkbf(v0[0], v0[1]); w.y = pkbf(v0[2], v0[3]); w.z = pkbf(v1[0], v1[1]); w.w = pkbf(v1[2], v1[3]);
                    *(u32x4*)dst = w;
                    if (nk) { *(f32x4*)(nk + cw) = v0; *(f32x4*)(nk + cw + 4) = v1; }
                }
                asm volatile("" ::: "memory");
            }
    }
};
struct EpiRes {
    static constexpr bool PERM = false, AFTER_DRAIN = false;
    float* X; bf16_t* XB; float* ssn;
    __device__ __forceinline__ void operator()(const f32x4 (&acc)[2][2][4][2], const Unit& u, int wr, int wc, int fr, int fq) const {
        const int col0 = u.pn * 256 + wc * 32 + 4 * fq;
#pragma unroll
        for (int ai = 0; ai < 2; ++ai)
#pragma unroll
            for (int m = 0; m < 4; ++m) {
                int r = u.pm * 256 + ai * 128 + wr * 64 + m * 16 + fr; asm volatile("" : "+v"(r)); const size_t off = (size_t)r * 1024 + col0; float sq = 0.f;
#pragma unroll
                for (int bj = 0; bj < 2; ++bj)
#pragma unroll
                    for (int n = 0; n < 2; ++n) { const size_t c = off + bj * 128 + n * 16; const f32x4 x = *(const f32x4*)(X + c) + acc[ai][bj][m][n]; *(f32x4*)(X + c) = x;
                        sq += (x[0] * x[0] + x[1] * x[1]) + (x[2] * x[2] + x[3] * x[3]); u32x2 w; w.x = pkbf(x[0], x[1]); w.y = pkbf(x[2], x[3]); *(u32x2*)(XB + c) = w; }
                sq += __shfl_xor(sq, 16); sq += __shfl_xor(sq, 32);
                if (fq == 0) ssn[(size_t)r * 16 + u.pn * 4 + wc] = sq;
                asm volatile("" ::: "memory");
            }
    }
};
struct EpiUp {
    static constexpr bool PERM = true, AFTER_DRAIN = false;
    const float* ss; bf16_t* H;
    __device__ __forceinline__ void operator()(const f32x4 (&acc)[2][2][4][2], const Unit& u, int wr, int wc, int fr, int fq) const {
#pragma unroll
        for (int ai = 0; ai < 2; ++ai)
#pragma unroll
            for (int m = 0; m < 4; ++m) {
                int r = u.pm * 256 + ai * 128 + wr * 64 + m * 16 + fr; asm volatile("" : "+v"(r)); const float rs = row_rs(ss, r);
#pragma unroll
                for (int bj = 0; bj < 2; ++bj) {
                    f32x4 v0 = acc[ai][bj][m][0] * rs, v1 = acc[ai][bj][m][1] * rs;
#pragma unroll
                    for (int e = 0; e < 4; ++e) { const float a = fmaxf(v0[e], 0.f), b = fmaxf(v1[e], 0.f); v0[e] = a * a; v1[e] = b * b; }
                    u32x4 w; w.x = pkbf(v0[0], v0[1]); w.y = pkbf(v0[2], v0[3]); w.z = pkbf(v1[0], v1[1]); w.w = pkbf(v1[2], v1[3]);
                    *(u32x4*)(H + (size_t)r * 4096 + u.pn * 256 + bj * 128 + wc * 32 + 8 * fq) = w;
                }
                asm volatile("" ::: "memory");
            }
    }
};
struct EpiHin {
    static constexpr bool PERM = true, AFTER_DRAIN = false;
    const float* ss; u16* base;
    __device__ __forceinline__ void operator()(const f32x4 (&acc)[2][2][4][2], const Unit& u, int wr, int wc, int fr, int fq) const {
        const int sel = u.pn >> 2; u16* ob = base + (size_t)sel * (ACT / 2);
#pragma unroll
        for (int ai = 0; ai < 2; ++ai)
#pragma unroll
            for (int m = 0; m < 4; ++m) {
                int r = u.pm * 256 + ai * 128 + wr * 64 + m * 16 + fr; asm volatile("" : "+v"(r)); const float rs = row_rs(ss, r);
#pragma unroll
                for (int bj = 0; bj < 2; ++bj) {
                    f32x4 v0 = acc[ai][bj][m][0] * rs, v1 = acc[ai][bj][m][1] * rs; u32x4 w;
                    if (sel == 1) { w.x = pkh(v0[0], v0[1]); w.y = pkh(v0[2], v0[3]); w.z = pkh(v1[0], v1[1]); w.w = pkh(v1[2], v1[3]); }
                    else {
                        if (sel != 2) {
#pragma unroll
                            for (int e = 0; e < 4; ++e) { v0[e] = silu(v0[e]); v1[e] = silu(v1[e]); }
                        }
                        w.x = pkbf(v0[0], v0[1]); w.y = pkbf(v0[2], v0[3]); w.z = pkbf(v1[0], v1[1]); w.w = pkbf(v1[2], v1[3]);
                    }
                    *(u32x4*)(ob + (size_t)r * 1024 + (u.pn & 3) * 256 + bj * 128 + wc * 32 + 8 * fq) = w;
                }
                asm volatile("" ::: "memory");
            }
    }
};

__device__ __forceinline__ void p0_transpose_item(const float* W, const float* g, int K, int N, bf16_t* WT, float* scr, int item, int lane) {
    const int nblk = N / 32, kb = item / nblk, nb = item % nblk, k0 = 64 * kb, n0 = 32 * nb;
#pragma unroll 8
    for (int i = 0; i < 32; ++i) { const int kk = 2 * i + (lane >> 5); const float gs = g ? g[k0 + kk] : 1.f; scr[kk * 33 + (lane & 31)] = W[(size_t)(k0 + kk) * N + n0 + (lane & 31)] * gs; }
    asm volatile("s_waitcnt lgkmcnt(0)" ::: "memory");
    const int c = lane & 7;
#pragma unroll
    for (int jj = 0; jj < 4; ++jj) { const int n = (lane >> 3) + 8 * jj; const float* s = scr + (8 * c) * 33 + n;
        u32x4 o; o.x = pkbf(s[0 * 33], s[1 * 33]); o.y = pkbf(s[2 * 33], s[3 * 33]); o.z = pkbf(s[4 * 33], s[5 * 33]); o.w = pkbf(s[6 * 33], s[7 * 33]);
        *(u32x4*)(WT + (size_t)(n0 + n) * K + k0 + 8 * c) = o; }
    asm volatile("s_waitcnt lgkmcnt(0)" ::: "memory");
}
__device__ __forceinline__ size_t wlayer_base(int layer) { return layer == 0 ? 0 : layer == 1 ? (size_t)(10.5 * WM) : layer == 2 ? (size_t)(23.5 * WM) : (size_t)(34 * WM); }
__device__ __forceinline__ size_t wmat_off(int layer, int which) {
    const size_t b = wlayer_base(layer);
    if (layer & 1) return b + (which == 0 ? 0 : which == 1 ? 4 * WM : which == 2 ? 5 * WM : 9 * WM);
    return b + (which == 0 ? 0 : which == 1 ? (size_t)(1.5 * WM) : which == 2 ? (size_t)(2.5 * WM) : (size_t)(6.5 * WM));
}
__device__ __forceinline__ void prologue(KP pk, char* lds, int vcu, int G) {
    int tid_ = threadIdx.x; asm volatile("" : "+v"(tid_)); const int tid = tid_, lane = tid & 63, w = __builtin_amdgcn_readfirstlane(tid >> 6);
    const int gw = vcu * 8 + w, NGW = G * 8, gt = vcu * 512 + tid, NTH = G * 512;
    float* scr = (float*)(lds + w * 16384);
    bf16_t* WB = (bf16_t*)(pk->ws + WS_W);
    for (int it = gw; it < 24064; it += NGW) {
        int layer, r;
        if (it < 5376) { layer = 0; r = it; } else if (it < 12032) { layer = 1; r = it - 5376; } else if (it < 17408) { layer = 2; r = it - 12032; } else { layer = 3; r = it - 17408; }
        const int j = layer >> 1; const int n0 = (layer & 1) ? 2048 : 768; int which;
        if (r < n0) which = 0; else if (r < n0 + 512) { which = 1; r -= n0; } else if (r < n0 + 2560) { which = 2; r -= n0 + 512; } else { which = 3; r -= n0 + 2560; }
        const float* W; const float* g = nullptr; int K = 1024, N = 1024;
        if (which == 0) { g = pk->in[5] + layer * 1024; if (layer & 1) { W = pk->in[10] + (size_t)j * 4 * WM; N = 4096; } else { W = pk->in[7] + (size_t)j * 1536 * 1024; N = 1536; } }
        else if (which == 1) { W = ((layer & 1) ? pk->in[13] : pk->in[8]) + (size_t)j * WM; }
        else if (which == 2) { W = pk->in[14] + (size_t)layer * 4 * WM; g = pk->in[6] + layer * 1024; N = 4096; }
        else { W = pk->in[15] + (size_t)layer * 4 * WM; K = 4096; }
        p0_transpose_item(W, g, K, N, WB + wmat_off(layer, which), scr, r, lane);
    }
    float* X = pk->out + OY; bf16_t* XB = (bf16_t*)(pk->ws + WS_XB); float* ss0 = (float*)(pk->ws + WS_SS);
    for (int r = gw; r < MT; r += NGW) {
        const float* src = r < MP ? pk->in[0] + (size_t)r * 1024 : pk->in[1] + (size_t)(r - MP) * 1024; float s = 0.f;
#pragma unroll
        for (int q = 0; q < 4; ++q) { const f32x4 v = *(const f32x4*)(src + 256 * q + 4 * lane); *(f32x4*)(X + (size_t)r * 1024 + 256 * q + 4 * lane) = v;
            u32x2 o; o.x = pkbf(v[0], v[1]); o.y = pkbf(v[2], v[3]); *(u32x2*)(XB + (size_t)r * 1024 + 256 * q + 4 * lane) = o; s += (v[0] * v[0] + v[1] * v[1]) + (v[2] * v[2] + v[3] * v[3]); }
#pragma unroll
        for (int o = 1; o < 64; o <<= 1) s += __shfl_xor(s, o);
        if (lane < 16) ss0[(size_t)r * 16 + lane] = lane == 0 ? s : 0.f;
    }
    float* rope = (float*)(pk->ws + WS_ROPE);
    for (int e = gt; e < 65536; e += NTH) { const int pos = e >> 3, i = e & 7; const float inv = exp2f(-(float)i * 2.3664460711655217f); const float ang = (float)pos * inv;
        const double rev = (double)ang * 0.15915494309189535; const float fr = (float)(rev - __builtin_rint(rev));
        rope[pos * 16 + i] = __builtin_amdgcn_cosf(fr); rope[pos * 16 + 8 + i] = __builtin_amdgcn_sinf(fr); }
    for (int e = gt; e < 65536; e += NTH) { const int jj = e >> 15, rem = e & 32767, sb = rem >> 12, row = (rem >> 6) & 63, c4 = rem & 63;
        const size_t so = ((size_t)((jj * 8 + sb) * 128 + 64 + row)) * 256 + 4 * c4, dof = ((size_t)((jj * 8 + sb) * 128 + row)) * 256 + 4 * c4;
        *(f32x4*)(pk->out + OKS + dof) = *(const f32x4*)(pk->in[2] + so); *(f32x4*)(pk->out + OVS + dof) = *(const f32x4*)(pk->in[3] + so); }
}

__device__ __forceinline__ void attn_phase(KP pk, char* lds, int j, int vcu, int G) {
    int tid_ = threadIdx.x; asm volatile("" : "+v"(tid_)); const int tid = tid_, lane = tid & 63, w = __builtin_amdgcn_readfirstlane(tid >> 6), l15 = lane & 15, q4 = lane >> 4;
    bf16_t* Ks = (bf16_t*)lds; bf16_t* Vt = (bf16_t*)(lds + 27648);
    const bf16_t* Qb = (const bf16_t*)(pk->ws + WS_POOL); bf16_t* Ob = (bf16_t*)(pk->ws + WS_POOL + ACT);
    const bf16_t* Kb = (const bf16_t*)(pk->ws + WS_POOL + 2 * ACT); const bf16_t* Vb = Kb + (size_t)MT * 256;
    const float* ck = pk->in[2] + (size_t)j * 8 * 128 * 256; const float* cv = pk->in[3] + (size_t)j * 8 * 128 * 256; const float* sinks = pk->in[9] + j * 16;
    for (int unit = vcu; unit < 2080; unit += G) {
        int qrow0, kvh, kt0, sb = -1;
        if (unit < 2048) { const int b = unit >> 9, c = (unit >> 2) & 127; kvh = unit & 3; qrow0 = b * 8192 + c * 64; kt0 = c >= 2 ? 0 : (c == 1 ? 4 : 8); }
        else { const int u2 = unit - 2048; sb = u2 >> 2; kvh = u2 & 3; qrow0 = MP + sb * 64; kt0 = 0; }
        __syncthreads();
#pragma unroll
        for (int i = 0; i < 3; ++i) { const int ch = tid + 512 * i, key = ch >> 3, dc = ch & 7; u32x4 kv = {0u, 0u, 0u, 0u}, vv = kv;
            if (key >= 16 * kt0) {
                if (sb >= 0 && key < 128) { const size_t so = ((size_t)(sb * 128 + key) * 4 + kvh) * 64 + 8 * dc;
                    const f32x4 a = *(const f32x4*)(ck + so), b = *(const f32x4*)(ck + so + 4), c = *(const f32x4*)(cv + so), d = *(const f32x4*)(cv + so + 4);
                    kv.x = pkbf(a[0], a[1]); kv.y = pkbf(a[2], a[3]); kv.z = pkbf(b[0], b[1]); kv.w = pkbf(b[2], b[3]);
                    vv.x = pkbf(c[0], c[1]); vv.y = pkbf(c[2], c[3]); vv.z = pkbf(d[0], d[1]); vv.w = pkbf(d[2], d[3]); }
                else { const size_t so = (size_t)(qrow0 - 128 + key) * 256 + kvh * 64 + 8 * dc; kv = *(const u32x4*)(Kb + so); vv = *(const u32x4*)(Vb + so); }
            }
            *(u32x4*)(Ks + key * 72 + 8 * dc) = kv;
#pragma unroll
            for (int e = 0; e < 8; ++e) Vt[(8 * dc + e) * 200 + key] = (u16)(vv[e >> 1] >> (16 * (e & 1)));
        }
        __syncthreads();
#pragma unroll 1
        for (int qt = 0; qt < 2; ++qt) {
            const int qi = 2 * w + qt, g = qi >> 2, t0 = 16 * (qi & 3), head = kvh * 4 + g;
            const bf16_t* qp = Qb + (size_t)(qrow0 + t0 + l15) * 1024 + head * 64 + 8 * q4;
            const bf16x8 qf0 = *(const bf16x8*)qp, qf1 = *(const bf16x8*)(qp + 32);
            f32x4 s[12]; const float sink2 = sinks[head] * LOG2E; float mx = sink2;
#pragma unroll
            for (int kt = 0; kt < 12; ++kt) { const bf16_t* kp = Ks + (16 * kt + l15) * 72 + 8 * q4;
                f32x4 a = {0.f, 0.f, 0.f, 0.f}; a = mfma16(*(const bf16x8*)kp, qf0, a); a = mfma16(*(const bf16x8*)(kp + 32), qf1, a);
                if (kt < kt0) a = (f32x4){-INFINITY, -INFINITY, -INFINITY, -INFINITY};
                s[kt] = a; mx = fmaxf(fmaxf(mx, fmaxf(a[0], a[1])), fmaxf(a[2], a[3])); asm volatile("" ::: "memory"); }
            mx = fmaxf(mx, __shfl_xor(mx, 16)); mx = fmaxf(mx, __shfl_xor(mx, 32));
            float ls = 0.f;
#pragma unroll
            for (int kt = 0; kt < 12; ++kt)
#pragma unroll
                for (int e = 0; e < 4; ++e) { const float pe = __builtin_amdgcn_exp2f(s[kt][e] - mx); s[kt][e] = pe; ls += pe; }
            ls += __shfl_xor(ls, 16); ls += __shfl_xor(ls, 32); ls += __builtin_amdgcn_exp2f(sink2 - mx);
            const float rl = 1.f / ls;
            f32x4 o[4];
#pragma unroll
            for (int dt = 0; dt < 4; ++dt) o[dt] = (f32x4){0.f, 0.f, 0.f, 0.f};
#pragma unroll
            for (int kp = 0; kp < 6; ++kp) { u32x4 pw; pw.x = pkbf(s[2 * kp][0], s[2 * kp][1]); pw.y = pkbf(s[2 * kp][2], s[2 * kp][3]); pw.z = pkbf(s[2 * kp + 1][0], s[2 * kp + 1][1]); pw.w = pkbf(s[2 * kp + 1][2], s[2 * kp + 1][3]);
                const bf16x8 pf = __builtin_bit_cast(bf16x8, pw);
#pragma unroll
                for (int dt = 0; dt < 4; ++dt) { const bf16_t* vp = Vt + (16 * dt + l15) * 200 + 32 * kp + 4 * q4; const u32x2 lo = *(const u32x2*)vp, hi = *(const u32x2*)(vp + 16);
                    u32x4 aw; aw.x = lo.x; aw.y = lo.y; aw.z = hi.x; aw.w = hi.y; o[dt] = mfma16(__builtin_bit_cast(bf16x8, aw), pf, o[dt]); } asm volatile("" ::: "memory"); }
            bf16_t* op = Ob + (size_t)(qrow0 + t0 + l15) * 1024 + head * 64 + 4 * q4;
#pragma unroll
            for (int dt = 0; dt < 4; ++dt) { u32x2 ow; ow.x = pkbf(o[dt][0] * rl, o[dt][1] * rl); ow.y = pkbf(o[dt][2] * rl, o[dt][3] * rl); *(u32x2*)(op + 16 * dt) = ow; }
        }
    }
}

__device__ __forceinline__ void hgrn_item(int it, int& m0, int& h) { if (it < 4096) { h = it & 7; m0 = (it >> 10) * 8192 + ((it >> 3) & 127) * 64; } else { const int x = it - 4096; h = x & 7; m0 = MP + (x >> 3) * 64; } }
constexpr int HL_ZS = 0, HL_TOT = 16384, HL_KT = 18432, HL_VT = 36864, HL_QS = 55296, HL_KS = 72704, HL_ST = 90112, HL_SSQ = 124928;

#define HGRN_COMMON() \
    __syncthreads(); \
    _Pragma("unroll") for (int i = 0; i < 2; ++i) { const int ch = tid + 512 * i, row = ch >> 4, cc = ch & 15; const size_t go = (size_t)(m0 + row) * 1024 + h * 128 + 8 * cc; \
        *(u32x4*)(ZS + row * 128 + 8 * cc) = *(const u32x4*)(ZF + go); const u32x4 vv = *(const u32x4*)(VH + go); \
        _Pragma("unroll") for (int e = 0; e < 8; ++e) VT[(8 * cc + e) * 72 + row] = (u16)(vv[e >> 1] >> (16 * (e & 1))); } \
    __syncthreads(); \
    float lbv = 0.f; if (j == 1) { const float a = pk->in[11][h * 128 + k], b = pk->in[11][1024 + h * 128 + k]; lbv = 1.f / (1.f + __expf(a - b)); } \
    const float oml = 1.f - lbv; float kk[16], bl[16]; float cum = 0.f; \
    _Pragma("unroll") for (int i = 0; i < 16; ++i) { const float z = (float)ZS[(16 * seg + i) * 128 + k]; const float ez = __expf(-z), sg = 1.f / (1.f + ez); cum += __logf(lbv + oml * sg); bl[i] = cum; kk[i] = oml * ez * sg; } \
    TOT[seg * 128 + k] = cum; \
    __syncthreads(); \
    const float t0_ = TOT[k], t1_ = TOT[128 + k], t2_ = TOT[256 + k], t3_ = TOT[384 + k]; \
    const float off = seg == 0 ? 0.f : seg == 1 ? t0_ : seg == 2 ? t0_ + t1_ : t0_ + t1_ + t2_; const float b31 = t0_ + t1_;

__device__ __forceinline__ void hgrn_passA(KP pk, char* lds, int j, int vcu, int G) {
    int tid_ = threadIdx.x; asm volatile("" : "+v"(tid_)); const int tid = tid_, lane = tid & 63, w = __builtin_amdgcn_readfirstlane(tid >> 6), l15 = lane & 15, q4 = lane >> 4, k = tid & 127, seg = tid >> 7;
    _Float16* ZS = (_Float16*)(lds + HL_ZS); float* TOT = (float*)(lds + HL_TOT); bf16_t* KT = (bf16_t*)(lds + HL_KT); bf16_t* VT = (bf16_t*)(lds + HL_VT);
    const u16* ZF = (const u16*)(pk->ws + WS_POOL + ACT); const u16* VH = (const u16*)(pk->ws + WS_POOL + 2 * ACT);
    bf16_t* UB = (bf16_t*)(pk->ws + WS_UB); float* DB = (float*)(pk->ws + WS_DB);
    for (int it = vcu; it < 4160; it += G) {
        int m0, h; hgrn_item(it, m0, h);
        HGRN_COMMON()
        { u32x4 w0, w1; unsigned wk[8];
#pragma unroll
          for (int i = 0; i < 8; ++i) wk[i] = pkbf(kk[2 * i] * __expf(b31 - (off + bl[2 * i])), kk[2 * i + 1] * __expf(b31 - (off + bl[2 * i + 1])));
          w0.x = wk[0]; w0.y = wk[1]; w0.z = wk[2]; w0.w = wk[3]; w1.x = wk[4]; w1.y = wk[5]; w1.z = wk[6]; w1.w = wk[7];
          *(u32x4*)(KT + k * 72 + 16 * seg) = w0; *(u32x4*)(KT + k * 72 + 16 * seg + 8) = w1; }
        if (seg == 0) DB[(size_t)it * 128 + k] = __expf(b31 + t2_ + t3_);
        __syncthreads();
        const int kr = 16 * w + l15;
        const bf16x8 b0 = *(const bf16x8*)(KT + kr * 72 + 8 * q4), b1 = *(const bf16x8*)(KT + kr * 72 + 32 + 8 * q4);
        const float sc = __expf(TOT[256 + kr] + TOT[384 + kr]);
        bf16_t* up = UB + (size_t)it * 16384 + kr * 128 + 4 * q4;
#pragma unroll
        for (int vt = 0; vt < 8; ++vt) { const bf16_t* vp = VT + (16 * vt + l15) * 72 + 8 * q4; f32x4 a = {0.f, 0.f, 0.f, 0.f};
            a = mfma16(*(const bf16x8*)vp, b0, a); a = mfma16(*(const bf16x8*)(vp + 32), b1, a);
            u32x2 ow; ow.x = pkbf(a[0] * sc, a[1] * sc); ow.y = pkbf(a[2] * sc, a[3] * sc); *(u32x2*)(up + 16 * vt) = ow; }
    }
}
__device__ __forceinline__ void hgrn_passB(KP pk, int j, int G) {
    int tid_ = threadIdx.x; asm volatile("" : "+v"(tid_)); const int gt = blockIdx.x * 512 + tid_, NTH = G * 512;
    bf16_t* UB = (bf16_t*)(pk->ws + WS_UB); const float* DB = (const float*)(pk->ws + WS_DB);
    for (int e = gt; e < 131072; e += NTH) {
        const int bh = e >> 12, k = (e >> 5) & 127, v4 = e & 31, b = bh >> 3, h = bh & 7;
        f32x4 S = {0.f, 0.f, 0.f, 0.f};
        bf16_t* ub = UB + (size_t)(b * 1024 + h) * 16384 + k * 128 + 4 * v4; const float* db = DB + (size_t)(b * 1024 + h) * 128 + k;
#pragma unroll 1
        for (int c0 = 0; c0 < 128; c0 += 8) {
            u32x2 uu[8]; float d[8];
#pragma unroll
            for (int i = 0; i < 8; ++i) { uu[i] = *(const u32x2*)(ub + (size_t)(c0 + i) * 8 * 16384); d[i] = db[(size_t)(c0 + i) * 1024]; }
#pragma unroll
            for (int i = 0; i < 8; ++i) { u32x2 sw; sw.x = pkbf(S[0], S[1]); sw.y = pkbf(S[2], S[3]); *(u32x2*)(ub + (size_t)(c0 + i) * 8 * 16384) = sw;
                S[0] = d[i] * S[0] + bflo(uu[i].x); S[1] = d[i] * S[1] + bfhi(uu[i].x); S[2] = d[i] * S[2] + bflo(uu[i].y); S[3] = d[i] * S[3] + bfhi(uu[i].y); }
        }
        *(f32x4*)(pk->out + OSP + (size_t)(j * 32 + bh) * 16384 + k * 128 + 4 * v4) = S;
    }
    for (int e = gt; e < 262144; e += NTH) {
        const int sbh = e >> 12, k = (e >> 5) & 127, v4 = e & 31, it = 4096 + sbh; const size_t eo = (size_t)k * 128 + 4 * v4;
        const f32x4 S0 = *(const f32x4*)(pk->in[4] + (size_t)(j * 64 + sbh) * 16384 + eo);
        bf16_t* ub = UB + (size_t)it * 16384 + eo; const u32x2 uu = *(const u32x2*)ub; const float d = DB[(size_t)it * 128 + k];
        u32x2 sw; sw.x = pkbf(S0[0], S0[1]); sw.y = pkbf(S0[2], S0[3]); *(u32x2*)ub = sw;
        f32x4 S; S[0] = d * S0[0] + bflo(uu.x); S[1] = d * S0[1] + bfhi(uu.x); S[2] = d * S0[2] + bflo(uu.y); S[3] = d * S0[3] + bfhi(uu.y);
        *(f32x4*)(pk->out + OSS + (size_t)(j * 64 + sbh) * 16384 + eo) = S;
    }
}
__device__ __forceinline__ void hgrn_passC(KP pk, char* lds, int j, int vcu, int G) {
    int tid_ = threadIdx.x; asm volatile("" : "+v"(tid_)); const int tid = tid_, lane = tid & 63, w = __builtin_amdgcn_readfirstlane(tid >> 6), l15 = lane & 15, q4 = lane >> 4, k = tid & 127, seg = tid >> 7;
    _Float16* ZS = (_Float16*)(lds + HL_ZS); float* TOT = (float*)(lds + HL_TOT); bf16_t* VT = (bf16_t*)(lds + HL_VT);
    bf16_t* QS = (bf16_t*)(lds + HL_QS); bf16_t* KS = (bf16_t*)(lds + HL_KS); bf16_t* ST = (bf16_t*)(lds + HL_ST); float* SSQ = (float*)(lds + HL_SSQ);
    u16* QH = (u16*)(pk->ws + WS_POOL); const u16* ZF = (const u16*)(pk->ws + WS_POOL + ACT); const u16* VH = (const u16*)(pk->ws + WS_POOL + 2 * ACT); const u16* GH = (const u16*)(pk->ws + WS_POOL + 3 * ACT);
    const bf16_t* UB = (const bf16_t*)(pk->ws + WS_UB); const float* onorm = pk->in[12] + j * 128;
    for (int it = vcu; it < 4160; it += G) {
        int m0, h; hgrn_item(it, m0, h);
        float qv[16];
#pragma unroll
        for (int i = 0; i < 16; ++i) qv[i] = bf2f(QH[(size_t)(m0 + 16 * seg + i) * 1024 + h * 128 + k]);
        HGRN_COMMON()
#pragma unroll
        for (int i = 0; i < 16; ++i) { const float bt = off + bl[i]; KS[(16 * seg + i) * 136 + k] = f2bf(kk[i] * __expf(b31 - bt)); QS[(16 * seg + i) * 136 + k] = f2bf(qv[i] * __expf(bt - b31)); }
#pragma unroll
        for (int i = 0; i < 4; ++i) { const int ch = tid + 512 * i, kr = ch >> 4, vc = ch & 15; const float sc = __expf(TOT[kr] + TOT[128 + kr]);
            const u32x4 sv = *(const u32x4*)(UB + (size_t)it * 16384 + kr * 128 + 8 * vc);
#pragma unroll
            for (int e = 0; e < 8; ++e) { const unsigned wv = sv[e >> 1]; const float f = (e & 1) ? bfhi(wv) : bflo(wv); ST[(8 * vc + e) * 136 + kr] = f2bf(f * sc); } }
        __syncthreads();
        const int tt = w & 3, vh = w >> 2;
        bf16x8 qf[4];
#pragma unroll
        for (int ks = 0; ks < 4; ++ks) qf[ks] = *(const bf16x8*)(QS + (16 * tt + l15) * 136 + 32 * ks + 8 * q4);
        f32x4 sc4[4];
#pragma unroll
        for (int st = 0; st < 4; ++st) { f32x4 a = {0.f, 0.f, 0.f, 0.f};
            if (st <= tt) {
#pragma unroll
                for (int ks = 0; ks < 4; ++ks) a = mfma16(*(const bf16x8*)(KS + (16 * st + l15) * 136 + 32 * ks + 8 * q4), qf[ks], a);
                if (st == tt) {
#pragma unroll
                    for (int r = 0; r < 4; ++r) if (4 * q4 + r > l15) a[r] = 0.f;
                }
            }
            sc4[st] = a; }
        f32x4 o[4];
#pragma unroll
        for (int vi = 0; vi < 4; ++vi) { const int vt = 4 * vh + vi; f32x4 a = {0.f, 0.f, 0.f, 0.f};
#pragma unroll
            for (int kp = 0; kp < 2; ++kp) if (2 * kp <= tt) {
                u32x4 pw; pw.x = pkbf(sc4[2 * kp][0], sc4[2 * kp][1]); pw.y = pkbf(sc4[2 * kp][2], sc4[2 * kp][3]); pw.z = pkbf(sc4[2 * kp + 1][0], sc4[2 * kp + 1][1]); pw.w = pkbf(sc4[2 * kp + 1][2], sc4[2 * kp + 1][3]);
                const bf16_t* vp = VT + (16 * vt + l15) * 72 + 32 * kp + 4 * q4; const u32x2 lo = *(const u32x2*)vp, hi = *(const u32x2*)(vp + 16);
                u32x4 aw; aw.x = lo.x; aw.y = lo.y; aw.z = hi.x; aw.w = hi.y; a = mfma16(__builtin_bit_cast(bf16x8, aw), __builtin_bit_cast(bf16x8, pw), a); }
#pragma unroll
            for (int ks = 0; ks < 4; ++ks) a = mfma16(*(const bf16x8*)(ST + (16 * vt + l15) * 136 + 32 * ks + 8 * q4), qf[ks], a);
            o[vi] = a; }
        float sq = 0.f;
#pragma unroll
        for (int vi = 0; vi < 4; ++vi) sq += (o[vi][0] * o[vi][0] + o[vi][1] * o[vi][1]) + (o[vi][2] * o[vi][2] + o[vi][3] * o[vi][3]);
        sq += __shfl_xor(sq, 16); sq += __shfl_xor(sq, 32);
        if (q4 == 0) SSQ[vh * 64 + 16 * tt + l15] = sq;
        __syncthreads();
        const float rn = rsqrtf((SSQ[16 * tt + l15] + SSQ[64 + 16 * tt + l15]) * (1.f / 128.f) + EPS);
#pragma unroll
        for (int vi = 0; vi < 4; ++vi) { const int v0 = 16 * (4 * vh + vi) + 4 * q4; const f32x4 gn = *(const f32x4*)(onorm + v0); const size_t go = (size_t)(m0 + 16 * tt + l15) * 1024 + h * 128 + v0;
            const u32x2 gg = *(const u32x2*)(GH + go); u32x2 ow;
            ow.x = pkbf(o[vi][0] * rn * gn[0] * bflo(gg.x), o[vi][1] * rn * gn[1] * bfhi(gg.x)); ow.y = pkbf(o[vi][2] * rn * gn[2] * bflo(gg.y), o[vi][3] * rn * gn[3] * bfhi(gg.y));
            *(u32x2*)(QH + go) = ow; }
    }
}
__device__ __forceinline__ void final_phase(KP pk, int vcu, int G) {
    int tid_ = threadIdx.x; asm volatile("" : "+v"(tid_)); const int tid = tid_, lane = tid & 63, w = tid >> 6; const int gw = vcu * 8 + w, NGW = G * 8;
    float* X = pk->out + OY; const float* ss = (const float*)(pk->ws + WS_SS) + (size_t)(8 % 3) * SS_SLOT; const float* fn = pk->in[16];
    for (int r = gw; r < MT; r += NGW) { const float rs = row_rs(ss, r);
#pragma unroll
        for (int q = 0; q < 4; ++q) { float* xp = X + (size_t)r * 1024 + 256 * q + 4 * lane; const f32x4 g = *(const f32x4*)(fn + 256 * q + 4 * lane); *(f32x4*)xp = *(const f32x4*)xp * rs * g; } }
}

constexpr int LDS_BYTES = 147456;
constexpr int NPHASE = 26;
#ifndef SKIPMASK
#define SKIPMASK 0
#endif
__global__ void __launch_bounds__(512, 2) fwd_kernel(Params p_unused) {
    extern __shared__ __attribute__((aligned(16))) unsigned char lds[];
    cg::grid_group grid = cg::this_grid();
    const int G = gridDim.x, bx = blockIdx.x; const int vcu = (G % 8 == 0) ? (bx % 8) * (G / 8) + bx / 8 : bx;
    int ph, ph_hi; { KP k0 = kargs(); ph = k0->ph_lo; ph_hi = k0->ph_hi; }
    for (; ph < ph_hi; ++ph) {
        int layer = 0, kind;
        if (ph == 0) kind = 0; else if (ph == NPHASE - 1) kind = 10;
        else { int q = ph - 1; if (q < 5) { layer = 0; kind = 1 + q; } else if (q < 12) { layer = 1; q -= 5; kind = q < 4 ? 6 + q : q - 1; } else if (q < 17) { layer = 2; kind = 1 + (q - 12); } else { layer = 3; q -= 17; kind = q < 4 ? 6 + q : q - 1; } }
        const int j = layer >> 1;
        KP pk = kargs();
        if (kind == 0) { if (!(SKIPMASK & 1)) prologue(pk, (char*)lds, vcu, G); }
        else if (kind == 1 && !(SKIPMASK & 2)) {
            unsigned char* ws = pk->ws; float* out = pk->out; bf16_t* WB = (bf16_t*)(ws + WS_W); float* ssb = (float*)(ws + WS_SS);
            pg8::Gemm g{(bf16_t*)(ws + WS_XB), WB + wmat_off(layer, 0), MT, 1536, 1024}; pg8::StaticOrder S; S.init(MT, 1536, G, bx);
            EpiQKV E{ssb + (size_t)((2 * layer) % 3) * SS_SLOT, (bf16_t*)(ws + WS_POOL), (bf16_t*)(ws + WS_POOL + 2 * ACT), (bf16_t*)(ws + WS_POOL + 2 * ACT) + (size_t)MT * 256, (const float*)(ws + WS_ROPE),
                     out + OKP + (size_t)j * 4 * 128 * 256, out + OVP + (size_t)j * 4 * 128 * 256, out + OKS + (size_t)j * 8 * 128 * 256, out + OVS + (size_t)j * 8 * 128 * 256};
            pg8::gemm_phase<EpiQKV, pg8::StaticOrder, true, true>((PG8_LAS unsigned char*)lds, g, S, E);
        } else if (kind == 2) { if (!(SKIPMASK & 4)) attn_phase(pk, (char*)lds, j, vcu, G); }
        else if ((kind == 3 || kind == 5) && !(SKIPMASK & 8)) {
            unsigned char* ws = pk->ws; bf16_t* WB = (bf16_t*)(ws + WS_W); float* ssb = (float*)(ws + WS_SS);
            const bool dn = kind == 5; const int K = dn ? 4096 : 1024;
            const bf16_t* A = dn ? (const bf16_t*)(ws + WS_POOL) : ((layer & 1) ? (const bf16_t*)(ws + WS_POOL) : (const bf16_t*)(ws + WS_POOL + ACT));
            pg8::Gemm g{A, WB + wmat_off(layer, dn ? 3 : 1), MT, 1024, K}; pg8::StaticOrder S; S.init(MT, 1024, G, bx);
            EpiRes E{pk->out + OY, (bf16_t*)(ws + WS_XB), ssb + (size_t)((2 * layer + (dn ? 2 : 1)) % 3) * SS_SLOT};
            pg8::gemm_phase<EpiRes, pg8::StaticOrder, true, true>((PG8_LAS unsigned char*)lds, g, S, E);
        } else if (kind == 4 && !(SKIPMASK & 16)) {
            unsigned char* ws = pk->ws; bf16_t* WB = (bf16_t*)(ws + WS_W); float* ssb = (float*)(ws + WS_SS);
            pg8::Gemm g{(bf16_t*)(ws + WS_XB), WB + wmat_off(layer, 2), MT, 4096, 1024}; pg8::StaticOrder S; S.init(MT, 4096, G, bx);
            EpiUp E{ssb + (size_t)((2 * layer + 1) % 3) * SS_SLOT, (bf16_t*)(ws + WS_POOL)};
            pg8::gemm_phase<EpiUp, pg8::StaticOrder, true, true>((PG8_LAS unsigned char*)lds, g, S, E);
        } else if (kind == 6 && !(SKIPMASK & 32)) {
            unsigned char* ws = pk->ws; bf16_t* WB = (bf16_t*)(ws + WS_W); float* ssb = (float*)(ws + WS_SS);
            pg8::Gemm g{(bf16_t*)(ws + WS_XB), WB + wmat_off(layer, 0), MT, 4096, 1024}; pg8::StaticOrder S; S.init(MT, 4096, G, bx);
            EpiHin E{ssb + (size_t)((2 * layer) % 3) * SS_SLOT, (u16*)(ws + WS_POOL)};
            pg8::gemm_phase<EpiHin, pg8::StaticOrder, true, true>((PG8_LAS unsigned char*)lds, g, S, E);
        } else if (kind == 7) { if (!(SKIPMASK & 64)) hgrn_passA(pk, (char*)lds, j, vcu, G); }
        else if (kind == 8) { if (!(SKIPMASK & 128)) hgrn_passB(pk, j, G); }
        else if (kind == 9) { if (!(SKIPMASK & 256)) hgrn_passC(pk, (char*)lds, j, vcu, G); }
        else if (kind == 10) { if (!(SKIPMASK & 512)) final_phase(pk, vcu, G); }
        if (ph + 1 < ph_hi) grid.sync();
    }
}

#ifndef MK_PER_PHASE
#define MK_PER_PHASE 0
#endif
extern "C" void kernel_launch(void* const* d_in, const int* in_sizes, int n_in, void* d_out, int out_size, void* d_ws, size_t ws_size, hipStream_t stream) {
    static int grid = 0;
    if (grid == 0) {
        int dev = 0, cus = 0, per_cu = 0;
        hipGetDevice(&dev); hipDeviceGetAttribute(&cus, hipDeviceAttributeMultiprocessorCount, dev);
        hipFuncSetAttribute((const void*)fwd_kernel, hipFuncAttributeMaxDynamicSharedMemorySize, LDS_BYTES);
        hipOccupancyMaxActiveBlocksPerMultiprocessor(&per_cu, (const void*)fwd_kernel, 512, LDS_BYTES);
        (void)hipGetLastError();
        if (per_cu < 1) { fprintf(stderr, "kernel_launch: occupancy query says %d blocks/CU\n", per_cu); per_cu = 1; }
        grid = cus;
        if (n_in != 17 || ws_size < WS_SS + 3 * SS_SLOT * 4) { fprintf(stderr, "kernel_launch: unexpected n_in %d / ws_size %zu (need %zu)\n", n_in, ws_size, (size_t)WS_END); }
    }
    Params p{};
    for (int i = 0; i < 17; ++i) p.in[i] = (const float*)d_in[i];
    p.out = (float*)d_out; p.ws = (unsigned char*)d_ws;
#if MK_PER_PHASE
    for (int ph = 0; ph < NPHASE; ++ph) { p.ph_lo = ph; p.ph_hi = ph + 1; hipLaunchKernelGGL(fwd_kernel, dim3(grid), dim3(512), LDS_BYTES, stream, p); }
#else
    p.ph_lo = 0; p.ph_hi = NPHASE;
    void* args[] = {&p};
    hipError_t e = hipLaunchCooperativeKernel((const void*)fwd_kernel, dim3(grid), dim3(512), args, LDS_BYTES, stream);
    if (e != hipSuccess) fprintf(stderr, "cooperative launch failed: %s (grid %d)\n", hipGetErrorString(e), grid);
#endif
}
```

```cpp
#include <hip/hip_runtime.h>
#include <hip/hip_cooperative_groups.h>
#include <cstdio>
#include <cstdint>
namespace cg = cooperative_groups;
namespace pg8 {
#define PG8_LAS __attribute__((address_space(3)))
typedef unsigned short bf16_t;
typedef short bf16x8 __attribute__((ext_vector_type(8)));
typedef float f32x4 __attribute__((ext_vector_type(4)));
typedef unsigned u32x4 __attribute__((ext_vector_type(4)));
constexpr int BM = 256, BK = 64, HALF = 128, HTB = HALF * BK * 2  , STAGE_BYTES = 8 * HTB, NXCD = 8, WGM = 8;

__host__ __device__ __forceinline__ int lds_byte(int r, int c) { const int st = (r >> 4) * 2 + (c >> 5), rr = r & 15, cc = c & 31, ob = rr * 64 + cc * 2; return st * 1024 + (ob ^ (((ob >> 9) & 1) << 5)); }
__host__ __device__ __forceinline__ void stage_rc(int b, int& R, int& C) { const int st = b / 1024, sb = b % 1024, swz = sb ^ (((sb >> 9) & 1) << 5); R = (st >> 1) * 16 + swz / 64; C = (st & 1) * 32 + (swz % 64) / 2; }
__host__ __device__ __forceinline__ int perm32(int rho) { const int n = rho >> 4, i = rho & 15; return 8 * (i >> 2) + 4 * n + (i & 3); }

struct Unit { int pm, pn; };
struct Gemm { const bf16_t* A; const bf16_t* Bt; int M, N, K; };

struct StaticOrder {
    int nM, nN, nwg, G, c;
    __host__ __device__ void init(int M, int N, int G_, int c_) { nM = M / BM; nN = N / BM; nwg = nM * nN; G = G_; c = c_; }
    __host__ __device__ bool next(int i, Unit& u) const {
        const long L = (long)i * G + c; if (L >= nwg) return false;
        int wgid = (int)L; { const int q = nwg / NXCD, r = nwg % NXCD, xcd = wgid % NXCD, off = wgid / NXCD; wgid = (xcd < r ? xcd * (q + 1) : r * (q + 1) + (xcd - r) * q) + off; }
        const int nig = WGM * nN, gid = wgid / nig, fm = gid * WGM, gsz = (nM - fm) < WGM ? (nM - fm) : WGM;
        u.pm = fm + ((wgid % nig) % gsz); u.pn = (wgid % nig) / gsz; return true;
    }
    __device__ __forceinline__ void a_ready(const Unit&) const {}
    __device__ __forceinline__ void done(const Unit&) const {}
};

__device__ __forceinline__ unsigned cvt_pk_bf16(float lo, float hi) { unsigned r; asm volatile("v_cvt_pk_bf16_f32 %0, %1, %2" : "=v"(r) : "v"(lo), "v"(hi)); return r; }
typedef float f32x2 __attribute__((ext_vector_type(2)));
template <class Epi, class Sched, bool ALIGN_EPI = false, bool SP2 = false>
__device__ __forceinline__ void gemm_phase(PG8_LAS unsigned char* lds, const Gemm g, const Sched& S, const Epi& E) {
    int tid_ = threadIdx.x; asm volatile("" : "+v"(tid_)); const int tid = tid_, wid = __builtin_amdgcn_readfirstlane(tid >> 6), lane = tid & 63, wr = wid >> 2, wc = wid & 3, fr = lane & 15, fq = lane >> 4;
    const int K = g.K, nt = K / BK;
    unsigned voffA[2], voffB[2];
#pragma unroll
    for (int i = 0; i < 2; ++i) { int R, C; stage_rc(tid * 16 + i * 8192, R, C); const int Rb = Epi::PERM ? ((R & ~31) + perm32(R & 31)) : R;
        voffA[i] = (unsigned)(R * K + C) * 2u; voffB[i] = (unsigned)(Rb * K + C) * 2u; }
    const size_t kstep = (size_t)(BK * 2);
    const size_t hstep = (size_t)HALF * K * 2;
    const size_t tstep = 2 * hstep;
    const unsigned ldsw = (unsigned)wid * 1024u;
    const int aoff = lds_byte(wr * 64 + fr, fq * 8), boff = lds_byte(wc * 32 + fr, fq * 8);
#define PG8_SA(b, h) (((b) * 2 + (h)) * HTB)
#define PG8_SB(b, h) ((4 + (b) * 2 + (h)) * HTB)
#define PG8_STAGE(bufoff, gbase, voff) do { _Pragma("unroll") for (int _i = 0; _i < 2; ++_i) \
        __builtin_amdgcn_global_load_lds((const unsigned*)((const char*)(gbase) + (voff)[_i]), (PG8_LAS unsigned*)(lds + (bufoff) + ldsw + _i * 8192), 16, 0, 0); } while (0)
#define PG8_LDA(dst, b, h) do { _Pragma("unroll") for (int m = 0; m < 4; ++m) _Pragma("unroll") for (int k = 0; k < 2; ++k) dst[m][k] = *(const PG8_LAS bf16x8*)(lds + PG8_SA(b, h) + aoff + m * 2048 + k * 1024); } while (0)
#define PG8_LDB(dst, b, h) do { _Pragma("unroll") for (int n = 0; n < 2; ++n) _Pragma("unroll") for (int k = 0; k < 2; ++k) dst[n][k] = *(const PG8_LAS bf16x8*)(lds + PG8_SB(b, h) + boff + n * 2048 + k * 1024); } while (0)
#define PG8_MMA(ai, bj, At, Bt) do { __builtin_amdgcn_s_setprio(1); _Pragma("unroll") for (int m = 0; m < 4; ++m) _Pragma("unroll") for (int n = 0; n < 2; ++n) _Pragma("unroll") for (int k = 0; k < 2; ++k) \
        acc[ai][bj][m][n] = __builtin_amdgcn_mfma_f32_16x16x32_bf16(Bt[n][k], At[m][k], acc[ai][bj][m][n], 0, 0, 0); __builtin_amdgcn_s_setprio(0); } while (0)
#define PG8_WAIT_V(n) asm volatile("s_waitcnt vmcnt(" #n ")" ::: "memory")
#define PG8_WAIT_L(n) asm volatile("s_waitcnt lgkmcnt(" #n ")" ::: "memory")
#define PG8_BAR __builtin_amdgcn_s_barrier()
#define PG8_SCHED __builtin_amdgcn_sched_barrier(0)
    Unit cur, nxt; int ui = 0;
    if (!S.next(0, cur)) return;
    f32x4 acc[2][2][4][2];
#pragma unroll
    for (int a = 0; a < 2; ++a)
#pragma unroll
        for (int b = 0; b < 2; ++b)
#pragma unroll
            for (int m = 0; m < 4; ++m)
#pragma unroll
                for (int n = 0; n < 2; ++n) acc[a][b][m][n] = (f32x4){0.f, 0.f, 0.f, 0.f};
    bf16x8 At[4][2], B0[2][2], B1[2][2];
    const char* cA = (const char*)g.A + (size_t)cur.pm * tstep; const char* cB = (const char*)g.Bt + (size_t)cur.pn * tstep;
    S.a_ready(cur);
    if constexpr (SP2) {
        PG8_STAGE(PG8_SB(0, 0), cB, voffB); PG8_STAGE(PG8_SB(0, 1), cB + hstep, voffB); PG8_STAGE(PG8_SA(0, 0), cA, voffA); PG8_STAGE(PG8_SA(0, 1), cA + hstep, voffA);
        if (wr == 1) PG8_BAR;
        PG8_WAIT_V(2); PG8_BAR;
        PG8_STAGE(PG8_SB(1, 0), cB + kstep, voffB); PG8_STAGE(PG8_SA(1, 0), cA + kstep, voffA); PG8_STAGE(PG8_SB(1, 1), cB + hstep + kstep, voffB);
        PG8_WAIT_V(6); PG8_BAR;
    } else {
        PG8_STAGE(PG8_SB(0, 0), cB, voffB); PG8_STAGE(PG8_SA(0, 0), cA, voffA); PG8_STAGE(PG8_SB(0, 1), cB + hstep, voffB); PG8_STAGE(PG8_SA(0, 1), cA + hstep, voffA);
        if (wr == 1) PG8_BAR;
        PG8_WAIT_V(4); PG8_BAR;
        PG8_STAGE(PG8_SB(1, 0), cB + kstep, voffB); PG8_STAGE(PG8_SA(1, 0), cA + kstep, voffA); PG8_STAGE(PG8_SB(1, 1), cB + hstep + kstep, voffB);
        PG8_WAIT_V(6); PG8_BAR;
    }
    for (;;) {
        const bool has_next = S.next(ui + 1, nxt);
        const char* nA = has_next ? (const char*)g.A + (size_t)nxt.pm * tstep : cA; const char* nB = has_next ? (const char*)g.Bt + (size_t)nxt.pn * tstep : cB;
        for (int t = 0; t < nt; t += 2) {
            const bool last = (t == nt - 2);
            const char* a1 = cA + (size_t)(t + 1) * kstep;
            const char* a2 = last ? nA : cA + (size_t)(t + 2) * kstep; const char* b2 = last ? nB : cB + (size_t)(t + 2) * kstep;
            const char* a3 = a2 + kstep; const char* b3 = b2 + kstep;
            if (last && has_next) S.a_ready(nxt);
            if constexpr (SP2) {
            PG8_LDB(B0, 0, 0); PG8_LDB(B1, 0, 1); PG8_SCHED; PG8_LDA(At, 0, 0); PG8_STAGE(PG8_SA(1, 1), a1 + hstep, voffA);
            PG8_WAIT_V(8); PG8_WAIT_L(0); PG8_BAR; PG8_MMA(0, 0, At, B0); PG8_MMA(0, 1, At, B1); PG8_BAR; PG8_SCHED;
            PG8_LDA(At, 0, 1); PG8_STAGE(PG8_SB(0, 0), b2, voffB); PG8_STAGE(PG8_SB(0, 1), b2 + hstep, voffB); PG8_STAGE(PG8_SA(0, 0), a2, voffA);
            PG8_WAIT_V(8); PG8_WAIT_L(0); PG8_BAR; PG8_MMA(1, 0, At, B0); PG8_MMA(1, 1, At, B1); PG8_BAR; PG8_SCHED;
            PG8_LDB(B0, 1, 0); PG8_LDB(B1, 1, 1); PG8_SCHED; PG8_LDA(At, 1, 0); PG8_STAGE(PG8_SA(0, 1), a2 + hstep, voffA);
            PG8_WAIT_V(8); PG8_WAIT_L(0); PG8_BAR; PG8_MMA(0, 0, At, B0); PG8_MMA(0, 1, At, B1); PG8_BAR; PG8_SCHED;
            PG8_LDA(At, 1, 1); PG8_STAGE(PG8_SB(1, 0), b3, voffB); PG8_STAGE(PG8_SB(1, 1), b3 + hstep, voffB); PG8_STAGE(PG8_SA(1, 0), a3, voffA);
            PG8_WAIT_V(8); PG8_WAIT_L(0); PG8_BAR; PG8_MMA(1, 0, At, B0); PG8_MMA(1, 1, At, B1); PG8_BAR; PG8_SCHED;
            } else {
            PG8_LDB(B0, 0, 0); PG8_SCHED; PG8_LDA(At, 0, 0); PG8_STAGE(PG8_SA(1, 1), a1 + hstep, voffA);
            PG8_WAIT_L(8); PG8_BAR; PG8_WAIT_L(0); PG8_MMA(0, 0, At, B0); PG8_BAR; PG8_SCHED;
            PG8_LDB(B1, 0, 1); PG8_STAGE(PG8_SB(0, 0), b2, voffB);
            PG8_BAR; PG8_WAIT_L(0); PG8_MMA(0, 1, At, B1); PG8_BAR;
            PG8_LDA(At, 0, 1); PG8_STAGE(PG8_SA(0, 0), a2, voffA);
            PG8_BAR; PG8_WAIT_L(0); PG8_MMA(1, 0, At, B0); PG8_BAR; PG8_SCHED;
            PG8_STAGE(PG8_SB(0, 1), b2 + hstep, voffB);
            PG8_WAIT_V(6); PG8_BAR; PG8_MMA(1, 1, At, B1); PG8_BAR;
            PG8_LDB(B0, 1, 0); PG8_SCHED; PG8_LDA(At, 1, 0); PG8_STAGE(PG8_SA(0, 1), a2 + hstep, voffA);
            PG8_WAIT_L(8); PG8_BAR; PG8_WAIT_L(0); PG8_MMA(0, 0, At, B0); PG8_BAR; PG8_SCHED;
            PG8_LDB(B1, 1, 1); PG8_STAGE(PG8_SB(1, 0), b3, voffB);
            PG8_BAR; PG8_WAIT_L(0); PG8_MMA(0, 1, At, B1); PG8_BAR;
            PG8_LDA(At, 1, 1); PG8_STAGE(PG8_SA(1, 0), a3, voffA);
            PG8_BAR; PG8_WAIT_L(0); PG8_MMA(1, 0, At, B0); PG8_BAR; PG8_SCHED;
            PG8_STAGE(PG8_SB(1, 1), b3 + hstep, voffB);
            PG8_WAIT_V(6); PG8_BAR; PG8_MMA(1, 1, At, B1); PG8_BAR;
            }
        }
        if constexpr (ALIGN_EPI) { if (wr == 0) PG8_BAR; }
        if constexpr (!Epi::AFTER_DRAIN) { E(acc, cur, wr, wc, fr, fq); S.done(cur); }
        if (!has_next) break;
#pragma unroll
        for (int a = 0; a < 2; ++a)
#pragma unroll
            for (int b = 0; b < 2; ++b)
#pragma unroll
                for (int m = 0; m < 4; ++m)
#pragma unroll
                    for (int n = 0; n < 2; ++n) acc[a][b][m][n] = (f32x4){0.f, 0.f, 0.f, 0.f};
        cur = nxt; cA = nA; cB = nB; ++ui;
        if constexpr (ALIGN_EPI) { if (wr == 1) PG8_BAR; }
    }
    PG8_WAIT_V(0);
    if constexpr (!ALIGN_EPI) { if (wr == 0) PG8_BAR; }
    PG8_BAR;
    if constexpr (Epi::AFTER_DRAIN) { E.fused(acc, cur, wr, wc, fr, fq, lds, wid, lane); S.done(cur); }
#undef PG8_SA
#undef PG8_SB
#undef PG8_STAGE
#undef PG8_LDA
#undef PG8_LDB
#undef PG8_MMA
#undef PG8_WAIT_V
#undef PG8_WAIT_L
#undef PG8_BAR
#undef PG8_SCHED
}
}
#define LAS __attribute__((address_space(3)))
#define XB_TMO      128
#define XB_XCNT(j)  (256  + 64 * (j))
#define XB_XSUB(j)  (1280 + 64 * (j))
#define XB_XGEN(j)  (2304 + 64 * (j))
#define XB_TOP      3328
#define XB_TOPGEN   3392
#define XCD_BAR_WORDS 3456
#define XB_SPIN_CAP (1u << 18)

__device__ __forceinline__ unsigned xb_ld(unsigned* p)              { return __hip_atomic_load(p, __ATOMIC_RELAXED, __HIP_MEMORY_SCOPE_AGENT); }
__device__ __forceinline__ unsigned xb_add(unsigned* p, unsigned v) { return __hip_atomic_fetch_add(p, v, __ATOMIC_RELAXED, __HIP_MEMORY_SCOPE_AGENT); }
__device__ __forceinline__ unsigned xb_xcc_id() { return (unsigned)__builtin_amdgcn_s_getreg((3 << 11) | 20) & 0xFu; }
#define XB_SPIN(cond, bar) do { unsigned _sp = 0; while (cond) { __builtin_amdgcn_s_sleep(1); \
    if ((++_sp & 255u) == 0u) { if (xb_ld(&(bar)[XB_TMO])) break; if (_sp > XB_SPIN_CAP) { atomicAdd(&(bar)[XB_TMO], 1u); break; } } } } while (0)

struct XcdBarrier {
    unsigned* bar; unsigned x;
    volatile LAS unsigned* st;
};

__device__ __forceinline__ XcdBarrier xcd_barrier_post(unsigned* bar, volatile LAS unsigned* st) {
    XcdBarrier b; b.bar = bar; b.x = xb_xcc_id(); b.st = st;
    if (threadIdx.x == 0) (void)xb_add(&bar[XB_XCNT(b.x)], 1u);
    return b;
}
__device__ __forceinline__ void xcd_barrier_complete(unsigned* bar, unsigned x, unsigned& nloc, unsigned& nx) {
    const unsigned G = gridDim.x * gridDim.y * gridDim.z;
    unsigned sum, cnt, mine, sp = 0u;
    for (;;) {
        sum = 0u; cnt = 0u; mine = 0u;
#pragma unroll
        for (unsigned j = 0; j < 16; ++j) { const unsigned c = xb_ld(&bar[XB_XCNT(j)]); sum += c; cnt += (c > 0u) ? 1u : 0u; mine = (j == x) ? c : mine; }
        if (sum == G) break;
        __builtin_amdgcn_s_sleep(1);
        if ((++sp & 255u) == 0u) { if (xb_ld(&bar[XB_TMO])) break; if (sp > XB_SPIN_CAP) { atomicAdd(&bar[XB_TMO], 1u); break; } }
    }
    nloc = mine > 0u ? mine : 1u; nx = cnt > 0u ? cnt : 1u;
}

__device__ __forceinline__ void xcd_barrier(const XcdBarrier& b) {
    asm volatile("s_waitcnt vmcnt(0)" ::: "memory");
    __syncthreads();
    if (threadIdx.x == 0) {
        unsigned* bar = b.bar;
        __builtin_amdgcn_s_waitcnt(0);
        unsigned nloc = b.st[0], nx = b.st[1];
        if (nloc == 0u) { xcd_barrier_complete(bar, b.x, nloc, nx); b.st[0] = nloc; b.st[1] = nx; }
        const unsigned old = xb_add(&bar[XB_XSUB(b.x)], 1u);
        const unsigned gen = old / nloc;
        if (old + 1u == (gen + 1u) * nloc) {
            __builtin_amdgcn_fence(__ATOMIC_RELEASE, "agent");
            asm volatile("s_waitcnt vmcnt(0)" ::: "memory");
            const unsigned og = xb_add(&bar[XB_TOP], 1u);
            const unsigned tg = og / nx;
            if (og + 1u == (tg + 1u) * nx) xb_add(&bar[XB_TOPGEN], 1u);
            else XB_SPIN(xb_ld(&bar[XB_TOPGEN]) == tg, bar);
            __builtin_amdgcn_fence(__ATOMIC_ACQUIRE, "agent");
            xb_add(&bar[XB_XGEN(b.x)], 1u);
            asm volatile("s_waitcnt vmcnt(0)" ::: "memory");
        } else {
            XB_SPIN(xb_ld(&bar[XB_XGEN(b.x)]) == gen, bar);
            __builtin_amdgcn_fence(__ATOMIC_ACQUIRE, "agent");
            asm volatile("s_waitcnt vmcnt(0)" ::: "memory");
        }
    }
    __syncthreads();
}

using pg8::bf16_t; using pg8::bf16x8; using pg8::f32x4; using pg8::u32x4; using pg8::Unit;
typedef unsigned u32x2 __attribute__((ext_vector_type(2)));
typedef unsigned short u16;
constexpr int DM = 1024, MP = 32768, MS = 512, MT = MP + MS, SEQ = 8192;
constexpr float EPS = 1e-5f, LOG2E = 1.4426950408889634f, C2 = 0.125f * 1.4426950408889634f;
constexpr size_t MiB = 1u << 20;
constexpr size_t WS_SS = 492 * MiB, SS_SLOT = (size_t)MT * 16;
constexpr size_t WS_CTL = 0, CTL_BYTES = 65536;
constexpr size_t WS_ROPE = 2 * MiB;
constexpr size_t WS_DB = 3 * MiB;
constexpr size_t WS_W = 6 * MiB;
constexpr size_t WS_XB = 100 * MiB;
constexpr size_t WS_UB = 100 * MiB;
constexpr size_t WS_POOL = 232 * MiB;
constexpr size_t ACT = (size_t)MT * DM * 2;
constexpr size_t WS_END = WS_POOL + 4 * ACT;
constexpr size_t OY = 0, OKP = 34078720, OVP = 34340864, OSP = 34603008, OKS = 35651584, OVS = 36175872, OSS = 36700160;
constexpr size_t WM = 1048576;
struct Params { const float* in[17]; float* out; unsigned char* ws; int ph_lo, ph_hi; };
typedef const __attribute__((address_space(4))) Params* KP;
__device__ __forceinline__ KP kargs() { KP k = (KP)__builtin_amdgcn_kernarg_segment_ptr(); asm volatile("" : "+s"(k)); return k; }

__device__ __forceinline__ unsigned pkbf(float lo, float hi) { typedef float f2 __attribute__((ext_vector_type(2))); typedef __bf16 b2 __attribute__((ext_vector_type(2))); f2 v = {lo, hi}; b2 b = __builtin_convertvector(v, b2); return __builtin_bit_cast(unsigned, b); }
__device__ __forceinline__ float bflo(unsigned u) { return __uint_as_float(u << 16); }
__device__ __forceinline__ float bfhi(unsigned u) { return __uint_as_float(u & 0xffff0000u); }
__device__ __forceinline__ float bf2f(u16 u) { return __uint_as_float((unsigned)u << 16); }
__device__ __forceinline__ u16 f2bf(float f) { return (u16)(pkbf(f, 0.f) & 0xffffu); }
__device__ __forceinline__ unsigned pkh(float lo, float hi) { _Float16 a = (_Float16)lo, b = (_Float16)hi; return (unsigned)__builtin_bit_cast(u16, a) | ((unsigned)__builtin_bit_cast(u16, b) << 16); }
__device__ __forceinline__ f32x4 mfma16(bf16x8 a, bf16x8 b, f32x4 c) { return __builtin_amdgcn_mfma_f32_16x16x32_bf16(a, b, c, 0, 0, 0); }
__device__ __forceinline__ int row_pos(int r) { return r < MP ? (r & (SEQ - 1)) : 2048 + ((r - MP) & 63); }
__device__ __forceinline__ float row_rs(const float* ss, int r) { const f32x4* q = (const f32x4*)(ss + (size_t)r * 16); f32x4 a = q[0], b = q[1], c = q[2], d = q[3]; a = (a + b) + (c + d); return rsqrtf(((a[0] + a[1]) + (a[2] + a[3])) * (1.f / 1024.f) + EPS); }
__device__ __forceinline__ float silu(float v) { return v / (1.f + __expf(-v)); }

struct EpiQKV {
    static constexpr bool PERM = true, AFTER_DRAIN = false;
    const float* ss; bf16_t* Q; bf16_t* K; bf16_t* V; const float* rope; float* nkp; float* nvp; float* nks; float* nvs;
    __device__ __forceinline__ void operator()(const f32x4 (&acc)[2][2][4][2], const Unit& u, int wr, int wc, int fr, int fq) const {
        const int pn = u.pn; const bool rot = (pn <= 4) && ((wc & 1) == 0); const float qs = pn < 4 ? C2 : 1.f;
#pragma unroll
        for (int ai = 0; ai < 2; ++ai)
#pragma unroll
            for (int m = 0; m < 4; ++m) {
                int rl = ai * 128 + wr * 64 + m * 16 + fr; asm volatile("" : "+v"(rl)); const int r = u.pm * 256 + rl;
                const float rs = row_rs(ss, r);
                f32x4 cs0 = {1.f, 1.f, 1.f, 1.f}, cs1 = cs0, sn0 = {0.f, 0.f, 0.f, 0.f}, sn1 = sn0;
                if (rot && fq < 2) { const float* t = rope + row_pos(r) * 16; cs0 = *(const f32x4*)t; cs1 = *(const f32x4*)(t + 4); sn0 = *(const f32x4*)(t + 8); sn1 = *(const f32x4*)(t + 12); }
                if (fq == 0) { sn0 = -sn0; sn1 = -sn1; }
                float* nk = nullptr;
                if (pn >= 4) {
                    if (u.pm < 128) { const int t = (u.pm & 31) * 256 + rl; if (t >= 8064) nk = (pn == 4 ? nkp : nvp) + ((size_t)(u.pm >> 5) * 128 + (t - 8064)) * 256; }
                    else { const int rr = r - MP; nk = (pn == 4 ? nks : nvs) + ((size_t)(rr >> 6) * 128 + 64 + (rr & 63)) * 256; }
                }
#pragma unroll
                for (int bj = 0; bj < 2; ++bj) {
                    f32x4 v0 = acc[ai][bj][m][0] * rs, v1 = acc[ai][bj][m][1] * rs;
                    if (rot) {
                        f32x4 p0, p1;
#pragma unroll
                        for (int e = 0; e < 4; ++e) { p0[e] = __shfl_xor(v0[e], 16); p1[e] = __shfl_xor(v1[e], 16); }
                        v0 = v0 * cs0 + p0 * sn0; v1 = v1 * cs1 + p1 * sn1;
                    }
                    v0 = v0 * qs; v1 = v1 * qs;
                    const int cw = bj * 128 + wc * 32 + 8 * fq;
                    bf16_t* dst = pn < 4 ? Q + (size_t)r * 1024 + pn * 256 + cw : (pn == 4 ? K : V) + (size_t)r * 256 + cw;
                    u32x4 w; w.x = pkbf(v0[0], v0[1]); w.y = pkbf(v0[2], v0[3]); w.z = pkbf(v1[0], v1[1]); w.w = pkbf(v1[2], v1[3]);
                    *(u32x4*)dst = w;
                    if (nk) { *(f32x4*)(nk + cw) = v0; *(f32x4*)(nk + cw + 4) = v1; }
                }
                asm volatile("" ::: "memory");
            }
    }
};
struct EpiRes {
    static constexpr bool PERM = false, AFTER_DRAIN = false;
    float* X; bf16_t* XB; float* ssn;
    __device__ __forceinline__ void operator()(const f32x4 (&acc)[2][2][4][2], const Unit& u, int wr, int wc, int fr, int fq) const {
        const int col0 = u.pn * 256 + wc * 32 + 4 * fq;
#pragma unroll
        for (int ai = 0; ai < 2; ++ai)
#pragma unroll
            for (int m = 0; m < 4; ++m) {
                int r = u.pm * 256 + ai * 128 + wr * 64 + m * 16 + fr; asm volatile("" : "+v"(r)); const size_t off = (size_t)r * 1024 + col0; float sq = 0.f;
#pragma unroll
                for (int bj = 0; bj < 2; ++bj)
#pragma unroll
                    for (int n = 0; n < 2; ++n) { const size_t c = off + bj * 128 + n * 16; const f32x4 x = *(const f32x4*)(X + c) + acc[ai][bj][m][n]; *(f32x4*)(X + c) = x;
                        sq += (x[0] * x[0] + x[1] * x[1]) + (x[2] * x[2] + x[3] * x[3]); u32x2 w; w.x = pkbf(x[0], x[1]); w.y = pkbf(x[2], x[3]); *(u32x2*)(XB + c) = w; }
                sq += __shfl_xor(sq, 16); sq += __shfl_xor(sq, 32);
                if (fq == 0) ssn[(size_t)r * 16 + u.pn * 4 + wc] = sq;
                asm volatile("" ::: "memory");
            }
    }
};
struct EpiUp {
    static constexpr bool PERM = true, AFTER_DRAIN = false;
    const float* ss; bf16_t* H;
    __device__ __forceinline__ void operator()(const f32x4 (&acc)[2][2][4][2], const Unit& u, int wr, int wc, int fr, int fq) const {
#pragma unroll
        for (int ai = 0; ai < 2; ++ai)
#pragma unroll
            for (int m = 0; m < 4; ++m) {
                int r = u.pm * 256 + ai * 128 + wr * 64 + m * 16 + fr; asm volatile("" : "+v"(r)); const float rs = row_rs(ss, r);
#pragma unroll
                for (int bj = 0; bj < 2; ++bj) {
                    f32x4 v0 = acc[ai][bj][m][0] * rs, v1 = acc[ai][bj][m][1] * rs;
#pragma unroll
                    for (int e = 0; e < 4; ++e) { const float a = fmaxf(v0[e], 0.f), b = fmaxf(v1[e], 0.f); v0[e] = a * a; v1[e] = b * b; }
                    u32x4 w; w.x = pkbf(v0[0], v0[1]); w.y = pkbf(v0[2], v0[3]); w.z = pkbf(v1[0], v1[1]); w.w = pkbf(v1[2], v1[3]);
                    *(u32x4*)(H + (size_t)r * 4096 + u.pn * 256 + bj * 128 + wc * 32 + 8 * fq) = w;
                }
                asm volatile("" ::: "memory");
            }
    }
};
struct EpiHin {
    static constexpr bool PERM = true, AFTER_DRAIN = false;
    const float* ss; u16* base;
    __device__ __forceinline__ void operator()(const f32x4 (&acc)[2][2][4][2], const Unit& u, int wr, int wc, int fr, int fq) const {
        const int sel = u.pn >> 2; u16* ob = base + (size_t)sel * (ACT / 2);
#pragma unroll
        for (int ai = 0; ai < 2; ++ai)
#pragma unroll
            for (int m = 0; m < 4; ++m) {
                int r = u.pm * 256 + ai * 128 + wr * 64 + m * 16 + fr; asm volatile("" : "+v"(r)); const float rs = row_rs(ss, r);
#pragma unroll
                for (int bj = 0; bj < 2; ++bj) {
                    f32x4 v0 = acc[ai][bj][m][0] * rs, v1 = acc[ai][bj][m][1] * rs; u32x4 w;
                    if (sel == 1) { w.x = pkh(v0[0], v0[1]); w.y = pkh(v0[2], v0[3]); w.z = pkh(v1[0], v1[1]); w.w = pkh(v1[2], v1[3]); }
                    else {
                        if (sel != 2) {
#pragma unroll
                            for (int e = 0; e < 4; ++e) { v0[e] = silu(v0[e]); v1[e] = silu(v1[e]); }
                        }
                        w.x = pkbf(v0[0], v0[1]); w.y = pkbf(v0[2], v0[3]); w.z = pkbf(v1[0], v1[1]); w.w = pkbf(v1[2], v1[3]);
                    }
                    *(u32x4*)(ob + (size_t)r * 1024 + (u.pn & 3) * 256 + bj * 128 + wc * 32 + 8 * fq) = w;
                }
                asm volatile("" ::: "memory");
            }
    }
};

__device__ __forceinline__ void p0_transpose_item(const float* W, const float* g, int K, int N, bf16_t* WT, float* scr, int item, int lane) {
    const int nblk = N / 32, kb = item / nblk, nb = item % nblk, k0 = 64 * kb, n0 = 32 * nb;
#pragma unroll 8
    for (int i = 0; i < 32; ++i) { const int kk = 2 * i + (lane >> 5); const float gs = g ? g[k0 + kk] : 1.f; scr[kk * 33 + (lane & 31)] = W[(size_t)(k0 + kk) * N + n0 + (lane & 31)] * gs; }
    asm volatile("s_waitcnt lgkmcnt(0)" ::: "memory");
    const int c = lane & 7;
#pragma unroll
    for (int jj = 0; jj < 4; ++jj) { const int n = (lane >> 3) + 8 * jj; const float* s = scr + (8 * c) * 33 + n;
        u32x4 o; o.x = pkbf(s[0 * 33], s[1 * 33]); o.y = pkbf(s[2 * 33], s[3 * 33]); o.z = pkbf(s[4 * 33], s[5 * 33]); o.w = pkbf(s[6 * 33], s[7 * 33]);
        *(u32x4*)(WT + (size_t)(n0 + n) * K + k0 + 8 * c) = o; }
    asm volatile("s_waitcnt lgkmcnt(0)" ::: "memory");
}
__device__ __forceinline__ size_t wlayer_base(int layer) { return layer == 0 ? 0 : layer == 1 ? (size_t)(10.5 * WM) : layer == 2 ? (size_t)(23.5 * WM) : (size_t)(34 * WM); }
__device__ __forceinline__ size_t wmat_off(int layer, int which) {
    const size_t b = wlayer_base(layer);
    if (layer & 1) return b + (which == 0 ? 0 : which == 1 ? 4 * WM : which == 2 ? 5 * WM : 9 * WM);
    return b + (which == 0 ? 0 : which == 1 ? (size_t)(1.5 * WM) : which == 2 ? (size_t)(2.5 * WM) : (size_t)(6.5 * WM));
}
__device__ __forceinline__ void prologue(KP pk, char* lds, int vcu, int G) {
    int tid_ = threadIdx.x; asm volatile("" : "+v"(tid_)); const int tid = tid_, lane = tid & 63, w = __builtin_amdgcn_readfirstlane(tid >> 6);
    const int gw = vcu * 8 + w, NGW = G * 8, gt = vcu * 512 + tid, NTH = G * 512;
    float* scr = (float*)(lds + w * 16384);
    bf16_t* WB = (bf16_t*)(pk->ws + WS_W);
    for (int it = gw; it < 24064; it += NGW) {
        int layer, r;
        if (it < 5376) { layer = 0; r = it; } else if (it < 12032) { layer = 1; r = it - 5376; } else if (it < 17408) { layer = 2; r = it - 12032; } else { layer = 3; r = it - 17408; }
        const int j = layer >> 1; const int n0 = (layer & 1) ? 2048 : 768; int which;
        if (r < n0) which = 0; else if (r < n0 + 512) { which = 1; r -= n0; } else if (r < n0 + 2560) { which = 2; r -= n0 + 512; } else { which = 3; r -= n0 + 2560; }
        const float* W; const float* g = nullptr; int K = 1024, N = 1024;
        if (which == 0) { g = pk->in[5] + layer * 1024; if (layer & 1) { W = pk->in[10] + (size_t)j * 4 * WM; N = 4096; } else { W = pk->in[7] + (size_t)j * 1536 * 1024; N = 1536; } }
        else if (which == 1) { W = ((layer & 1) ? pk->in[13] : pk->in[8]) + (size_t)j * WM; }
        else if (which == 2) { W = pk->in[14] + (size_t)layer * 4 * WM; g = pk->in[6] + layer * 1024; N = 4096; }
        else { W = pk->in[15] + (size_t)layer * 4 * WM; K = 4096; }
        p0_transpose_item(W, g, K, N, WB + wmat_off(layer, which), scr, r, lane);
    }
    float* X = pk->out + OY; bf16_t* XB = (bf16_t*)(pk->ws + WS_XB); float* ss0 = (float*)(pk->ws + WS_SS);
    for (int r = gw; r < MT; r += NGW) {
        const float* src = r < MP ? pk->in[0] + (size_t)r * 1024 : pk->in[1] + (size_t)(r - MP) * 1024; float s = 0.f;
#pragma unroll
        for (int q = 0; q < 4; ++q) { const f32x4 v = *(const f32x4*)(src + 256 * q + 4 * lane); *(f32x4*)(X + (size_t)r * 1024 + 256 * q + 4 * lane) = v;
            u32x2 o; o.x = pkbf(v[0], v[1]); o.y = pkbf(v[2], v[3]); *(u32x2*)(XB + (size_t)r * 1024 + 256 * q + 4 * lane) = o; s += (v[0] * v[0] + v[1] * v[1]) + (v[2] * v[2] + v[3] * v[3]); }
#pragma unroll
        for (int o = 1; o < 64; o <<= 1) s += __shfl_xor(s, o);
        if (lane < 16) ss0[(size_t)r * 16 + lane] = lane == 0 ? s : 0.f;
    }
    float* rope = (float*)(pk->ws + WS_ROPE);
    for (int e = gt; e < 65536; e += NTH) { const int pos = e >> 3, i = e & 7; const float inv = exp2f(-(float)i * 2.3664460711655217f); const float ang = (float)pos * inv;
        const double rev = (double)ang * 0.15915494309189535; const float fr = (float)(rev - __builtin_rint(rev));
        rope[pos * 16 + i] = __builtin_amdgcn_cosf(fr); rope[pos * 16 + 8 + i] = __builtin_amdgcn_sinf(fr); }
    for (int e = gt; e < 65536; e += NTH) { const int jj = e >> 15, rem = e & 32767, sb = rem >> 12, row = (rem >> 6) & 63, c4 = rem & 63;
        const size_t so = ((size_t)((jj * 8 + sb) * 128 + 64 + row)) * 256 + 4 * c4, dof = ((size_t)((jj * 8 + sb) * 128 + row)) * 256 + 4 * c4;
        *(f32x4*)(pk->out + OKS + dof) = *(const f32x4*)(pk->in[2] + so); *(f32x4*)(pk->out + OVS + dof) = *(const f32x4*)(pk->in[3] + so); }
}

__device__ __forceinline__ void attn_phase(KP pk, char* lds, int j, int vcu, int G) {
    int tid_ = threadIdx.x; asm volatile("" : "+v"(tid_)); const int tid = tid_, lane = tid & 63, w = __builtin_amdgcn_readfirstlane(tid >> 6), l15 = lane & 15, q4 = lane >> 4;
    bf16_t* Ks = (bf16_t*)lds; bf16_t* Vt = (bf16_t*)(lds + 27648);
    const bf16_t* Qb = (const bf16_t*)(pk->ws + WS_POOL); bf16_t* Ob = (bf16_t*)(pk->ws + WS_POOL + ACT);
    const bf16_t* Kb = (const bf16_t*)(pk->ws + WS_POOL + 2 * ACT); const bf16_t* Vb = Kb + (size_t)MT * 256;
    const float* ck = pk->in[2] + (size_t)j * 8 * 128 * 256; const float* cv = pk->in[3] + (size_t)j * 8 * 128 * 256; const float* sinks = pk->in[9] + j * 16;
    for (int unit = vcu; unit < 2080; unit += G) {
        int qrow0, kvh, kt0, sb = -1;
        if (unit < 2048) { const int b = unit >> 9, c = (unit >> 2) & 127; kvh = unit & 3; qrow0 = b * 8192 + c * 64; kt0 = c >= 2 ? 0 : (c == 1 ? 4 : 8); }
        else { const int u2 = unit - 2048; sb = u2 >> 2; kvh = u2 & 3; qrow0 = MP + sb * 64; kt0 = 0; }
        __syncthreads();
#pragma unroll
        for (int i = 0; i < 3; ++i) { const int ch = tid + 512 * i, key = ch >> 3, dc = ch & 7; u32x4 kv = {0u, 0u, 0u, 0u}, vv = kv;
            if (key >= 16 * kt0) {
                if (sb >= 0 && key < 128) { const size_t so = ((size_t)(sb * 128 + key) * 4 + kvh) * 64 + 8 * dc;
                    const f32x4 a = *(const f32x4*)(ck + so), b = *(const f32x4*)(ck + so + 4), c = *(const f32x4*)(cv + so), d = *(const f32x4*)(cv + so + 4);
                    kv.x = pkbf(a[0], a[1]); kv.y = pkbf(a[2], a[3]); kv.z = pkbf(b[0], b[1]); kv.w = pkbf(b[2], b[3]);
                    vv.x = pkbf(c[0], c[1]); vv.y = pkbf(c[2], c[3]); vv.z = pkbf(d[0], d[1]); vv.w = pkbf(d[2], d[3]); }
                else { const size_t so = (size_t)(qrow0 - 128 + key) * 256 + kvh * 64 + 8 * dc; kv = *(const u32x4*)(Kb + so); vv = *(const u32x4*)(Vb + so); }
            }
            *(u32x4*)(Ks + key * 72 + 8 * dc) = kv;
#pragma unroll
            for (int e = 0; e < 8; ++e) Vt[(8 * dc + e) * 200 + key] = (u16)(vv[e >> 1] >> (16 * (e & 1)));
        }
        __syncthreads();
#pragma unroll 1
        for (int qt = 0; qt < 2; ++qt) {
            const int qi = 2 * w + qt, g = qi >> 2, t0 = 16 * (qi & 3), head = kvh * 4 + g;
            const bf16_t* qp = Qb + (size_t)(qrow0 + t0 + l15) * 1024 + head * 64 + 8 * q4;
            const bf16x8 qf0 = *(const bf16x8*)qp, qf1 = *(const bf16x8*)(qp + 32);
            f32x4 s[12]; const float sink2 = sinks[head] * LOG2E; float mx = sink2;
#pragma unroll
            for (int kt = 0; kt < 12; ++kt) { const bf16_t* kp = Ks + (16 * kt + l15) * 72 + 8 * q4;
                f32x4 a = {0.f, 0.f, 0.f, 0.f}; a = mfma16(*(const bf16x8*)kp, qf0, a); a = mfma16(*(const bf16x8*)(kp + 32), qf1, a);
                if (kt < kt0) a = (f32x4){-INFINITY, -INFINITY, -INFINITY, -INFINITY};
                s[kt] = a; mx = fmaxf(fmaxf(mx, fmaxf(a[0], a[1])), fmaxf(a[2], a[3])); asm volatile("" ::: "memory"); }
            mx = fmaxf(mx, __shfl_xor(mx, 16)); mx = fmaxf(mx, __shfl_xor(mx, 32));
            float ls = 0.f;
#pragma unroll
            for (int kt = 0; kt < 12; ++kt)
#pragma unroll
                for (int e = 0; e < 4; ++e) { const float pe = __builtin_amdgcn_exp2f(s[kt][e] - mx); s[kt][e] = pe; ls += pe; }
            ls += __shfl_xor(ls, 16); ls += __shfl_xor(ls, 32); ls += __builtin_amdgcn_exp2f(sink2 - mx);
            const float rl = 1.f / ls;
            f32x4 o[4];
#pragma unroll
            for (int dt = 0; dt < 4; ++dt) o[dt] = (f32x4){0.f, 0.f, 0.f, 0.f};
#pragma unroll
            for (int kp = 0; kp < 6; ++kp) { u32x4 pw; pw.x = pkbf(s[2 * kp][0], s[2 * kp][1]); pw.y = pkbf(s[2 * kp][2], s[2 * kp][3]); pw.z = pkbf(s[2 * kp + 1][0], s[2 * kp + 1][1]); pw.w = pkbf(s[2 * kp + 1][2], s[2 * kp + 1][3]);
                const bf16x8 pf = __builtin_bit_cast(bf16x8, pw);
#pragma unroll
                for (int dt = 0; dt < 4; ++dt) { const bf16_t* vp = Vt + (16 * dt + l15) * 200 + 32 * kp + 4 * q4; const u32x2 lo = *(const u32x2*)vp, hi = *(const u32x2*)(vp + 16);
                    u32x4 aw; aw.x = lo.x; aw.y = lo.y; aw.z = hi.x; aw.w = hi.y; o[dt] = mfma16(__builtin_bit_cast(bf16x8, aw), pf, o[dt]); } asm volatile("" ::: "memory"); }
            bf16_t* op = Ob + (size_t)(qrow0 + t0 + l15) * 1024 + head * 64 + 4 * q4;
#pragma unroll
            for (int dt = 0; dt < 4; ++dt) { u32x2 ow; ow.x = pkbf(o[dt][0] * rl, o[dt][1] * rl); ow.y = pkbf(o[dt][2] * rl, o[dt][3] * rl); *(u32x2*)(op + 16 * dt) = ow; }
        }
    }
}

__device__ __forceinline__ void hgrn_item(int it, int& m0, int& h) { if (it < 4096) { h = it & 7; m0 = (it >> 10) * 8192 + ((it >> 3) & 127) * 64; } else { const int x = it - 4096; h = x & 7; m0 = MP + (x >> 3) * 64; } }
constexpr int HL_ZS = 0, HL_TOT = 16384, HL_KT = 18432, HL_VT = 36864, HL_QS = 55296, HL_KS = 72704, HL_ST = 90112, HL_SSQ = 124928;

#define HGRN_COMMON() \
    __syncthreads(); \
    _Pragma("unroll") for (int i = 0; i < 2; ++i) { const int ch = tid + 512 * i, row = ch >> 4, cc = ch & 15; const size_t go = (size_t)(m0 + row) * 1024 + h * 128 + 8 * cc; \
        *(u32x4*)(ZS + row * 128 + 8 * cc) = *(const u32x4*)(ZF + go); const u32x4 vv = *(const u32x4*)(VH + go); \
        _Pragma("unroll") for (int e = 0; e < 8; ++e) VT[(8 * cc + e) * 72 + row] = (u16)(vv[e >> 1] >> (16 * (e & 1))); } \
    __syncthreads(); \
    float lbv = 0.f; if (j == 1) { const float a = pk->in[11][h * 128 + k], b = pk->in[11][1024 + h * 128 + k]; lbv = 1.f / (1.f + __expf(a - b)); } \
    const float oml = 1.f - lbv; float kk[16], bl[16]; float cum = 0.f; \
    _Pragma("unroll") for (int i = 0; i < 16; ++i) { const float z = (float)ZS[(16 * seg + i) * 128 + k]; const float ez = __expf(-z), sg = 1.f / (1.f + ez); cum += __logf(lbv + oml * sg); bl[i] = cum; kk[i] = oml * ez * sg; } \
    TOT[seg * 128 + k] = cum; \
    __syncthreads(); \
    const float t0_ = TOT[k], t1_ = TOT[128 + k], t2_ = TOT[256 + k], t3_ = TOT[384 + k]; \
    const float off = seg == 0 ? 0.f : seg == 1 ? t0_ : seg == 2 ? t0_ + t1_ : t0_ + t1_ + t2_; const float b31 = t0_ + t1_;

__device__ __forceinline__ void hgrn_passA(KP pk, char* lds, int j, int vcu, int G) {
    int tid_ = threadIdx.x; asm volatile("" : "+v"(tid_)); const int tid = tid_, lane = tid & 63, w = __builtin_amdgcn_readfirstlane(tid >> 6), l15 = lane & 15, q4 = lane >> 4, k = tid & 127, seg = tid >> 7;
    _Float16* ZS = (_Float16*)(lds + HL_ZS); float* TOT = (float*)(lds + HL_TOT); bf16_t* KT = (bf16_t*)(lds + HL_KT); bf16_t* VT = (bf16_t*)(lds + HL_VT);
    const u16* ZF = (const u16*)(pk->ws + WS_POOL + ACT); const u16* VH = (const u16*)(pk->ws + WS_POOL + 2 * ACT);
    bf16_t* UB = (bf16_t*)(pk->ws + WS_UB); float* DB = (float*)(pk->ws + WS_DB);
    for (int it = vcu; it < 4160; it += G) {
        int m0, h; hgrn_item(it, m0, h);
        HGRN_COMMON()
        { u32x4 w0, w1; unsigned wk[8];
#pragma unroll
          for (int i = 0; i < 8; ++i) wk[i] = pkbf(kk[2 * i] * __expf(b31 - (off + bl[2 * i])), kk[2 * i + 1] * __expf(b31 - (off + bl[2 * i + 1])));
          w0.x = wk[0]; w0.y = wk[1]; w0.z = wk[2]; w0.w = wk[3]; w1.x = wk[4]; w1.y = wk[5]; w1.z = wk[6]; w1.w = wk[7];
          *(u32x4*)(KT + k * 72 + 16 * seg) = w0; *(u32x4*)(KT + k * 72 + 16 * seg + 8) = w1; }
        if (seg == 0) DB[(size_t)it * 128 + k] = __expf(b31 + t2_ + t3_);
        __syncthreads();
        const int kr = 16 * w + l15;
        const bf16x8 b0 = *(const bf16x8*)(KT + kr * 72 + 8 * q4), b1 = *(const bf16x8*)(KT + kr * 72 + 32 + 8 * q4);
        const float sc = __expf(TOT[256 + kr] + TOT[384 + kr]);
        bf16_t* up = UB + (size_t)it * 16384 + kr * 128 + 4 * q4;
#pragma unroll
        for (int vt = 0; vt < 8; ++vt) { const bf16_t* vp = VT + (16 * vt + l15) * 72 + 8 * q4; f32x4 a = {0.f, 0.f, 0.f, 0.f};
            a = mfma16(*(const bf16x8*)vp, b0, a); a = mfma16(*(const bf16x8*)(vp + 32), b1, a);
            u32x2 ow; ow.x = pkbf(a[0] * sc, a[1] * sc); ow.y = pkbf(a[2] * sc, a[3] * sc); *(u32x2*)(up + 16 * vt) = ow; }
    }
}
__device__ __forceinline__ void hgrn_passB(KP pk, int j, int G) {
    int tid_ = threadIdx.x; asm volatile("" : "+v"(tid_)); const int gt = blockIdx.x * 512 + tid_, NTH = G * 512;
    bf16_t* UB = (bf16_t*)(pk->ws + WS_UB); const float* DB = (const float*)(pk->ws + WS_DB);
    for (int e = gt; e < 131072; e += NTH) {
        const int bh = e >> 12, k = (e >> 5) & 127, v4 = e & 31, b = bh >> 3, h = bh & 7;
        f32x4 S = {0.f, 0.f, 0.f, 0.f};
        bf16_t* ub = UB + (size_t)(b * 1024 + h) * 16384 + k * 128 + 4 * v4; const float* db = DB + (size_t)(b * 1024 + h) * 128 + k;
#pragma unroll 1
        for (int c0 = 0; c0 < 128; c0 += 8) {
            u32x2 uu[8]; float d[8];
#pragma unroll
            for (int i = 0; i < 8; ++i) { uu[i] = *(const u32x2*)(ub + (size_t)(c0 + i) * 8 * 16384); d[i] = db[(size_t)(c0 + i) * 1024]; }
#pragma unroll
            for (int i = 0; i < 8; ++i) { u32x2 sw; sw.x = pkbf(S[0], S[1]); sw.y = pkbf(S[2], S[3]); *(u32x2*)(ub + (size_t)(c0 + i) * 8 * 16384) = sw;
                S[0] = d[i] * S[0] + bflo(uu[i].x); S[1] = d[i] * S[1] + bfhi(uu[i].x); S[2] = d[i] * S[2] + bflo(uu[i].y); S[3] = d[i] * S[3] + bfhi(uu[i].y); }
        }
        *(f32x4*)(pk->out + OSP + (size_t)(j * 32 + bh) * 16384 + k * 128 + 4 * v4) = S;
    }
    for (int e = gt; e < 262144; e += NTH) {
        const int sbh = e >> 12, k = (e >> 5) & 127, v4 = e & 31, it = 4096 + sbh; const size_t eo = (size_t)k * 128 + 4 * v4;
        const f32x4 S0 = *(const f32x4*)(pk->in[4] + (size_t)(j * 64 + sbh) * 16384 + eo);
        bf16_t* ub = UB + (size_t)it * 16384 + eo; const u32x2 uu = *(const u32x2*)ub; const float d = DB[(size_t)it * 128 + k];
        u32x2 sw; sw.x = pkbf(S0[0], S0[1]); sw.y = pkbf(S0[2], S0[3]); *(u32x2*)ub = sw;
        f32x4 S; S[0] = d * S0[0] + bflo(uu.x); S[1] = d * S0[1] + bfhi(uu.x); S[2] = d * S0[2] + bflo(uu.y); S[3] = d * S0[3] + bfhi(uu.y);
        *(f32x4*)(pk->out + OSS + (size_t)(j * 64 + sbh) * 16384 + eo) = S;
    }
}
__device__ __forceinline__ void hgrn_passC(KP pk, char* lds, int j, int vcu, int G) {
    int tid_ = threadIdx.x; asm volatile("" : "+v"(tid_)); const int tid = tid_, lane = tid & 63, w = __builtin_amdgcn_readfirstlane(tid >> 6), l15 = lane & 15, q4 = lane >> 4, k = tid & 127, seg = tid >> 7;
    _Float16* ZS = (_Float16*)(lds + HL_ZS); float* TOT = (float*)(lds + HL_TOT); bf16_t* VT = (bf16_t*)(lds + HL_VT);
    bf16_t* QS = (bf16_t*)(lds + HL_QS); bf16_t* KS = (bf16_t*)(lds + HL_KS); bf16_t* ST = (bf16_t*)(lds + HL_ST); float* SSQ = (float*)(lds + HL_SSQ);
    u16* QH = (u16*)(pk->ws + WS_POOL); const u16* ZF = (const u16*)(pk->ws + WS_POOL + ACT); const u16* VH = (const u16*)(pk->ws + WS_POOL + 2 * ACT); const u16* GH = (const u16*)(pk->ws + WS_POOL + 3 * ACT);
    const bf16_t* UB = (const bf16_t*)(pk->ws + WS_UB); const float* onorm = pk->in[12] + j * 128;
    for (int it = vcu; it < 4160; it += G) {
        int m0, h; hgrn_item(it, m0, h);
        float qv[16];
#pragma unroll
        for (int i = 0; i < 16; ++i) qv[i] = bf2f(QH[(size_t)(m0 + 16 * seg + i) * 1024 + h * 128 + k]);
        HGRN_COMMON()
#pragma unroll
        for (int i = 0; i < 16; ++i) { const float bt = off + bl[i]; KS[(16 * seg + i) * 136 + k] = f2bf(kk[i] * __expf(b31 - bt)); QS[(16 * seg + i) * 136 + k] = f2bf(qv[i] * __expf(bt - b31)); }
#pragma unroll
        for (int i = 0; i < 4; ++i) { const int ch = tid + 512 * i, kr = ch >> 4, vc = ch & 15; const float sc = __expf(TOT[kr] + TOT[128 + kr]);
            const u32x4 sv = *(const u32x4*)(UB + (size_t)it * 16384 + kr * 128 + 8 * vc);
#pragma unroll
            for (int e = 0; e < 8; ++e) { const unsigned wv = sv[e >> 1]; const float f = (e & 1) ? bfhi(wv) : bflo(wv); ST[(8 * vc + e) * 136 + kr] = f2bf(f * sc); } }
        __syncthreads();
        const int tt = w & 3, vh = w >> 2;
        bf16x8 qf[4];
#pragma unroll
        for (int ks = 0; ks < 4; ++ks) qf[ks] = *(const bf16x8*)(QS + (16 * tt + l15) * 136 + 32 * ks + 8 * q4);
        f32x4 sc4[4];
#pragma unroll
        for (int st = 0; st < 4; ++st) { f32x4 a = {0.f, 0.f, 0.f, 0.f};
            if (st <= tt) {
#pragma unroll
                for (int ks = 0; ks < 4; ++ks) a = mfma16(*(const bf16x8*)(KS + (16 * st + l15) * 136 + 32 * ks + 8 * q4), qf[ks], a);
                if (st == tt) {
#pragma unroll
                    for (int r = 0; r < 4; ++r) if (4 * q4 + r > l15) a[r] = 0.f;
                }
            }
            sc4[st] = a; }
        f32x4 o[4];
#pragma unroll
        for (int vi = 0; vi < 4; ++vi) { const int vt = 4 * vh + vi; f32x4 a = {0.f, 0.f, 0.f, 0.f};
#pragma unroll
            for (int kp = 0; kp < 2; ++kp) if (2 * kp <= tt) {
                u32x4 pw; pw.x = pkbf(sc4[2 * kp][0], sc4[2 * kp][1]); pw.y = pkbf(sc4[2 * kp][2], sc4[2 * kp][3]); pw.z = pkbf(sc4[2 * kp + 1][0], sc4[2 * kp + 1][1]); pw.w = pkbf(sc4[2 * kp + 1][2], sc4[2 * kp + 1][3]);
                const bf16_t* vp = VT + (16 * vt + l15) * 72 + 32 * kp + 4 * q4; const u32x2 lo = *(const u32x2*)vp, hi = *(const u32x2*)(vp + 16);
                u32x4 aw; aw.x = lo.x; aw.y = lo.y; aw.z = hi.x; aw.w = hi.y; a = mfma16(__builtin_bit_cast(bf16x8, aw), __builtin_bit_cast(bf16x8, pw), a); }
#pragma unroll
            for (int ks = 0; ks < 4; ++ks) a = mfma16(*(const bf16x8*)(ST + (16 * vt + l15) * 136 + 32 * ks + 8 * q4), qf[ks], a);
            o[vi] = a; }
        float sq = 0.f;
#pragma unroll
        for (int vi = 0; vi < 4; ++vi) sq += (o[vi][0] * o[vi][0] + o[vi][1] * o[vi][1]) + (o[vi][2] * o[vi][2] + o[vi][3] * o[vi][3]);
        sq += __shfl_xor(sq, 16); sq += __shfl_xor(sq, 32);
        if (q4 == 0) SSQ[vh * 64 + 16 * tt + l15] = sq;
        __syncthreads();
        const float rn = rsqrtf((SSQ[16 * tt + l15] + SSQ[64 + 16 * tt + l15]) * (1.f / 128.f) + EPS);
#pragma unroll
        for (int vi = 0; vi < 4; ++vi) { const int v0 = 16 * (4 * vh + vi) + 4 * q4; const f32x4 gn = *(const f32x4*)(onorm + v0); const size_t go = (size_t)(m0 + 16 * tt + l15) * 1024 + h * 128 + v0;
            const u32x2 gg = *(const u32x2*)(GH + go); u32x2 ow;
            ow.x = pkbf(o[vi][0] * rn * gn[0] * bflo(gg.x), o[vi][1] * rn * gn[1] * bfhi(gg.x)); ow.y = pkbf(o[vi][2] * rn * gn[2] * bflo(gg.y), o[vi][3] * rn * gn[3] * bfhi(gg.y));
            *(u32x2*)(QH + go) = ow; }
    }
}
__device__ __forceinline__ void final_phase(KP pk, int vcu, int G) {
    int tid_ = threadIdx.x; asm volatile("" : "+v"(tid_)); const int tid = tid_, lane = tid & 63, w = tid >> 6; const int gw = vcu * 8 + w, NGW = G * 8;
    float* X = pk->out + OY; const float* ss = (const float*)(pk->ws + WS_SS) + (size_t)(8 % 3) * SS_SLOT; const float* fn = pk->in[16];
    for (int r = gw; r < MT; r += NGW) { const float rs = row_rs(ss, r);
#pragma unroll
        for (int q = 0; q < 4; ++q) { float* xp = X + (size_t)r * 1024 + 256 * q + 4 * lane; const f32x4 g = *(const f32x4*)(fn + 256 * q + 4 * lane); *(f32x4*)xp = *(const f32x4*)xp * rs * g; } }
}

constexpr int LDS_BYTES = 147456;
constexpr int NPHASE = 26;
#ifndef SKIPMASK
#define SKIPMASK 0
#endif
#ifndef PROBE_KIND
#define PROBE_KIND -1
#endif
#ifndef PROBE_REP
#define PROBE_REP 1
#endif
__global__ void __launch_bounds__(512, 2) fwd_kernel(Params p_unused) {
    extern __shared__ __attribute__((aligned(16))) unsigned char lds[];
    cg::grid_group grid = cg::this_grid();
    const int G = gridDim.x, bx = blockIdx.x; const int vcu = (G % 8 == 0) ? (bx % 8) * (G / 8) + bx / 8 : bx;
    volatile LAS unsigned* misc = (volatile LAS unsigned*)((LAS unsigned char*)lds + 131072 + 320);
    if (threadIdx.x < 64) misc[threadIdx.x] = 0u;
    __syncthreads();
    int ph, ph_hi; XcdBarrier bar; { KP k0 = kargs(); ph = k0->ph_lo; ph_hi = k0->ph_hi; bar = xcd_barrier_post((unsigned*)(k0->ws + WS_CTL) + 4096, misc + 8); }
    for (; ph < ph_hi; ++ph) {
        int layer = 0, kind;
        if (ph == 0) kind = 0; else if (ph == NPHASE - 1) kind = 10;
        else { int q = ph - 1; if (q < 5) { layer = 0; kind = 1 + q; } else if (q < 12) { layer = 1; q -= 5; kind = q < 4 ? 6 + q : q - 1; } else if (q < 17) { layer = 2; kind = 1 + (q - 12); } else { layer = 3; q -= 17; kind = q < 4 ? 6 + q : q - 1; } }
        const int j = layer >> 1;
        int nrep = 1; if (kind == PROBE_KIND) nrep = PROBE_REP;
        for (int rep = 0; rep < nrep; ++rep) {
        if (rep) xcd_barrier(bar);
        KP pk = kargs();
        if (kind == 0) { if (!(SKIPMASK & 1)) prologue(pk, (char*)lds, vcu, G); }
        else if (kind == 1 && !(SKIPMASK & 2)) {
            unsigned char* ws = pk->ws; float* out = pk->out; bf16_t* WB = (bf16_t*)(ws + WS_W); float* ssb = (float*)(ws + WS_SS);
            pg8::Gemm g{(bf16_t*)(ws + WS_XB), WB + wmat_off(layer, 0), MT, 1536, 1024}; pg8::StaticOrder S; S.init(MT, 1536, G, bx);
            EpiQKV E{ssb + (size_t)((2 * layer) % 3) * SS_SLOT, (bf16_t*)(ws + WS_POOL), (bf16_t*)(ws + WS_POOL + 2 * ACT), (bf16_t*)(ws + WS_POOL + 2 * ACT) + (size_t)MT * 256, (const float*)(ws + WS_ROPE),
                     out + OKP + (size_t)j * 4 * 128 * 256, out + OVP + (size_t)j * 4 * 128 * 256, out + OKS + (size_t)j * 8 * 128 * 256, out + OVS + (size_t)j * 8 * 128 * 256};
            pg8::gemm_phase<EpiQKV, pg8::StaticOrder, true, true>((PG8_LAS unsigned char*)lds, g, S, E);
        } else if (kind == 2) { if (!(SKIPMASK & 4)) attn_phase(pk, (char*)lds, j, vcu, G); }
        else if ((kind == 3 || kind == 5) && !(SKIPMASK & 8)) {
            unsigned char* ws = pk->ws; bf16_t* WB = (bf16_t*)(ws + WS_W); float* ssb = (float*)(ws + WS_SS);
            const bool dn = kind == 5; const int K = dn ? 4096 : 1024;
            const bf16_t* A = dn ? (const bf16_t*)(ws + WS_POOL) : ((layer & 1) ? (const bf16_t*)(ws + WS_POOL) : (const bf16_t*)(ws + WS_POOL + ACT));
            pg8::Gemm g{A, WB + wmat_off(layer, dn ? 3 : 1), MT, 1024, K}; pg8::StaticOrder S; S.init(MT, 1024, G, bx);
            EpiRes E{pk->out + OY, (bf16_t*)(ws + WS_XB), ssb + (size_t)((2 * layer + (dn ? 2 : 1)) % 3) * SS_SLOT};
            pg8::gemm_phase<EpiRes, pg8::StaticOrder, true, true>((PG8_LAS unsigned char*)lds, g, S, E);
        } else if (kind == 4 && !(SKIPMASK & 16)) {
            unsigned char* ws = pk->ws; bf16_t* WB = (bf16_t*)(ws + WS_W); float* ssb = (float*)(ws + WS_SS);
            pg8::Gemm g{(bf16_t*)(ws + WS_XB), WB + wmat_off(layer, 2), MT, 4096, 1024}; pg8::StaticOrder S; S.init(MT, 4096, G, bx);
            EpiUp E{ssb + (size_t)((2 * layer + 1) % 3) * SS_SLOT, (bf16_t*)(ws + WS_POOL)};
            pg8::gemm_phase<EpiUp, pg8::StaticOrder, true, true>((PG8_LAS unsigned char*)lds, g, S, E);
        } else if (kind == 6 && !(SKIPMASK & 32)) {
            unsigned char* ws = pk->ws; bf16_t* WB = (bf16_t*)(ws + WS_W); float* ssb = (float*)(ws + WS_SS);
            pg8::Gemm g{(bf16_t*)(ws + WS_XB), WB + wmat_off(layer, 0), MT, 4096, 1024}; pg8::StaticOrder S; S.init(MT, 4096, G, bx);
            EpiHin E{ssb + (size_t)((2 * layer) % 3) * SS_SLOT, (u16*)(ws + WS_POOL)};
            pg8::gemm_phase<EpiHin, pg8::StaticOrder, true, true>((PG8_LAS unsigned char*)lds, g, S, E);
        } else if (kind == 7) { if (!(SKIPMASK & 64)) hgrn_passA(pk, (char*)lds, j, vcu, G); }
        else if (kind == 8) { if (!(SKIPMASK & 128)) hgrn_passB(pk, j, G); }
        else if (kind == 9) { if (!(SKIPMASK & 256)) hgrn_passC(pk, (char*)lds, j, vcu, G); }
        else if (kind == 10) { if (!(SKIPMASK & 512)) final_phase(pk, vcu, G); }
        }
        if (PROBE_KIND == 99 && ph == 3) for (int e = 0; e < PROBE_REP; ++e) xcd_barrier(bar);
        if (ph + 1 < ph_hi) { if (ph == 0) grid.sync(); else xcd_barrier(bar); }
    }
}

#ifndef MK_PER_PHASE
#define MK_PER_PHASE 0
#endif
extern "C" void kernel_launch(void* const* d_in, const int* in_sizes, int n_in, void* d_out, int out_size, void* d_ws, size_t ws_size, hipStream_t stream) {
    static int grid = 0;
    if (grid == 0) {
        int dev = 0, cus = 0, per_cu = 0;
        hipGetDevice(&dev); hipDeviceGetAttribute(&cus, hipDeviceAttributeMultiprocessorCount, dev);
        hipFuncSetAttribute((const void*)fwd_kernel, hipFuncAttributeMaxDynamicSharedMemorySize, LDS_BYTES);
        hipOccupancyMaxActiveBlocksPerMultiprocessor(&per_cu, (const void*)fwd_kernel, 512, LDS_BYTES);
        (void)hipGetLastError();
        if (per_cu < 1) { fprintf(stderr, "kernel_launch: occupancy query says %d blocks/CU\n", per_cu); per_cu = 1; }
        grid = cus;
        if (n_in != 17 || ws_size < WS_SS + 3 * SS_SLOT * 4) { fprintf(stderr, "kernel_launch: unexpected n_in %d / ws_size %zu (need %zu)\n", n_in, ws_size, (size_t)WS_END); }
    }
    (void)hipMemsetAsync((char*)d_ws + WS_CTL, 0, CTL_BYTES, stream);
    Params p{};
    for (int i = 0; i < 17; ++i) p.in[i] = (const float*)d_in[i];
    p.out = (float*)d_out; p.ws = (unsigned char*)d_ws;
#if MK_PER_PHASE
    for (int ph = 0; ph < NPHASE; ++ph) { p.ph_lo = ph; p.ph_hi = ph + 1; hipLaunchKernelGGL(fwd_kernel, dim3(grid), dim3(512), LDS_BYTES, stream, p); }
#else
    p.ph_lo = 0; p.ph_hi = NPHASE;
    void* args[] = {&p};
    hipError_t e = hipLaunchCooperativeKernel((const void*)fwd_kernel, dim3(grid), dim3(512), args, LDS_BYTES, stream);
    if (e != hipSuccess) fprintf(stderr, "cooperative launch failed: %s (grid %d)\n", hipGetErrorString(e), grid);
#endif
}
```

```cpp
#include <hip/hip_runtime.h>
#include <hip/hip_cooperative_groups.h>
#include <cstdio>
#include <cstdint>
namespace cg = cooperative_groups;
#ifndef PG_WGM
#define PG_WGM 8
#endif
#ifndef PG_ALIGN
#define PG_ALIGN true
#endif
#ifndef PG_SP2
#define PG_SP2 true
#endif
namespace pg8 {
#define PG8_LAS __attribute__((address_space(3)))
typedef unsigned short bf16_t;
typedef short bf16x8 __attribute__((ext_vector_type(8)));
typedef float f32x4 __attribute__((ext_vector_type(4)));
typedef unsigned u32x4 __attribute__((ext_vector_type(4)));
constexpr int BM = 256, BK = 64, HALF = 128, HTB = HALF * BK * 2  , STAGE_BYTES = 8 * HTB, NXCD = 8, WGM = PG_WGM;

__host__ __device__ __forceinline__ int lds_byte(int r, int c) { const int st = (r >> 4) * 2 + (c >> 5), rr = r & 15, cc = c & 31, ob = rr * 64 + cc * 2; return st * 1024 + (ob ^ (((ob >> 9) & 1) << 5)); }
__host__ __device__ __forceinline__ void stage_rc(int b, int& R, int& C) { const int st = b / 1024, sb = b % 1024, swz = sb ^ (((sb >> 9) & 1) << 5); R = (st >> 1) * 16 + swz / 64; C = (st & 1) * 32 + (swz % 64) / 2; }
__host__ __device__ __forceinline__ int perm32(int rho) { const int n = rho >> 4, i = rho & 15; return 8 * (i >> 2) + 4 * n + (i & 3); }

struct Unit { int pm, pn, k0, nt, sp; };
struct Gemm { const bf16_t* A; const bf16_t* Bt; int M, N, K; };

struct StaticOrder {
    int nM, nN, nwg, G, c, ntK, pm0;
    int sM0, sNM, sS, sKs, nsp;
    __host__ __device__ void init(int M, int N, int K, int G_, int c_, int pm0_ = 0) { pm0 = pm0_; nM = M / BM; nN = N / BM; nwg = nM * nN; G = G_; c = c_; ntK = K / BK; sM0 = 0; sNM = 0; sS = 1; sKs = K; nsp = 0; }
    __host__ __device__ void split(int m0, int nm, int S) { sM0 = m0; sNM = nm; sS = S; sKs = (ntK / S) * BK; nsp = nm * nN * S; }
    __host__ __device__ bool next(int i, Unit& u) const {
        const long L = (long)i * G + c;
        if (L >= nwg) { const long L2 = L - (long)((nwg + G - 1) / G) * G; if (L2 < 0 || L2 >= nsp) return false;
            const int ks = (int)(L2 % sS), un = (int)(L2 / sS); u.pm = sM0 + un % sNM; u.pn = un / sNM; u.k0 = ks * sKs; u.nt = sKs / BK; u.sp = ks; return true; }
        int wgid = (int)L; { const int q = nwg / NXCD, r = nwg % NXCD, xcd = wgid % NXCD, off = wgid / NXCD; wgid = (xcd < r ? xcd * (q + 1) : r * (q + 1) + (xcd - r) * q) + off; }
        const int nig = WGM * nN, gid = wgid / nig, fm = gid * WGM, gsz = (nM - fm) < WGM ? (nM - fm) : WGM;
        u.pm = pm0 + fm + ((wgid % nig) % gsz); u.pn = (wgid % nig) / gsz; u.k0 = 0; u.nt = ntK; u.sp = -1; return true;
    }
    __device__ __forceinline__ void a_ready(const Unit&) const {}
    __device__ __forceinline__ void done(const Unit&) const {}
};

__device__ __forceinline__ unsigned cvt_pk_bf16(float lo, float hi) { unsigned r; asm volatile("v_cvt_pk_bf16_f32 %0, %1, %2" : "=v"(r) : "v"(lo), "v"(hi)); return r; }
typedef float f32x2 __attribute__((ext_vector_type(2)));
template <class Epi, class Sched, bool ALIGN_EPI = false, bool SP2 = false>
__device__ __forceinline__ void gemm_phase(PG8_LAS unsigned char* lds, const Gemm g, const Sched& S, const Epi& E) {
    int tid_ = threadIdx.x; asm volatile("" : "+v"(tid_)); const int tid = tid_, wid = __builtin_amdgcn_readfirstlane(tid >> 6), lane = tid & 63, wr = wid >> 2, wc = wid & 3, fr = lane & 15, fq = lane >> 4;
    const int K = g.K;
    unsigned voffA[2], voffB[2];
#pragma unroll
    for (int i = 0; i < 2; ++i) { int R, C; stage_rc(tid * 16 + i * 8192, R, C); const int Rb = Epi::PERM ? ((R & ~31) + perm32(R & 31)) : R;
        voffA[i] = (unsigned)(R * K + C) * 2u; voffB[i] = (unsigned)(Rb * K + C) * 2u; }
    const size_t kstep = (size_t)(BK * 2);
    const size_t hstep = (size_t)HALF * K * 2;
    const size_t tstep = 2 * hstep;
    const unsigned ldsw = (unsigned)wid * 1024u;
    const int aoff = lds_byte(wr * 64 + fr, fq * 8), boff = lds_byte(wc * 32 + fr, fq * 8);
#define PG8_SA(b, h) (((b) * 2 + (h)) * HTB)
#define PG8_SB(b, h) ((4 + (b) * 2 + (h)) * HTB)
#define PG8_STAGE(bufoff, gbase, voff) do { _Pragma("unroll") for (int _i = 0; _i < 2; ++_i) \
        __builtin_amdgcn_global_load_lds((const unsigned*)((const char*)(gbase) + (voff)[_i]), (PG8_LAS unsigned*)(lds + (bufoff) + ldsw + _i * 8192), 16, 0, 0); } while (0)
#define PG8_LDA(dst, b, h) do { _Pragma("unroll") for (int m = 0; m < 4; ++m) _Pragma("unroll") for (int k = 0; k < 2; ++k) dst[m][k] = *(const PG8_LAS bf16x8*)(lds + PG8_SA(b, h) + aoff + m * 2048 + k * 1024); } while (0)
#define PG8_LDB(dst, b, h) do { _Pragma("unroll") for (int n = 0; n < 2; ++n) _Pragma("unroll") for (int k = 0; k < 2; ++k) dst[n][k] = *(const PG8_LAS bf16x8*)(lds + PG8_SB(b, h) + boff + n * 2048 + k * 1024); } while (0)
#define PG8_MMA(ai, bj, At, Bt) do { __builtin_amdgcn_s_setprio(1); _Pragma("unroll") for (int m = 0; m < 4; ++m) _Pragma("unroll") for (int n = 0; n < 2; ++n) _Pragma("unroll") for (int k = 0; k < 2; ++k) \
        acc[ai][bj][m][n] = __builtin_amdgcn_mfma_f32_16x16x32_bf16(Bt[n][k], At[m][k], acc[ai][bj][m][n], 0, 0, 0); __builtin_amdgcn_s_setprio(0); } while (0)
#define PG8_WAIT_V(n) asm volatile("s_waitcnt vmcnt(" #n ")" ::: "memory")
#define PG8_WAIT_L(n) asm volatile("s_waitcnt lgkmcnt(" #n ")" ::: "memory")
#define PG8_BAR __builtin_amdgcn_s_barrier()
#define PG8_SCHED __builtin_amdgcn_sched_barrier(0)
    Unit cur, nxt; int ui = 0;
    if (!S.next(0, cur)) return;
    f32x4 acc[2][2][4][2];
#pragma unroll
    for (int a = 0; a < 2; ++a)
#pragma unroll
        for (int b = 0; b < 2; ++b)
#pragma unroll
            for (int m = 0; m < 4; ++m)
#pragma unroll
                for (int n = 0; n < 2; ++n) acc[a][b][m][n] = (f32x4){0.f, 0.f, 0.f, 0.f};
    bf16x8 At[4][2], B0[2][2], B1[2][2];
    const char* cA = (const char*)g.A + (size_t)cur.pm * tstep + (size_t)cur.k0 * 2; const char* cB = (const char*)g.Bt + (size_t)cur.pn * tstep + (size_t)cur.k0 * 2;
    S.a_ready(cur);
    if constexpr (SP2) {
        PG8_STAGE(PG8_SB(0, 0), cB, voffB); PG8_STAGE(PG8_SB(0, 1), cB + hstep, voffB); PG8_STAGE(PG8_SA(0, 0), cA, voffA); PG8_STAGE(PG8_SA(0, 1), cA + hstep, voffA);
        if (wr == 1) PG8_BAR;
        PG8_WAIT_V(2); PG8_BAR;
        PG8_STAGE(PG8_SB(1, 0), cB + kstep, voffB); PG8_STAGE(PG8_SA(1, 0), cA + kstep, voffA); PG8_STAGE(PG8_SB(1, 1), cB + hstep + kstep, voffB);
        PG8_WAIT_V(6); PG8_BAR;
    } else {
        PG8_STAGE(PG8_SB(0, 0), cB, voffB); PG8_STAGE(PG8_SA(0, 0), cA, voffA); PG8_STAGE(PG8_SB(0, 1), cB + hstep, voffB); PG8_STAGE(PG8_SA(0, 1), cA + hstep, voffA);
        if (wr == 1) PG8_BAR;
        PG8_WAIT_V(4); PG8_BAR;
        PG8_STAGE(PG8_SB(1, 0), cB + kstep, voffB); PG8_STAGE(PG8_SA(1, 0), cA + kstep, voffA); PG8_STAGE(PG8_SB(1, 1), cB + hstep + kstep, voffB);
        PG8_WAIT_V(6); PG8_BAR;
    }
    for (;;) {
        const bool has_next = S.next(ui + 1, nxt);
        const char* nA = has_next ? (const char*)g.A + (size_t)nxt.pm * tstep + (size_t)nxt.k0 * 2 : cA; const char* nB = has_next ? (const char*)g.Bt + (size_t)nxt.pn * tstep + (size_t)nxt.k0 * 2 : cB;
        const int nt = cur.nt;
        for (int t = 0; t < nt; t += 2) {
            const bool last = (t == nt - 2);
            const char* a1 = cA + (size_t)(t + 1) * kstep;
            const char* a2 = last ? nA : cA + (size_t)(t + 2) * kstep; const char* b2 = last ? nB : cB + (size_t)(t + 2) * kstep;
            const char* a3 = a2 + kstep; const char* b3 = b2 + kstep;
            if (last && has_next) S.a_ready(nxt);
            if constexpr (SP2) {
            PG8_LDB(B0, 0, 0); PG8_LDB(B1, 0, 1); PG8_SCHED; PG8_LDA(At, 0, 0); PG8_STAGE(PG8_SA(1, 1), a1 + hstep, voffA);
            PG8_WAIT_V(8); PG8_WAIT_L(0); PG8_BAR; PG8_MMA(0, 0, At, B0); PG8_MMA(0, 1, At, B1); PG8_BAR; PG8_SCHED;
            PG8_LDA(At, 0, 1); PG8_STAGE(PG8_SB(0, 0), b2, voffB); PG8_STAGE(PG8_SB(0, 1), b2 + hstep, voffB); PG8_STAGE(PG8_SA(0, 0), a2, voffA);
            PG8_WAIT_V(8); PG8_WAIT_L(0); PG8_BAR; PG8_MMA(1, 0, At, B0); PG8_MMA(1, 1, At, B1); PG8_BAR; PG8_SCHED;
            PG8_LDB(B0, 1, 0); PG8_LDB(B1, 1, 1); PG8_SCHED; PG8_LDA(At, 1, 0); PG8_STAGE(PG8_SA(0, 1), a2 + hstep, voffA);
            PG8_WAIT_V(8); PG8_WAIT_L(0); PG8_BAR; PG8_MMA(0, 0, At, B0); PG8_MMA(0, 1, At, B1); PG8_BAR; PG8_SCHED;
            PG8_LDA(At, 1, 1); PG8_STAGE(PG8_SB(1, 0), b3, voffB); PG8_STAGE(PG8_SB(1, 1), b3 + hstep, voffB); PG8_STAGE(PG8_SA(1, 0), a3, voffA);
            PG8_WAIT_V(8); PG8_WAIT_L(0); PG8_BAR; PG8_MMA(1, 0, At, B0); PG8_MMA(1, 1, At, B1); PG8_BAR; PG8_SCHED;
            } else {
            PG8_LDB(B0, 0, 0); PG8_SCHED; PG8_LDA(At, 0, 0); PG8_STAGE(PG8_SA(1, 1), a1 + hstep, voffA);
            PG8_WAIT_L(8); PG8_BAR; PG8_WAIT_L(0); PG8_MMA(0, 0, At, B0); PG8_BAR; PG8_SCHED;
            PG8_LDB(B1, 0, 1); PG8_STAGE(PG8_SB(0, 0), b2, voffB);
            PG8_BAR; PG8_WAIT_L(0); PG8_MMA(0, 1, At, B1); PG8_BAR;
            PG8_LDA(At, 0, 1); PG8_STAGE(PG8_SA(0, 0), a2, voffA);
            PG8_BAR; PG8_WAIT_L(0); PG8_MMA(1, 0, At, B0); PG8_BAR; PG8_SCHED;
            PG8_STAGE(PG8_SB(0, 1), b2 + hstep, voffB);
            PG8_WAIT_V(6); PG8_BAR; PG8_MMA(1, 1, At, B1); PG8_BAR;
            PG8_LDB(B0, 1, 0); PG8_SCHED; PG8_LDA(At, 1, 0); PG8_STAGE(PG8_SA(0, 1), a2 + hstep, voffA);
            PG8_WAIT_L(8); PG8_BAR; PG8_WAIT_L(0); PG8_MMA(0, 0, At, B0); PG8_BAR; PG8_SCHED;
            PG8_LDB(B1, 1, 1); PG8_STAGE(PG8_SB(1, 0), b3, voffB);
            PG8_BAR; PG8_WAIT_L(0); PG8_MMA(0, 1, At, B1); PG8_BAR;
            PG8_LDA(At, 1, 1); PG8_STAGE(PG8_SA(1, 0), a3, voffA);
            PG8_BAR; PG8_WAIT_L(0); PG8_MMA(1, 0, At, B0); PG8_BAR; PG8_SCHED;
            PG8_STAGE(PG8_SB(1, 1), b3 + hstep, voffB);
            PG8_WAIT_V(6); PG8_BAR; PG8_MMA(1, 1, At, B1); PG8_BAR;
            }
        }
        if constexpr (ALIGN_EPI) { if (wr == 0) PG8_BAR; }
        if constexpr (!Epi::AFTER_DRAIN) { E(acc, cur, wr, wc, fr, fq); S.done(cur); }
        if (!has_next) break;
#pragma unroll
        for (int a = 0; a < 2; ++a)
#pragma unroll
            for (int b = 0; b < 2; ++b)
#pragma unroll
                for (int m = 0; m < 4; ++m)
#pragma unroll
                    for (int n = 0; n < 2; ++n) acc[a][b][m][n] = (f32x4){0.f, 0.f, 0.f, 0.f};
        cur = nxt; cA = nA; cB = nB; ++ui;
        if constexpr (ALIGN_EPI) { if (wr == 1) PG8_BAR; }
    }
    PG8_WAIT_V(0);
    if constexpr (!ALIGN_EPI) { if (wr == 0) PG8_BAR; }
    PG8_BAR;
    if constexpr (Epi::AFTER_DRAIN) { E.fused(acc, cur, wr, wc, fr, fq, lds, wid, lane); S.done(cur); }
#undef PG8_SA
#undef PG8_SB
#undef PG8_STAGE
#undef PG8_LDA
#undef PG8_LDB
#undef PG8_MMA
#undef PG8_WAIT_V
#undef PG8_WAIT_L
#undef PG8_BAR
#undef PG8_SCHED
}
}
#define LAS __attribute__((address_space(3)))
#define XB_TMO      128
#define XB_XCNT(j)  (256  + 64 * (j))
#define XB_XSUB(j)  (1280 + 64 * (j))
#define XB_XGEN(j)  (2304 + 64 * (j))
#define XB_TOP      3328
#define XB_TOPGEN   3392
#define XCD_BAR_WORDS 3456
#define XB_SPIN_CAP (1u << 18)

__device__ __forceinline__ unsigned xb_ld(unsigned* p)              { return __hip_atomic_load(p, __ATOMIC_RELAXED, __HIP_MEMORY_SCOPE_AGENT); }
__device__ __forceinline__ unsigned xb_add(unsigned* p, unsigned v) { return __hip_atomic_fetch_add(p, v, __ATOMIC_RELAXED, __HIP_MEMORY_SCOPE_AGENT); }
__device__ __forceinline__ unsigned xb_xcc_id() { return (unsigned)__builtin_amdgcn_s_getreg((3 << 11) | 20) & 0xFu; }
#define XB_SPIN(cond, bar) do { unsigned _sp = 0; while (cond) { __builtin_amdgcn_s_sleep(1); \
    if ((++_sp & 255u) == 0u) { if (xb_ld(&(bar)[XB_TMO])) break; if (_sp > XB_SPIN_CAP) { atomicAdd(&(bar)[XB_TMO], 1u); break; } } } } while (0)

struct XcdBarrier {
    unsigned* bar; unsigned x;
    volatile LAS unsigned* st;
};

__device__ __forceinline__ XcdBarrier xcd_barrier_post(unsigned* bar, volatile LAS unsigned* st) {
    XcdBarrier b; b.bar = bar; b.x = xb_xcc_id(); b.st = st;
    if (threadIdx.x == 0) (void)xb_add(&bar[XB_XCNT(b.x)], 1u);
    return b;
}
__device__ __forceinline__ void xcd_barrier_complete(unsigned* bar, unsigned x, unsigned& nloc, unsigned& nx) {
    const unsigned G = gridDim.x * gridDim.y * gridDim.z;
    unsigned sum, cnt, mine, sp = 0u;
    for (;;) {
        sum = 0u; cnt = 0u; mine = 0u;
#pragma unroll
        for (unsigned j = 0; j < 16; ++j) { const unsigned c = xb_ld(&bar[XB_XCNT(j)]); sum += c; cnt += (c > 0u) ? 1u : 0u; mine = (j == x) ? c : mine; }
        if (sum == G) break;
        __builtin_amdgcn_s_sleep(1);
        if ((++sp & 255u) == 0u) { if (xb_ld(&bar[XB_TMO])) break; if (sp > XB_SPIN_CAP) { atomicAdd(&bar[XB_TMO], 1u); break; } }
    }
    nloc = mine > 0u ? mine : 1u; nx = cnt > 0u ? cnt : 1u;
}

__device__ __forceinline__ void xcd_barrier(const XcdBarrier& b) {
    asm volatile("s_waitcnt vmcnt(0)" ::: "memory");
    __syncthreads();
    if (threadIdx.x == 0) {
        unsigned* bar = b.bar;
        __builtin_amdgcn_s_waitcnt(0);
        unsigned nloc = b.st[0], nx = b.st[1];
        if (nloc == 0u) { xcd_barrier_complete(bar, b.x, nloc, nx); b.st[0] = nloc; b.st[1] = nx; }
        const unsigned old = xb_add(&bar[XB_XSUB(b.x)], 1u);
        const unsigned gen = old / nloc;
        if (old + 1u == (gen + 1u) * nloc) {
            __builtin_amdgcn_fence(__ATOMIC_RELEASE, "agent");
            asm volatile("s_waitcnt vmcnt(0)" ::: "memory");
            const unsigned og = xb_add(&bar[XB_TOP], 1u);
            const unsigned tg = og / nx;
            if (og + 1u == (tg + 1u) * nx) xb_add(&bar[XB_TOPGEN], 1u);
            else XB_SPIN(xb_ld(&bar[XB_TOPGEN]) == tg, bar);
            __builtin_amdgcn_fence(__ATOMIC_ACQUIRE, "agent");
            xb_add(&bar[XB_XGEN(b.x)], 1u);
            asm volatile("s_waitcnt vmcnt(0)" ::: "memory");
        } else {
            XB_SPIN(xb_ld(&bar[XB_XGEN(b.x)]) == gen, bar);
            __builtin_amdgcn_fence(__ATOMIC_ACQUIRE, "agent");
            asm volatile("s_waitcnt vmcnt(0)" ::: "memory");
        }
    }
    __syncthreads();
}

using pg8::bf16_t; using pg8::bf16x8; using pg8::f32x4; using pg8::u32x4; using pg8::Unit;
typedef unsigned u32x2 __attribute__((ext_vector_type(2)));
typedef unsigned short u16;
constexpr int MP_ROWS = 32768;
constexpr int DM = 1024, MP = 32768, MS = 512, MT = MP + MS, SEQ = 8192;
constexpr float EPS = 1e-5f, LOG2E = 1.4426950408889634f, C2 = 0.125f * 1.4426950408889634f;
constexpr size_t MiB = 1u << 20;
constexpr size_t WS_SS = 492 * MiB, SS_SLOT = (size_t)MT * 16;
constexpr size_t WS_CTL = 0, CTL_BYTES = 131072;
constexpr size_t WS_SPK = 166 * MiB;
constexpr size_t WS_ROPE = 2 * MiB;
constexpr size_t WS_DB = 3 * MiB;
constexpr size_t WS_W = 6 * MiB;
constexpr size_t WS_XB = 100 * MiB;
constexpr size_t WS_POOL = 232 * MiB;
constexpr size_t ACT = (size_t)MT * DM * 2;
constexpr size_t WS_END = WS_POOL + 4 * ACT;
constexpr size_t OY = 0, OKP = 34078720, OVP = 34340864, OSP = 34603008, OKS = 35651584, OVS = 36175872, OSS = 36700160;
constexpr size_t WM = 1048576;
#ifndef NHALF
#define NHALF 1
#endif
constexpr int HROWS = MP_ROWS / NHALF;
struct Params { const float* in[17]; float* out; unsigned char* ws; int ph_lo, ph_hi; };
typedef const __attribute__((address_space(4))) Params* KP;
__device__ __forceinline__ KP kargs() { KP k = (KP)__builtin_amdgcn_kernarg_segment_ptr(); asm volatile("" : "+s"(k)); return k; }

__device__ __forceinline__ unsigned pkbf(float lo, float hi) { typedef float f2 __attribute__((ext_vector_type(2))); typedef __bf16 b2 __attribute__((ext_vector_type(2))); f2 v = {lo, hi}; b2 b = __builtin_convertvector(v, b2); return __builtin_bit_cast(unsigned, b); }
__device__ __forceinline__ float bflo(unsigned u) { return __uint_as_float(u << 16); }
__device__ __forceinline__ float bfhi(unsigned u) { return __uint_as_float(u & 0xffff0000u); }
__device__ __forceinline__ float bf2f(u16 u) { return __uint_as_float((unsigned)u << 16); }
__device__ __forceinline__ u16 f2bf(float f) { return (u16)(pkbf(f, 0.f) & 0xffffu); }
__device__ __forceinline__ unsigned pkh(float lo, float hi) { _Float16 a = (_Float16)lo, b = (_Float16)hi; return (unsigned)__builtin_bit_cast(u16, a) | ((unsigned)__builtin_bit_cast(u16, b) << 16); }
__device__ __forceinline__ f32x4 mfma16(bf16x8 a, bf16x8 b, f32x4 c) { return __builtin_amdgcn_mfma_f32_16x16x32_bf16(a, b, c, 0, 0, 0); }
__device__ __forceinline__ int row_pos(int r) { return r < MP ? (r & (SEQ - 1)) : 2048 + ((r - MP) & 63); }
__device__ __forceinline__ float row_rs(const float* ss, int r) { const f32x4* q = (const f32x4*)(ss + (size_t)r * 16); f32x4 a = q[0], b = q[1], c = q[2], d = q[3]; a = (a + b) + (c + d); return rsqrtf(((a[0] + a[1]) + (a[2] + a[3])) * (1.f / 1024.f) + EPS); }
__device__ __forceinline__ float silu(float v) { return v * __builtin_amdgcn_rcpf(1.f + __builtin_amdgcn_exp2f(-1.4426950408889634f * v)); }

#ifndef COLPERM
#define COLPERM 1
#endif
#ifndef NT_STORE
#define NT_STORE 0
#endif
#if NT_STORE == 2
__device__ __forceinline__ void st16_wt(void* p, u32x4 v) { asm volatile("global_store_dwordx4 %0, %1, off sc0 sc1" :: "v"(p), "v"(v) : "memory"); }
#define ST16(p, v) st16_wt((void*)(p), (v))
#define ST8(p, v) (*(u32x2*)(p) = (v))
#define STF4(p, v) (*(f32x4*)(p) = (v))
#elif NT_STORE
#define ST16(p, v) __builtin_nontemporal_store((v), (u32x4*)(p))
#define ST8(p, v) __builtin_nontemporal_store((v), (u32x2*)(p))
#define STF4(p, v) __builtin_nontemporal_store((v), (f32x4*)(p))
#else
#define ST16(p, v) (*(u32x4*)(p) = (v))
#define ST8(p, v) (*(u32x2*)(p) = (v))
#define STF4(p, v) (*(f32x4*)(p) = (v))
#endif
#define EPI_ROW(idx) (u.pm * 256 + ((idx) >> 2) * 128 + wr * 64 + ((idx) & 3) * 16 + fr)
#define EPI_LOAD_RS(rsv, ss) float rsv[8]; { f32x4 pv_[8]; \
    _Pragma("unroll") for (int idx = 0; idx < 8; ++idx) pv_[idx] = *(const f32x4*)((ss) + (size_t)EPI_ROW(idx) * 16 + fq * 4); \
    _Pragma("unroll") for (int idx = 0; idx < 8; ++idx) { float s_ = (pv_[idx][0] + pv_[idx][1]) + (pv_[idx][2] + pv_[idx][3]); s_ += __shfl_xor(s_, 16); s_ += __shfl_xor(s_, 32); rsv[idx] = rsqrtf(s_ * (1.f / 1024.f) + EPS); } }
struct EpiQKV {
    static constexpr bool PERM = true, AFTER_DRAIN = false;
    unsigned char* ws; float* out; int j, slot;
    __device__ __forceinline__ void operator()(const f32x4 (&acc)[2][2][4][2], const Unit& u, int wr, int wc, int fr, int fq, unsigned mask) const {
        const float* ss = (const float*)(ws + WS_SS) + (size_t)slot * SS_SLOT; const float* rope = (const float*)(ws + WS_ROPE);
        const int pn = u.pn; const bool rot = (pn <= 4) && ((wc & 1) == 0); const float qs = pn < 4 ? C2 : 1.f; const bool rl_ = rot && fq < 2;
        EPI_LOAD_RS(rsv, ss)
        const f32x4 one4 = {1.f, 1.f, 1.f, 1.f}, zero4 = {0.f, 0.f, 0.f, 0.f};
        f32x4 c0 = one4, c1 = one4, s0 = zero4, s1 = zero4, dc0 = one4, dc1 = one4, ds0 = zero4, ds1 = zero4;
        if (rl_) { const float* t = rope + row_pos(EPI_ROW(0)) * 16; c0 = *(const f32x4*)t; c1 = *(const f32x4*)(t + 4); s0 = *(const f32x4*)(t + 8); s1 = *(const f32x4*)(t + 12);
            const float* d = rope + 16 * 16; dc0 = *(const f32x4*)d; dc1 = *(const f32x4*)(d + 4); ds0 = *(const f32x4*)(d + 8); ds1 = *(const f32x4*)(d + 12); }
        const float sgn = fq == 0 ? -1.f : 1.f;
#pragma unroll
        for (int idx = 0; idx < 8; ++idx) {
            const int ai = idx >> 2, m = idx & 3;
            if (idx > 0) {
                const bool back = (idx == 4) && (u.pm >= 128);
                const float dsg = back ? -1.f : 1.f;
#pragma unroll 1
                for (int st_ = (idx == 4 ? (back ? 3 : 5) : 1); st_ > 0; --st_) { const f32x4 e0 = ds0 * dsg, e1 = ds1 * dsg; const f32x4 a0 = c0 * dc0 - s0 * e0, b0 = s0 * dc0 + c0 * e0, a1 = c1 * dc1 - s1 * e1, b1 = s1 * dc1 + c1 * e1; c0 = a0; s0 = b0; c1 = a1; s1 = b1; }
            }
            if (!((mask >> idx) & 1u)) continue;
            int rl = ai * 128 + wr * 64 + m * 16 + fr; asm volatile("" : "+v"(rl)); const int r = u.pm * 256 + rl;
            const float rs = rsv[idx];
            const f32x4 sn0 = s0 * sgn, sn1 = s1 * sgn;
            float* nk = nullptr;
            if (pn >= 4) {
                if (u.pm < 128) { const int t = (u.pm & 31) * 256 + rl; if (t >= 8064) nk = out + (pn == 4 ? OKP : OVP) + ((size_t)((j * 4 + (u.pm >> 5)) * 128 + (t - 8064))) * 256; }
                else { const int rr = r - MP; nk = out + (pn == 4 ? OKS : OVS) + ((size_t)((j * 8 + (rr >> 6)) * 128 + 64 + (rr & 63))) * 256; }
            }
#pragma unroll
            for (int bj = 0; bj < 2; ++bj) {
                f32x4 v0 = acc[ai][bj][m][0] * rs, v1 = acc[ai][bj][m][1] * rs;
                if (rot) {
                    f32x4 p0, p1;
#pragma unroll
                    for (int e = 0; e < 4; ++e) { p0[e] = __shfl_xor(v0[e], 16); p1[e] = __shfl_xor(v1[e], 16); }
                    v0 = v0 * c0 + p0 * sn0; v1 = v1 * c1 + p1 * sn1;
                }
                v0 = v0 * qs; v1 = v1 * qs;
                const int cw = bj * 128 + wc * 32 + 8 * fq;
                bf16_t* dst = pn < 4 ? (bf16_t*)(ws + WS_POOL) + (size_t)r * 1024 + pn * 256 + cw : (bf16_t*)(ws + WS_POOL + 2 * ACT) + (pn == 4 ? (size_t)0 : (size_t)MT * 256) + (size_t)r * 256 + cw;
                u32x4 w; w.x = pkbf(v0[0], v0[1]); w.y = pkbf(v0[2], v0[3]); w.z = pkbf(v1[0], v1[1]); w.w = pkbf(v1[2], v1[3]);
                ST16(dst, w);
                if (nk) { *(f32x4*)(nk + cw) = v0; *(f32x4*)(nk + cw + 4) = v1; }
            }
        }
    }
};
struct EpiRes {
    static constexpr bool PERM = true, AFTER_DRAIN = false;
    bf16_t* XB; float* ssn;
    __device__ __forceinline__ void operator()(const f32x4 (&acc)[2][2][4][2], const Unit& u, int wr, int wc, int fr, int fq, unsigned mask) const {
        const int col0 = u.pn * 256 + wc * 32 + 8 * fq;
        u32x4 xin[8][2];
#pragma unroll
        for (int idx = 0; idx < 8; ++idx) { const bf16_t* xp = XB + (size_t)EPI_ROW(idx) * 1024 + col0; xin[idx][0] = *(const u32x4*)xp; xin[idx][1] = *(const u32x4*)(xp + 128); }
#pragma unroll
        for (int idx = 0; idx < 8; ++idx) {
            const int ai = idx >> 2, m = idx & 3;
            if (!((mask >> idx) & 1u)) continue;
            int r = EPI_ROW(idx); asm volatile("" : "+v"(r)); bf16_t* xo = XB + (size_t)r * 1024 + col0; float sq = 0.f;
#pragma unroll
            for (int bj = 0; bj < 2; ++bj) { const u32x4 cx = xin[idx][bj]; const f32x4 a0 = acc[ai][bj][m][0], a1 = acc[ai][bj][m][1]; u32x4 w;
                w.x = pkbf(bflo(cx.x) + a0[0], bfhi(cx.x) + a0[1]); w.y = pkbf(bflo(cx.y) + a0[2], bfhi(cx.y) + a0[3]); w.z = pkbf(bflo(cx.z) + a1[0], bfhi(cx.z) + a1[1]); w.w = pkbf(bflo(cx.w) + a1[2], bfhi(cx.w) + a1[3]);
                ST16(xo + bj * 128, w);
#pragma unroll
                for (int e = 0; e < 4; ++e) { const float lo = bflo(w[e]), hi = bfhi(w[e]); sq += lo * lo + hi * hi; } }
            sq += __shfl_xor(sq, 16); sq += __shfl_xor(sq, 32);
            if (fq == 0) ssn[(size_t)r * 16 + u.pn * 4 + wc] = sq;
        }
    }
};
struct EpiUp {
    static constexpr bool PERM = true, AFTER_DRAIN = false;
    const float* ss; bf16_t* H; int rowmask;
    __device__ __forceinline__ void operator()(const f32x4 (&acc)[2][2][4][2], const Unit& u, int wr, int wc, int fr, int fq, unsigned mask) const {
        EPI_LOAD_RS(rsv, ss)
#pragma unroll
        for (int idx = 0; idx < 8; ++idx) {
            const int ai = idx >> 2, m = idx & 3;
            if (!((mask >> idx) & 1u)) continue;
            int r = EPI_ROW(idx); asm volatile("" : "+v"(r)); const float rs = rsv[idx];
#pragma unroll
            for (int bj = 0; bj < 2; ++bj) {
                f32x4 v0 = acc[ai][bj][m][0] * rs, v1 = acc[ai][bj][m][1] * rs;
#pragma unroll
                for (int e = 0; e < 4; ++e) { const float a = fmaxf(v0[e], 0.f), b = fmaxf(v1[e], 0.f); v0[e] = a * a; v1[e] = b * b; }
                u32x4 w; w.x = pkbf(v0[0], v0[1]); w.y = pkbf(v0[2], v0[3]); w.z = pkbf(v1[0], v1[1]); w.w = pkbf(v1[2], v1[3]);
                if (rowmask == 0x7ffffffe) ST16(H + ((size_t)(u.pm * 16 + u.pn) * 65536 + (size_t)(r & 255) * 256) + (COLPERM ? wc * 64 + bj * 32 : bj * 128 + wc * 32) + 8 * fq, w);
                else ST16(H + (size_t)(r & rowmask) * 4096 + u.pn * 256 + (COLPERM ? wc * 64 + bj * 32 : bj * 128 + wc * 32) + 8 * fq, w);
            }
        }
    }
};
struct EpiHin {
    static constexpr bool PERM = true, AFTER_DRAIN = false;
    const float* ss; u16* base;
    __device__ __forceinline__ void operator()(const f32x4 (&acc)[2][2][4][2], const Unit& u, int wr, int wc, int fr, int fq, unsigned mask) const {
        const int sel = u.pn >> 2; u16* ob = base + (size_t)sel * (ACT / 2);
        EPI_LOAD_RS(rsv, ss)
#pragma unroll
        for (int idx = 0; idx < 8; ++idx) {
            const int ai = idx >> 2, m = idx & 3;
            if (!((mask >> idx) & 1u)) continue;
            int r = EPI_ROW(idx); asm volatile("" : "+v"(r)); const float rs = rsv[idx];
#pragma unroll
            for (int bj = 0; bj < 2; ++bj) {
                f32x4 v0 = acc[ai][bj][m][0] * rs, v1 = acc[ai][bj][m][1] * rs; u32x4 w;
                if (sel == 1) { w.x = pkh(v0[0], v0[1]); w.y = pkh(v0[2], v0[3]); w.z = pkh(v1[0], v1[1]); w.w = pkh(v1[2], v1[3]); }
                else {
                    if (sel != 2) {
#pragma unroll
                        for (int e = 0; e < 4; ++e) { v0[e] = silu(v0[e]); v1[e] = silu(v1[e]); }
                    }
                    w.x = pkbf(v0[0], v0[1]); w.y = pkbf(v0[2], v0[3]); w.z = pkbf(v1[0], v1[1]); w.w = pkbf(v1[2], v1[3]);
                }
                ST16(ob + (size_t)r * 1024 + (u.pn & 3) * 256 + (COLPERM ? wc * 64 + bj * 32 : bj * 128 + wc * 32) + 8 * fq, w);
            }
        }
    }
};

template <class Epi> struct EpiMix {
    static constexpr bool PERM = Epi::PERM, AFTER_DRAIN = false;
    Epi E; float* P; unsigned* cnt; int S, m0, nm; unsigned pmask;
    __device__ __forceinline__ void operator()(f32x4 (&acc)[2][2][4][2], const Unit& u, int wr, int wc, int fr, int fq) const {
        unsigned mask = pmask;
        if (u.sp >= 0 && pmask == 0u) return;
        if (u.sp >= 0) {
            const int wid = wr * 4 + wc, lane = fq * 16 + fr, tile = (u.pm - m0) + nm * u.pn;
            float* pw = P + ((size_t)(tile * S + u.sp) * 8 + wid) * 8192 + lane * 4;
#pragma unroll
            for (int i = 0; i < 32; ++i) *(f32x4*)(pw + i * 256) = acc[i >> 4][(i >> 3) & 1][(i >> 1) & 3][i & 1];
            __builtin_amdgcn_fence(__ATOMIC_RELEASE, "agent");
            unsigned* cw = cnt + tile * 8 + wid;
            if (lane == 0) (void)__hip_atomic_fetch_add(cw, 1u, __ATOMIC_RELAXED, __HIP_MEMORY_SCOPE_AGENT);
            { unsigned sp_ = 0; while ((unsigned)__builtin_amdgcn_readfirstlane((int)__hip_atomic_load(cw, __ATOMIC_RELAXED, __HIP_MEMORY_SCOPE_AGENT)) < (unsigned)S) { __builtin_amdgcn_s_sleep(2); if (++sp_ > (1u << 22)) break; } }
            __builtin_amdgcn_fence(__ATOMIC_ACQUIRE, "agent");
            mask = S == 8 ? (1u << u.sp) : (3u << (2 * u.sp));
            const float* pr = P + ((size_t)(tile * S) * 8 + wid) * 8192 + lane * 4;
#pragma unroll
            for (int c = 0; c < 8; ++c) if ((mask >> c) & 1u) {
                f32x4 t0 = {0.f, 0.f, 0.f, 0.f}, t1 = t0, t2 = t0, t3 = t0; const int i0 = (c >> 2) * 16 + (c & 3) * 2;
#pragma unroll 2
                for (int s = 0; s < S; ++s) { const float* ps = pr + (size_t)s * 8 * 8192 + i0 * 256;
                    t0 += *(const f32x4*)(ps); t1 += *(const f32x4*)(ps + 256); t2 += *(const f32x4*)(ps + 8 * 256); t3 += *(const f32x4*)(ps + 9 * 256); }
                acc[c >> 2][0][c & 3][0] = t0; acc[c >> 2][0][c & 3][1] = t1; acc[c >> 2][1][c & 3][0] = t2; acc[c >> 2][1][c & 3][1] = t3;
            }
        }
        E(acc, u, wr, wc, fr, fq, mask);
    }
};

__device__ __forceinline__ int colperm(int a) { return (a & ~255) | (((a >> 5) & 1) << 7) | (((a >> 6) & 3) << 5) | (a & 31); }
__device__ __forceinline__ void p0_transpose_item(const float* W, const float* g, int K, int N, bf16_t* WT, float* scr, int item, int lane, bool perm) {
    const int nblk = N / 32, kb = item / nblk, nb = item % nblk, k0 = 64 * kb, n0 = 32 * nb;
    float wv[32];
#pragma unroll
    for (int i = 0; i < 32; ++i) { const int kk = 2 * i + (lane >> 5); wv[i] = W[(size_t)(k0 + kk) * N + n0 + (lane & 31)]; }
#pragma unroll
    for (int i = 0; i < 32; ++i) { const int kk = 2 * i + (lane >> 5); const float gs = g ? g[k0 + kk] : 1.f; scr[kk * 33 + (lane & 31)] = wv[i] * gs; }
    asm volatile("s_waitcnt lgkmcnt(0)" ::: "memory");
    const int c = lane & 7;
#pragma unroll
    for (int jj = 0; jj < 4; ++jj) { const int n = (lane >> 3) + 8 * jj; const float* s = scr + (8 * c) * 33 + n;
        u32x4 o; o.x = pkbf(s[0 * 33], s[1 * 33]); o.y = pkbf(s[2 * 33], s[3 * 33]); o.z = pkbf(s[4 * 33], s[5 * 33]); o.w = pkbf(s[6 * 33], s[7 * 33]);
        *(u32x4*)(WT + (size_t)(perm ? colperm(n0 + n) : n0 + n) * K + k0 + 8 * c) = o; }
    asm volatile("s_waitcnt lgkmcnt(0)" ::: "memory");
}
__device__ __forceinline__ size_t wlayer_base(int layer) { return layer == 0 ? 0 : layer == 1 ? (size_t)(10.5 * WM) : layer == 2 ? (size_t)(23.5 * WM) : (size_t)(34 * WM); }
__device__ __forceinline__ size_t wmat_off(int layer, int which) {
    const size_t b = wlayer_base(layer);
    if (layer & 1) return b + (which == 0 ? 0 : which == 1 ? 4 * WM : which == 2 ? 5 * WM : 9 * WM);
    return b + (which == 0 ? 0 : which == 1 ? (size_t)(1.5 * WM) : which == 2 ? (size_t)(2.5 * WM) : (size_t)(6.5 * WM));
}
__device__ __forceinline__ void prologue(KP pk, char* lds, int vcu, int G) {
    int tid_ = threadIdx.x; asm volatile("" : "+v"(tid_)); const int tid = tid_, lane = tid & 63, w = __builtin_amdgcn_readfirstlane(tid >> 6);
    const int gw = vcu * 8 + w, NGW = G * 8, gt = vcu * 512 + tid, NTH = G * 512;
    float* scr = (float*)(lds + w * 16384);
    bf16_t* WB = (bf16_t*)(pk->ws + WS_W);
    for (int it = gw; it < 24064; it += NGW) {
        int layer, r;
        if (it < 5376) { layer = 0; r = it; } else if (it < 12032) { layer = 1; r = it - 5376; } else if (it < 17408) { layer = 2; r = it - 12032; } else { layer = 3; r = it - 17408; }
        const int j = layer >> 1; const int n0 = (layer & 1) ? 2048 : 768; int which;
        if (r < n0) which = 0; else if (r < n0 + 512) { which = 1; r -= n0; } else if (r < n0 + 2560) { which = 2; r -= n0 + 512; } else { which = 3; r -= n0 + 2560; }
        const float* W; const float* g = nullptr; int K = 1024, N = 1024;
        if (which == 0) { g = pk->in[5] + layer * 1024; if (layer & 1) { W = pk->in[10] + (size_t)j * 4 * WM; N = 4096; } else { W = pk->in[7] + (size_t)j * 1536 * 1024; N = 1536; } }
        else if (which == 1) { W = ((layer & 1) ? pk->in[13] : pk->in[8]) + (size_t)j * WM; }
        else if (which == 2) { W = pk->in[14] + (size_t)layer * 4 * WM; g = pk->in[6] + layer * 1024; N = 4096; }
        else { W = pk->in[15] + (size_t)layer * 4 * WM; K = 4096; }
        p0_transpose_item(W, g, K, N, WB + wmat_off(layer, which), scr, r, lane, COLPERM && (which == 2 || (which == 0 && (layer & 1))));
    }
    bf16_t* XB = (bf16_t*)(pk->ws + WS_XB); float* ss0 = (float*)(pk->ws + WS_SS);
    for (int r0 = gw; r0 < MT; r0 += 2 * NGW) {
        const int r1 = r0 + NGW; const bool has1 = r1 < MT; const int rr[2] = {r0, has1 ? r1 : r0};
        f32x4 v[2][4];
#pragma unroll
        for (int t = 0; t < 2; ++t) { const int r = rr[t]; const float* src = r < MP ? pk->in[0] + (size_t)r * 1024 : pk->in[1] + (size_t)(r - MP) * 1024;
#pragma unroll
            for (int q = 0; q < 4; ++q) v[t][q] = *(const f32x4*)(src + 256 * q + 4 * lane); }
#pragma unroll
        for (int t = 0; t < 2; ++t) { const int r = rr[t]; float s = 0.f;
            if (t == 1 && !has1) break;
#pragma unroll
            for (int q = 0; q < 4; ++q) { u32x2 o; o.x = pkbf(v[t][q][0], v[t][q][1]); o.y = pkbf(v[t][q][2], v[t][q][3]); *(u32x2*)(XB + (size_t)r * 1024 + 256 * q + 4 * lane) = o;
                const float a = bflo(o.x), b = bfhi(o.x), c = bflo(o.y), d = bfhi(o.y); s += (a * a + b * b) + (c * c + d * d); }
#pragma unroll
            for (int o = 1; o < 64; o <<= 1) s += __shfl_xor(s, o);
            if (lane < 16) ss0[(size_t)r * 16 + lane] = lane == 0 ? s : 0.f; }
    }
    { u32x4* ctl = (u32x4*)(pk->ws + WS_CTL); const u32x4 z = {0u, 0u, 0u, 0u}; for (int e = gt; e < (int)(CTL_BYTES / 16); e += NTH) ctl[e] = z; }
    float* rope = (float*)(pk->ws + WS_ROPE);
    for (int e = gt; e < 65536; e += NTH) { const int pos = e >> 3, i = e & 7; const float inv = exp2f(-(float)i * 2.3664460711655217f); const float ang = (float)pos * inv;
        const double rev = (double)ang * 0.15915494309189535; const float fr = (float)(rev - __builtin_rint(rev));
        rope[pos * 16 + i] = __builtin_amdgcn_cosf(fr); rope[pos * 16 + 8 + i] = __builtin_amdgcn_sinf(fr); }
    for (int e = gt; e < 65536; e += NTH) { const int jj = e >> 15, rem = e & 32767, sb = rem >> 12, row = (rem >> 6) & 63, c4 = rem & 63;
        const size_t so = ((size_t)((jj * 8 + sb) * 128 + 64 + row)) * 256 + 4 * c4, dof = ((size_t)((jj * 8 + sb) * 128 + row)) * 256 + 4 * c4;
        *(f32x4*)(pk->out + OKS + dof) = *(const f32x4*)(pk->in[2] + so); *(f32x4*)(pk->out + OVS + dof) = *(const f32x4*)(pk->in[3] + so); }
}

__device__ __forceinline__ void attn_phase(KP pk, char* lds, int j, int vcu, int G) {
    int tid_ = threadIdx.x; asm volatile("" : "+v"(tid_)); const int tid = tid_, lane = tid & 63, w = __builtin_amdgcn_readfirstlane(tid >> 6), l15 = lane & 15, q4 = lane >> 4;
    bf16_t* Ks = (bf16_t*)lds; bf16_t* Vt = (bf16_t*)(lds + 27648);
    const bf16_t* Qb = (const bf16_t*)(pk->ws + WS_POOL); bf16_t* Ob = (bf16_t*)(pk->ws + WS_POOL + ACT);
    const bf16_t* Kb = (const bf16_t*)(pk->ws + WS_POOL + 2 * ACT); const bf16_t* Vb = Kb + (size_t)MT * 256;
    const float* ck = pk->in[2] + (size_t)j * 8 * 128 * 256; const float* cv = pk->in[3] + (size_t)j * 8 * 128 * 256; const float* sinks = pk->in[9] + j * 16;
    for (int unit = vcu; unit < 2080; unit += G) {
        int qrow0, kvh, kt0, sb = -1;
        if (unit < 2048) { const int b = unit >> 9, c = (unit >> 2) & 127; kvh = unit & 3; qrow0 = b * 8192 + c * 64; kt0 = c >= 2 ? 0 : (c == 1 ? 4 : 8); }
        else { const int u2 = unit - 2048; sb = u2 >> 2; kvh = u2 & 3; qrow0 = MP + sb * 64; kt0 = 0; }
        __syncthreads();
#pragma unroll
        for (int i = 0; i < 3; ++i) { const int ch = tid + 512 * i, key = ch >> 3, dc = ch & 7; u32x4 kv = {0u, 0u, 0u, 0u}, vv = kv;
            if (key >= 16 * kt0) {
                if (sb >= 0 && key < 128) { const size_t so = ((size_t)(sb * 128 + key) * 4 + kvh) * 64 + 8 * dc;
                    const f32x4 a = *(const f32x4*)(ck + so), b = *(const f32x4*)(ck + so + 4), c = *(const f32x4*)(cv + so), d = *(const f32x4*)(cv + so + 4);
                    kv.x = pkbf(a[0], a[1]); kv.y = pkbf(a[2], a[3]); kv.z = pkbf(b[0], b[1]); kv.w = pkbf(b[2], b[3]);
                    vv.x = pkbf(c[0], c[1]); vv.y = pkbf(c[2], c[3]); vv.z = pkbf(d[0], d[1]); vv.w = pkbf(d[2], d[3]); }
                else { const size_t so = (size_t)(qrow0 - 128 + key) * 256 + kvh * 64 + 8 * dc; kv = *(const u32x4*)(Kb + so); vv = *(const u32x4*)(Vb + so); }
            }
            *(u32x4*)(Ks + key * 72 + 8 * dc) = kv;
#pragma unroll
            for (int e = 0; e < 8; ++e) Vt[(8 * dc + e) * 200 + ((((key >> 3) ^ dc) << 3) | (key & 7))] = (u16)(vv[e >> 1] >> (16 * (e & 1)));
        }
        __syncthreads();
#pragma unroll 1
        for (int qt = 0; qt < 2; ++qt) {
            const int qi = 2 * w + qt, g = qi >> 2, t0 = 16 * (qi & 3), head = kvh * 4 + g;
            const bf16_t* qp = Qb + (size_t)(qrow0 + t0 + l15) * 1024 + head * 64 + 8 * q4;
            const bf16x8 qf0 = *(const bf16x8*)qp, qf1 = *(const bf16x8*)(qp + 32);
            f32x4 s[12]; const float sink2 = sinks[head] * LOG2E; float mx = sink2;
#pragma unroll
            for (int kt = 0; kt < 12; ++kt) { const bf16_t* kp = Ks + (16 * kt + l15) * 72 + 8 * q4;
                f32x4 a = {0.f, 0.f, 0.f, 0.f}; a = mfma16(*(const bf16x8*)kp, qf0, a); a = mfma16(*(const bf16x8*)(kp + 32), qf1, a);
                if (kt < kt0) a = (f32x4){-INFINITY, -INFINITY, -INFINITY, -INFINITY};
                s[kt] = a; mx = fmaxf(fmaxf(mx, fmaxf(a[0], a[1])), fmaxf(a[2], a[3])); asm volatile("" ::: "memory"); }
            mx = fmaxf(mx, __shfl_xor(mx, 16)); mx = fmaxf(mx, __shfl_xor(mx, 32));
            float ls = 0.f;
#pragma unroll
            for (int kt = 0; kt < 12; ++kt)
#pragma unroll
                for (int e = 0; e < 4; ++e) { const float pe = __builtin_amdgcn_exp2f(s[kt][e] - mx); s[kt][e] = pe; ls += pe; }
            ls += __shfl_xor(ls, 16); ls += __shfl_xor(ls, 32); ls += __builtin_amdgcn_exp2f(sink2 - mx);
            const float rl = 1.f / ls;
            f32x4 o[4];
#pragma unroll
            for (int dt = 0; dt < 4; ++dt) o[dt] = (f32x4){0.f, 0.f, 0.f, 0.f};
#pragma unroll
            for (int kp = 0; kp < 6; ++kp) { u32x4 pw; pw.x = pkbf(s[2 * kp][0], s[2 * kp][1]); pw.y = pkbf(s[2 * kp][2], s[2 * kp][3]); pw.z = pkbf(s[2 * kp + 1][0], s[2 * kp + 1][1]); pw.w = pkbf(s[2 * kp + 1][2], s[2 * kp + 1][3]);
                const bf16x8 pf = __builtin_bit_cast(bf16x8, pw);
#pragma unroll
                for (int dt = 0; dt < 4; ++dt) { const int vd = 16 * dt + l15, vsw = (vd >> 3) & 7, vc0 = 4 * kp + (q4 >> 1); const bf16_t* vrow = Vt + vd * 200 + 4 * (q4 & 1); const u32x2 lo = *(const u32x2*)(vrow + ((vc0 ^ vsw) << 3)), hi = *(const u32x2*)(vrow + (((vc0 + 2) ^ vsw) << 3));
                    u32x4 aw; aw.x = lo.x; aw.y = lo.y; aw.z = hi.x; aw.w = hi.y; o[dt] = mfma16(__builtin_bit_cast(bf16x8, aw), pf, o[dt]); } asm volatile("" ::: "memory"); }
            bf16_t* stg = (bf16_t*)(lds + 53248) + w * 1152;
#pragma unroll
            for (int dt = 0; dt < 4; ++dt) { u32x2 ow; ow.x = pkbf(o[dt][0] * rl, o[dt][1] * rl); ow.y = pkbf(o[dt][2] * rl, o[dt][3] * rl); *(u32x2*)(stg + l15 * 72 + 16 * dt + 4 * q4) = ow; }
            asm volatile("s_waitcnt lgkmcnt(0)" ::: "memory");
#pragma unroll
            for (int i = 0; i < 2; ++i) { const int row = 8 * i + (lane >> 3), chn = lane & 7; *(u32x4*)(Ob + (size_t)(qrow0 + t0 + row) * 1024 + head * 64 + 8 * chn) = *(const u32x4*)(stg + row * 72 + 8 * chn); }
            asm volatile("s_waitcnt lgkmcnt(0)" ::: "memory");
        }
    }
}

__device__ __forceinline__ void hgrn_item(int it, int& m0, int& h) { if (it < 4096) { h = it & 7; m0 = (it >> 10) * 8192 + ((it >> 3) & 127) * 64; } else { const int x = it - 4096; h = x & 7; m0 = MP + (x >> 3) * 64; } }
constexpr int HL_ZS = 0, HL_TOT = 16384, HL_KT = 18432, HL_VT = 36864, HL_QS = 55296, HL_KS = 72704, HL_ST = 90112, HL_SSQ = 124928;

#define HGRN_STAGE_ZV() \
    _Pragma("unroll") for (int i = 0; i < 2; ++i) { const int ch = tid + 512 * i, row = ch >> 4, cc = ch & 15; \
        *(u32x4*)(ZS + row * 128 + 8 * cc) = zfr[i]; const u32x4 vv = vr[i]; \
        _Pragma("unroll") for (int e = 0; e < 8; ++e) VT[(8 * cc + e) * 72 + ((((row >> 3) ^ (cc & 7)) << 3) | (row & 7))] = (u16)(vv[e >> 1] >> (16 * (e & 1))); }
#define HGRN_GATES() \
    float kk[16], bl[16]; float cum = 0.f; \
    _Pragma("unroll") for (int i = 0; i < 16; ++i) { const float z = fminf(fmaxf((float)ZS[(16 * seg + i) * 128 + k], -30.f), 30.f); const float ez = __builtin_amdgcn_exp2f(-1.4426950408889634f * z), sg = __builtin_amdgcn_rcpf(1.f + ez); cum += __logf(lbv + oml * sg); bl[i] = cum; kk[i] = oml * ez * sg; } \
    TOT[seg * 128 + k] = cum; \
    __syncthreads(); \
    const float t0_ = TOT[k], t1_ = TOT[128 + k], t2_ = TOT[256 + k], t3_ = TOT[384 + k]; \
    const float off = seg == 0 ? 0.f : seg == 1 ? t0_ : seg == 2 ? t0_ + t1_ : t0_ + t1_ + t2_; const float b31 = t0_ + t1_;

__device__ __forceinline__ void hgrn_passA(KP pk, char* lds, int j, int vcu, int G, bool dost) {
    int tid_ = threadIdx.x; asm volatile("" : "+v"(tid_)); const int tid = tid_, lane = tid & 63, w = __builtin_amdgcn_readfirstlane(tid >> 6), l15 = lane & 15, q4 = lane >> 4, k = tid & 127, seg = tid >> 7;
    _Float16* ZS = (_Float16*)(lds + HL_ZS); float* TOT = (float*)(lds + HL_TOT); bf16_t* KT = (bf16_t*)(lds + HL_KT); bf16_t* VT = (bf16_t*)(lds + HL_VT);
    const u16* ZF = (const u16*)(pk->ws + WS_POOL + ACT); const u16* VH = (const u16*)(pk->ws + WS_POOL + 2 * ACT);
    bf16_t* UB = (bf16_t*)(pk->out + OY); float* DB = (float*)(pk->ws + WS_DB);
    float lbv = 0.f, oml = 1.f; int hprev = -1;
    u32x4 zfr[2], vr[2];
#define PA_LOAD(itx) { int m0_, h_; hgrn_item(itx, m0_, h_); _Pragma("unroll") for (int i = 0; i < 2; ++i) { const int ch = tid + 512 * i; const size_t go = (size_t)(m0_ + (ch >> 4)) * 1024 + h_ * 128 + 8 * (ch & 15); zfr[i] = *(const u32x4*)(ZF + go); vr[i] = *(const u32x4*)(VH + go); } }
    if (vcu < 4160) PA_LOAD(vcu)
    for (int it = vcu; it < 4160; it += G) {
        int m0, h; hgrn_item(it, m0, h);
        if (j == 1 && h != hprev) { const float a = pk->in[11][h * 128 + k], b = pk->in[11][1024 + h * 128 + k]; lbv = 1.f / (1.f + __expf(a - b)); oml = 1.f - lbv; hprev = h; }
        __syncthreads();
        HGRN_STAGE_ZV()
        if (it + G < 4160) PA_LOAD(it + G)
        __syncthreads();
        HGRN_GATES()
        { u32x4 w0, w1; unsigned wk[8];
#pragma unroll
          for (int i = 0; i < 8; ++i) wk[i] = pkbf(kk[2 * i] * __expf(b31 - (off + bl[2 * i])), kk[2 * i + 1] * __expf(b31 - (off + bl[2 * i + 1])));
          w0.x = wk[0]; w0.y = wk[1]; w0.z = wk[2]; w0.w = wk[3]; w1.x = wk[4]; w1.y = wk[5]; w1.z = wk[6]; w1.w = wk[7];
          *(u32x4*)(KT + k * 72 + 16 * seg) = w0; *(u32x4*)(KT + k * 72 + 16 * seg + 8) = w1; }
        if (seg == 0) DB[(size_t)it * 128 + k] = __expf(b31 + t2_ + t3_);
        __syncthreads();
        const int kr = 16 * w + l15;
        const bf16x8 b0 = *(const bf16x8*)(KT + kr * 72 + 8 * q4), b1 = *(const bf16x8*)(KT + kr * 72 + 32 + 8 * q4);
        const float sc = __expf(TOT[256 + kr] + TOT[384 + kr]);
        bf16_t* stg = (bf16_t*)(lds + HL_QS) + w * 2176;
#pragma unroll
        for (int vt = 0; vt < 8; ++vt) { const int vv_ = 16 * vt + l15, vsw = (vv_ >> 3) & 7; const bf16_t* vp = VT + vv_ * 72; f32x4 a = {0.f, 0.f, 0.f, 0.f};
            a = mfma16(*(const bf16x8*)(vp + ((q4 ^ vsw) << 3)), b0, a); a = mfma16(*(const bf16x8*)(vp + (((4 + q4) ^ vsw) << 3)), b1, a);
            u32x2 ow; ow.x = pkbf(a[0] * sc, a[1] * sc); ow.y = pkbf(a[2] * sc, a[3] * sc); *(u32x2*)(stg + l15 * 136 + 16 * vt + 4 * q4) = ow; }
        asm volatile("s_waitcnt lgkmcnt(0)" ::: "memory");
        { bf16_t* up = UB + (size_t)it * 16384 + (16 * w) * 128;
#pragma unroll
          for (int i = 0; i < 4; ++i) { const int row = 4 * i + (lane >> 4), chn = lane & 15; if (dost) *(u32x4*)(up + row * 128 + 8 * chn) = *(const u32x4*)(stg + row * 136 + 8 * chn); } }
    }
#undef PA_LOAD
}
__device__ __forceinline__ void hgrn_passB(KP pk, int j, int G, bool dost) {
    int tid_ = threadIdx.x; asm volatile("" : "+v"(tid_)); const int gt = blockIdx.x * 512 + tid_, NTH = G * 512;
    bf16_t* UB = (bf16_t*)(pk->out + OY); const float* DB = (const float*)(pk->ws + WS_DB);
    for (int e = gt; e < 131072; e += NTH) {
        const int bh = e >> 12, k = (e >> 5) & 127, v4 = e & 31, b = bh >> 3, h = bh & 7;
        f32x4 S = {0.f, 0.f, 0.f, 0.f};
        bf16_t* ub = UB + (size_t)(b * 1024 + h) * 16384 + k * 128 + 4 * v4; const float* db = DB + (size_t)(b * 1024 + h) * 128 + k;
#pragma unroll 1
        for (int c0 = 0; c0 < 128; c0 += 16) {
            u32x2 uu[16]; float d[16];
#pragma unroll
            for (int i = 0; i < 16; ++i) { uu[i] = *(const u32x2*)(ub + (size_t)(c0 + i) * 8 * 16384); d[i] = db[(size_t)(c0 + i) * 1024]; }
#pragma unroll
            for (int i = 0; i < 16; ++i) { u32x2 sw; sw.x = pkbf(S[0], S[1]); sw.y = pkbf(S[2], S[3]); if (dost) *(u32x2*)(ub + (size_t)(c0 + i) * 8 * 16384) = sw;
                S[0] = d[i] * S[0] + bflo(uu[i].x); S[1] = d[i] * S[1] + bfhi(uu[i].x); S[2] = d[i] * S[2] + bflo(uu[i].y); S[3] = d[i] * S[3] + bfhi(uu[i].y); }
        }
        if (dost) *(f32x4*)(pk->out + OSP + (size_t)(j * 32 + bh) * 16384 + k * 128 + 4 * v4) = S;
    }
    for (int e = gt; e < 262144; e += NTH) {
        const int sbh = e >> 12, k = (e >> 5) & 127, v4 = e & 31, it = 4096 + sbh; const size_t eo = (size_t)k * 128 + 4 * v4;
        const f32x4 S0 = *(const f32x4*)(pk->in[4] + (size_t)(j * 64 + sbh) * 16384 + eo);
        bf16_t* ub = UB + (size_t)it * 16384 + eo; const u32x2 uu = *(const u32x2*)ub; const float d = DB[(size_t)it * 128 + k];
        u32x2 sw; sw.x = pkbf(S0[0], S0[1]); sw.y = pkbf(S0[2], S0[3]); if (dost) *(u32x2*)ub = sw;
        f32x4 S; S[0] = d * S0[0] + bflo(uu.x); S[1] = d * S0[1] + bfhi(uu.x); S[2] = d * S0[2] + bflo(uu.y); S[3] = d * S0[3] + bfhi(uu.y);
        if (dost) *(f32x4*)(pk->out + OSS + (size_t)(j * 64 + sbh) * 16384 + eo) = S;
    }
}
__device__ __forceinline__ void hgrn_passC(KP pk, char* lds, int j, int vcu, int G, bool dost) {
    int tid_ = threadIdx.x; asm volatile("" : "+v"(tid_)); const int tid = tid_, lane = tid & 63, w = __builtin_amdgcn_readfirstlane(tid >> 6), l15 = lane & 15, q4 = lane >> 4, k = tid & 127, seg = tid >> 7;
    _Float16* ZS = (_Float16*)(lds + HL_ZS); float* TOT = (float*)(lds + HL_TOT); bf16_t* VT = (bf16_t*)(lds + HL_VT);
    u16* QG = (u16*)(lds + HL_KT); bf16_t* QS = (bf16_t*)(lds + HL_QS); bf16_t* KS = (bf16_t*)(lds + HL_KS); bf16_t* ST = (bf16_t*)(lds + HL_ST); float* SSQ = (float*)(lds + HL_SSQ);
    u16* QH = (u16*)(pk->ws + WS_POOL); const u16* ZF = (const u16*)(pk->ws + WS_POOL + ACT); const u16* VH = (const u16*)(pk->ws + WS_POOL + 2 * ACT); const u16* GH = (const u16*)(pk->ws + WS_POOL + 3 * ACT);
    const bf16_t* UB = (const bf16_t*)(pk->out + OY); const float* onorm = pk->in[12] + j * 128;
    const int tt = w & 3, vh = w >> 2;
    float lbv = 0.f, oml = 1.f; int hprev = -1;
    float* ONL = (float*)(lds + HL_SSQ + 512); if (tid < 128) ONL[tid] = onorm[tid];
    u32x4 zfr[2], vr[2], qr[2], sr[4];
#define PC_LOAD(itx) { int m0_, h_; hgrn_item(itx, m0_, h_); _Pragma("unroll") for (int i = 0; i < 2; ++i) { const int ch = tid + 512 * i; const size_t go = (size_t)(m0_ + (ch >> 4)) * 1024 + h_ * 128 + 8 * (ch & 15); \
        zfr[i] = *(const u32x4*)(ZF + go); vr[i] = *(const u32x4*)(VH + go); qr[i] = *(const u32x4*)(QH + go); } \
        _Pragma("unroll") for (int i = 0; i < 4; ++i) { const int ch = tid + 512 * i; sr[i] = *(const u32x4*)(UB + (size_t)(itx) * 16384 + (ch >> 4) * 128 + 8 * (ch & 15)); } }
    if (vcu < 4160) PC_LOAD(vcu)
    for (int it = vcu; it < 4160; it += G) {
        int m0, h; hgrn_item(it, m0, h);
        if (j == 1 && h != hprev) { const float a = pk->in[11][h * 128 + k], b = pk->in[11][1024 + h * 128 + k]; lbv = 1.f / (1.f + __expf(a - b)); oml = 1.f - lbv; hprev = h; }
        __syncthreads();
        HGRN_STAGE_ZV()
#pragma unroll
        for (int i = 0; i < 2; ++i) { const int ch = tid + 512 * i; *(u32x4*)(QG + (ch >> 4) * 128 + 8 * (ch & 15)) = qr[i]; }
        u32x4 sc_[4];
#pragma unroll
        for (int i = 0; i < 4; ++i) sc_[i] = sr[i];
        u32x4 gr[2];
#pragma unroll
        for (int i = 0; i < 2; ++i) { const int ch = tid + 512 * i; gr[i] = *(const u32x4*)(GH + (size_t)(m0 + (ch >> 4)) * 1024 + h * 128 + 8 * (ch & 15)); }
        if (it + G < 4160) PC_LOAD(it + G)
        __syncthreads();
        HGRN_GATES()
        { u16* GS = (u16*)(lds + HL_ZS);
#pragma unroll
          for (int i = 0; i < 2; ++i) { const int ch = tid + 512 * i; *(u32x4*)(GS + (ch >> 4) * 128 + 8 * (ch & 15)) = gr[i]; } }
        float qv[16];
#pragma unroll
        for (int i = 0; i < 16; ++i) qv[i] = bf2f(QG[(16 * seg + i) * 128 + k]);
#pragma unroll
        for (int i = 0; i < 16; ++i) { const float bt = off + bl[i]; KS[(16 * seg + i) * 136 + k] = f2bf(kk[i] * __expf(b31 - bt)); QS[(16 * seg + i) * 136 + k] = f2bf(qv[i] * __expf(bt - b31)); }
#pragma unroll
        for (int i = 0; i < 4; ++i) { const int ch = tid + 512 * i, kr = ch >> 4, vc = ch & 15; const float sc = __expf(TOT[kr] + TOT[128 + kr]);
            const u32x4 sv = sc_[i];
#pragma unroll
            for (int e = 0; e < 8; ++e) { const unsigned wv = sv[e >> 1]; const float f = (e & 1) ? bfhi(wv) : bflo(wv); ST[(8 * vc + e) * 136 + ((((kr >> 3) ^ vc) << 3) | (kr & 7))] = f2bf(f * sc); } }
        __syncthreads();
        bf16x8 qf[4];
#pragma unroll
        for (int ks = 0; ks < 4; ++ks) qf[ks] = *(const bf16x8*)(QS + (16 * tt + l15) * 136 + 32 * ks + 8 * q4);
        f32x4 sc4[4];
#pragma unroll
        for (int st = 0; st < 4; ++st) { f32x4 a = {0.f, 0.f, 0.f, 0.f};
            if (st <= tt) {
#pragma unroll
                for (int ks = 0; ks < 4; ++ks) a = mfma16(*(const bf16x8*)(KS + (16 * st + l15) * 136 + 32 * ks + 8 * q4), qf[ks], a);
                if (st == tt) {
#pragma unroll
                    for (int r = 0; r < 4; ++r) if (4 * q4 + r > l15) a[r] = 0.f;
                }
            }
            sc4[st] = a; }
        f32x4 o[4];
#pragma unroll
        for (int vi = 0; vi < 4; ++vi) { const int vt = 4 * vh + vi; f32x4 a = {0.f, 0.f, 0.f, 0.f};
#pragma unroll
            for (int kp = 0; kp < 2; ++kp) if (2 * kp <= tt) {
                u32x4 pw; pw.x = pkbf(sc4[2 * kp][0], sc4[2 * kp][1]); pw.y = pkbf(sc4[2 * kp][2], sc4[2 * kp][3]); pw.z = pkbf(sc4[2 * kp + 1][0], sc4[2 * kp + 1][1]); pw.w = pkbf(sc4[2 * kp + 1][2], sc4[2 * kp + 1][3]);
                const int vv_ = 16 * vt + l15, vsw = (vv_ >> 3) & 7, vc0 = 4 * kp + (q4 >> 1); const bf16_t* vrow = VT + vv_ * 72 + 4 * (q4 & 1); const u32x2 lo = *(const u32x2*)(vrow + ((vc0 ^ vsw) << 3)), hi = *(const u32x2*)(vrow + (((vc0 + 2) ^ vsw) << 3));
                u32x4 aw; aw.x = lo.x; aw.y = lo.y; aw.z = hi.x; aw.w = hi.y; a = mfma16(__builtin_bit_cast(bf16x8, aw), __builtin_bit_cast(bf16x8, pw), a); }
#pragma unroll
            for (int ks = 0; ks < 4; ++ks) a = mfma16(*(const bf16x8*)(ST + (16 * vt + l15) * 136 + (((4 * ks + q4) ^ (((16 * vt + l15) >> 3) & 15)) << 3)), qf[ks], a);
            o[vi] = a; }
        float sq = 0.f;
#pragma unroll
        for (int vi = 0; vi < 4; ++vi) sq += (o[vi][0] * o[vi][0] + o[vi][1] * o[vi][1]) + (o[vi][2] * o[vi][2] + o[vi][3] * o[vi][3]);
        sq += __shfl_xor(sq, 16); sq += __shfl_xor(sq, 32);
        if (q4 == 0) SSQ[vh * 64 + 16 * tt + l15] = sq;
        __syncthreads();
        const float rn = rsqrtf((SSQ[16 * tt + l15] + SSQ[64 + 16 * tt + l15]) * (1.f / 128.f) + EPS);
        bf16_t* stg = (bf16_t*)(lds + HL_QS) + w * 1152;
#pragma unroll
        for (int vi = 0; vi < 4; ++vi) { const int v0 = 16 * (4 * vh + vi) + 4 * q4; const f32x4 gn = *(const f32x4*)(ONL + v0);
            const u32x2 g2 = *(const u32x2*)((const u16*)(lds + HL_ZS) + (16 * tt + l15) * 128 + v0); u32x2 ow;
            ow.x = pkbf(o[vi][0] * rn * gn[0] * bflo(g2.x), o[vi][1] * rn * gn[1] * bfhi(g2.x)); ow.y = pkbf(o[vi][2] * rn * gn[2] * bflo(g2.y), o[vi][3] * rn * gn[3] * bfhi(g2.y));
            *(u32x2*)(stg + l15 * 72 + 16 * vi + 4 * q4) = ow; }
        asm volatile("s_waitcnt lgkmcnt(0)" ::: "memory");
        if (dost) {
#pragma unroll
            for (int i = 0; i < 2; ++i) { const int row = 8 * i + (lane >> 3), chn = lane & 7; *(u32x4*)(QH + (size_t)(m0 + 16 * tt + row) * 1024 + h * 128 + 64 * vh + 8 * chn) = *(const u32x4*)(stg + row * 72 + 8 * chn); } }
    }
#undef PC_LOAD
}
__device__ __forceinline__ void final_phase(KP pk, int vcu, int G) {
    int tid_ = threadIdx.x; asm volatile("" : "+v"(tid_)); const int tid = tid_, lane = tid & 63, w = tid >> 6; const int gw = vcu * 8 + w, NGW = G * 8;
    float* Y = pk->out + OY; const bf16_t* XB = (const bf16_t*)(pk->ws + WS_XB); const float* ss = (const float*)(pk->ws + WS_SS) + (size_t)(8 % 3) * SS_SLOT; const float* fn = pk->in[16];
    f32x4 g[4];
#pragma unroll
    for (int q = 0; q < 4; ++q) g[q] = *(const f32x4*)(fn + 256 * q + 4 * lane);
    for (int r0 = gw; r0 < MT; r0 += 4 * NGW) {
        u32x2 xv[4][4]; float pv[4];
#pragma unroll
        for (int t = 0; t < 4; ++t) { const int r = r0 + t * NGW < MT ? r0 + t * NGW : r0;
            pv[t] = lane < 16 ? ss[(size_t)r * 16 + lane] : 0.f;
#pragma unroll
            for (int q = 0; q < 4; ++q) xv[t][q] = *(const u32x2*)(XB + (size_t)r * 1024 + 256 * q + 4 * lane); }
#pragma unroll
        for (int t = 0; t < 4; ++t) { const int r = r0 + t * NGW; if (r >= MT) break;
            float s = pv[t];
#pragma unroll
            for (int o = 1; o < 16; o <<= 1) s += __shfl_xor(s, o);
            s = __shfl(s, 0); const float rs = rsqrtf(s * (1.f / 1024.f) + EPS);
#pragma unroll
            for (int q = 0; q < 4; ++q) { f32x4 y; y[0] = bflo(xv[t][q].x) * rs * g[q][0]; y[1] = bfhi(xv[t][q].x) * rs * g[q][1]; y[2] = bflo(xv[t][q].y) * rs * g[q][2]; y[3] = bfhi(xv[t][q].y) * rs * g[q][3];
                *(f32x4*)(Y + (size_t)r * 1024 + 256 * q + 4 * lane) = y; } }
    }
}

#ifndef STAG_MODE
#define STAG_MODE 0
#endif
#ifndef STAG_T
#define STAG_T 26
#endif
__device__ __forceinline__ void stagger(int bx, int usec_total) {
    if (STAG_MODE == 0) return;
    const int grp = STAG_MODE == 1 ? (bx & 7) : ((bx >> 3) & 7);
    const unsigned long long t0 = __builtin_amdgcn_s_memrealtime(); const unsigned long long dt = (unsigned long long)(grp * usec_total * 100 / 8);
    while (__builtin_amdgcn_s_memrealtime() - t0 < dt) __builtin_amdgcn_s_sleep(8);
}

constexpr int LDS_BYTES = 147456;
constexpr int PH_A = 3 + 2 * NHALF, PH_H = 5 + 2 * NHALF, NPHASE = 2 + 2 * (PH_A + PH_H);
#ifndef SKIPMASK
#define SKIPMASK 0
#endif
#ifndef PROBE_KIND
#define PROBE_KIND -1
#endif
#ifndef PROBE_REP
#define PROBE_REP 1
#endif
#ifndef PROBE_NOEPI
#define PROBE_NOEPI 0
#endif
__global__ void __launch_bounds__(512, 2) fwd_kernel(Params p_unused) {
    extern __shared__ __attribute__((aligned(16))) unsigned char lds[];
    cg::grid_group grid = cg::this_grid();
    const int G = gridDim.x, bx = blockIdx.x; const int vcu = (G % 8 == 0) ? (bx % 8) * (G / 8) + bx / 8 : bx;
    volatile LAS unsigned* misc = (volatile LAS unsigned*)((LAS unsigned char*)lds + 131072 + 320);
    if (threadIdx.x < 64) misc[threadIdx.x] = 0u;
    __syncthreads();
    int ph, ph_hi; XcdBarrier bar; { KP k0 = kargs(); ph = k0->ph_lo; ph_hi = k0->ph_hi; bar.bar = (unsigned*)(k0->ws + WS_CTL) + 4096; bar.x = 0u; bar.st = misc + 8; }
    for (; ph < ph_hi; ++ph) {
        int layer = 0, kind, half = 0;
        if (ph == 0) kind = 0; else if (ph == NPHASE - 1) kind = 10;
        else { int q = ph - 1; if (q < PH_A) { layer = 0; } else if (q < PH_A + PH_H) { layer = 1; q -= PH_A; } else if (q < 2 * PH_A + PH_H) { layer = 2; q -= PH_A + PH_H; } else { layer = 3; q -= 2 * PH_A + PH_H; }
            if (layer & 1) { if (q < 4) kind = 6 + q; else if (q == 4) kind = 3; else { kind = 4 + ((q - 5) & 1); half = (q - 5) >> 1; } }
            else { if (q < 3) kind = 1 + q; else { kind = 4 + ((q - 3) & 1); half = (q - 3) >> 1; } } }
        const int j = layer >> 1;
        int nrep = 1; if (kind == PROBE_KIND) nrep = PROBE_REP;
        for (int rep = 0; rep < nrep; ++rep) {
        if (rep) xcd_barrier(bar);
        KP pk = kargs();
        if (kind == 0) { if (!(SKIPMASK & 1)) prologue(pk, (char*)lds, vcu, G); }
        else if (kind == 1 && !(SKIPMASK & 2)) {
            stagger(bx, STAG_T);
            unsigned char* ws = pk->ws; float* out = pk->out; bf16_t* WB = (bf16_t*)(ws + WS_W); float* ssb = (float*)(ws + WS_SS);
            pg8::Gemm g{(bf16_t*)(ws + WS_XB), WB + wmat_off(layer, 0), MT, 1536, 1024}; pg8::StaticOrder S; S.init(MP, 1536, 1024, G, bx); S.split(128, 2, 4);
            EpiQKV E{ws, out, j, (2 * layer) % 3};
            EpiMix<EpiQKV> EM{E, (float*)(ws + WS_SPK), (unsigned*)(ws + WS_CTL + 32768) + ph * 256, 4, 128, 2, (PROBE_NOEPI && rep + 1 < nrep) ? 0u : 0xffu};
            pg8::gemm_phase<EpiMix<EpiQKV>, pg8::StaticOrder, PG_ALIGN, PG_SP2>((PG8_LAS unsigned char*)lds, g, S, EM);
        } else if (kind == 2) { if (!(SKIPMASK & 4)) attn_phase(pk, (char*)lds, j, vcu, G); }
        else if ((kind == 3 || kind == 5) && !(SKIPMASK & 8)) {
            unsigned char* ws = pk->ws; bf16_t* WB = (bf16_t*)(ws + WS_W); float* ssb = (float*)(ws + WS_SS);
            const bool dn = kind == 5; const int K = dn ? 4096 : 1024;
            const bf16_t* A = dn ? (const bf16_t*)(ws + WS_POOL) - (size_t)(half * HROWS) * 4096 : ((layer & 1) ? (const bf16_t*)(ws + WS_POOL) : (const bf16_t*)(ws + WS_POOL + ACT));
            pg8::Gemm g{A, WB + wmat_off(layer, dn ? 3 : 1), MT, 1024, K}; pg8::StaticOrder S;
            if (dn) { S.init(HROWS, 1024, K, G, bx, half * (HROWS / 256)); if (half == NHALF - 1) S.split(128, 2, 8); } else { S.init(MP, 1024, K, G, bx); S.split(128, 2, 4); }
            EpiRes E{(bf16_t*)(ws + WS_XB), ssb + (size_t)((2 * layer + (dn ? 2 : 1)) % 3) * SS_SLOT};
            EpiMix<EpiRes> EM{E, (float*)(ws + WS_SPK), (unsigned*)(ws + WS_CTL + 32768) + ph * 256, dn ? 8 : 4, 128, 2, (PROBE_NOEPI && rep + 1 < nrep) ? 0u : 0xffu};
            pg8::gemm_phase<EpiMix<EpiRes>, pg8::StaticOrder, PG_ALIGN, PG_SP2>((PG8_LAS unsigned char*)lds, g, S, EM);
        } else if (kind == 4 && !(SKIPMASK & 16)) {
            unsigned char* ws = pk->ws; bf16_t* WB = (bf16_t*)(ws + WS_W); float* ssb = (float*)(ws + WS_SS);
            pg8::Gemm g{(bf16_t*)(ws + WS_XB), WB + wmat_off(layer, 2), MT, 4096, 1024}; pg8::StaticOrder S; S.init(HROWS, 4096, 1024, G, bx, half * (HROWS / 256)); if (half == NHALF - 1) S.split(128, 2, 4);
            EpiUp E{ssb + (size_t)((2 * layer + 1) % 3) * SS_SLOT, (bf16_t*)(ws + WS_POOL) - (size_t)(half * HROWS) * 4096, (PROBE_NOEPI == 2 && rep + 1 < nrep) ? 255 : (PROBE_NOEPI == 3 && rep + 1 < nrep) ? 0x7ffffffe : 0x7fffffff};
            EpiMix<EpiUp> EM{E, (float*)(ws + WS_SPK), (unsigned*)(ws + WS_CTL + 32768) + ph * 256, 4, 128, 2, 0xffu};
            pg8::gemm_phase<EpiMix<EpiUp>, pg8::StaticOrder, PG_ALIGN, PG_SP2>((PG8_LAS unsigned char*)lds, g, S, EM);
        } else if (kind == 6 && !(SKIPMASK & 32)) {
            stagger(bx, STAG_T);
            unsigned char* ws = pk->ws; bf16_t* WB = (bf16_t*)(ws + WS_W); float* ssb = (float*)(ws + WS_SS);
            pg8::Gemm g{(bf16_t*)(ws + WS_XB), WB + wmat_off(layer, 0), MT, 4096, 1024}; pg8::StaticOrder S; S.init(MP, 4096, 1024, G, bx); S.split(128, 2, 4);
            EpiHin E{ssb + (size_t)((2 * layer) % 3) * SS_SLOT, (u16*)(ws + WS_POOL)};
            EpiMix<EpiHin> EM{E, (float*)(ws + WS_SPK), (unsigned*)(ws + WS_CTL + 32768) + ph * 256, 4, 128, 2, (PROBE_NOEPI && rep + 1 < nrep) ? 0u : 0xffu};
            pg8::gemm_phase<EpiMix<EpiHin>, pg8::StaticOrder, PG_ALIGN, PG_SP2>((PG8_LAS unsigned char*)lds, g, S, EM);
        } else if (kind == 7) { if (!(SKIPMASK & 64)) hgrn_passA(pk, (char*)lds, j, vcu, G, !(PROBE_NOEPI && rep + 1 < nrep)); }
        else if (kind == 8) { if (!(SKIPMASK & 128)) hgrn_passB(pk, j, G, !(PROBE_NOEPI && rep + 1 < nrep)); }
        else if (kind == 9) { if (!(SKIPMASK & 256)) hgrn_passC(pk, (char*)lds, j, vcu, G, !(PROBE_NOEPI && rep + 1 < nrep)); }
        else if (kind == 10) { if (!(SKIPMASK & 512)) final_phase(pk, vcu, G); }
        }
        if (PROBE_KIND == 99 && ph == 3) for (int e = 0; e < PROBE_REP; ++e) xcd_barrier(bar);
        if (ph + 1 < ph_hi) { if (ph == 0) { grid.sync(); KP k1 = kargs(); bar = xcd_barrier_post((unsigned*)(k1->ws + WS_CTL) + 4096, misc + 8); } else xcd_barrier(bar); }
    }
}

#ifndef MK_PER_PHASE
#define MK_PER_PHASE 0
#endif
extern "C" void kernel_launch(void* const* d_in, const int* in_sizes, int n_in, void* d_out, int out_size, void* d_ws, size_t ws_size, hipStream_t stream) {
    static int grid = 0;
    if (grid == 0) {
        int dev = 0, cus = 0, per_cu = 0;
        hipGetDevice(&dev); hipDeviceGetAttribute(&cus, hipDeviceAttributeMultiprocessorCount, dev);
        hipFuncSetAttribute((const void*)fwd_kernel, hipFuncAttributeMaxDynamicSharedMemorySize, LDS_BYTES);
        hipOccupancyMaxActiveBlocksPerMultiprocessor(&per_cu, (const void*)fwd_kernel, 512, LDS_BYTES);
        (void)hipGetLastError();
        if (per_cu < 1) { fprintf(stderr, "kernel_launch: occupancy query says %d blocks/CU\n", per_cu); per_cu = 1; }
        grid = cus;
        if (n_in != 17 || ws_size < WS_SS + 3 * SS_SLOT * 4) { fprintf(stderr, "kernel_launch: unexpected n_in %d / ws_size %zu (need %zu)\n", n_in, ws_size, (size_t)WS_END); }
    }
    Params p{};
    for (int i = 0; i < 17; ++i) p.in[i] = (const float*)d_in[i];
    p.out = (float*)d_out; p.ws = (unsigned char*)d_ws;
#if MK_PER_PHASE
    for (int ph = 0; ph < NPHASE; ++ph) { p.ph_lo = ph; p.ph_hi = ph + 1; hipLaunchKernelGGL(fwd_kernel, dim3(grid), dim3(512), LDS_BYTES, stream, p); }
#else
    p.ph_lo = 0; p.ph_hi = NPHASE;
    void* args[] = {&p};
    hipError_t e = hipLaunchCooperativeKernel((const void*)fwd_kernel, dim3(grid), dim3(512), args, LDS_BYTES, stream);
    if (e != hipSuccess) fprintf(stderr, "cooperative launch failed: %s (grid %d)\n", hipGetErrorString(e), grid);
#endif
}
```

```cpp
#include <hip/hip_runtime.h>
#include <hip/hip_cooperative_groups.h>
#include <cstdio>
#include <cstdint>
namespace cg = cooperative_groups;
#ifndef PG_WGM
#define PG_WGM 8
#endif
#ifndef PG_ALIGN
#define PG_ALIGN true
#endif
#ifndef PG_SP2
#define PG_SP2 true
#endif
namespace pg8 {
#define PG8_LAS __attribute__((address_space(3)))
typedef unsigned short bf16_t;
typedef short bf16x8 __attribute__((ext_vector_type(8)));
typedef float f32x4 __attribute__((ext_vector_type(4)));
typedef unsigned u32x4 __attribute__((ext_vector_type(4)));
constexpr int BM = 256, BK = 64, HALF = 128, HTB = HALF * BK * 2  , STAGE_BYTES = 8 * HTB, NXCD = 8, WGM = PG_WGM;

__host__ __device__ __forceinline__ int lds_byte(int r, int c) { const int st = (r >> 4) * 2 + (c >> 5), rr = r & 15, cc = c & 31, ob = rr * 64 + cc * 2; return st * 1024 + (ob ^ (((ob >> 9) & 1) << 5)); }
__host__ __device__ __forceinline__ void stage_rc(int b, int& R, int& C) { const int st = b / 1024, sb = b % 1024, swz = sb ^ (((sb >> 9) & 1) << 5); R = (st >> 1) * 16 + swz / 64; C = (st & 1) * 32 + (swz % 64) / 2; }
__host__ __device__ __forceinline__ int perm32(int rho) { const int n = rho >> 4, i = rho & 15; return 8 * (i >> 2) + 4 * n + (i & 3); }

struct Unit { int pm, pn, k0, nt, sp; };
struct Gemm { const bf16_t* A; const bf16_t* Bt; int M, N, K; };

struct StaticOrder {
    int nM, nN, nwg, G, c, ntK, pm0;
    int sM0, sNM, sS, sKs, nsp;
    __host__ __device__ void init(int M, int N, int K, int G_, int c_, int pm0_ = 0) { pm0 = pm0_; nM = M / BM; nN = N / BM; nwg = nM * nN; G = G_; c = c_; ntK = K / BK; sM0 = 0; sNM = 0; sS = 1; sKs = K; nsp = 0; }
    __host__ __device__ void split(int m0, int nm, int S) { sM0 = m0; sNM = nm; sS = S; sKs = (ntK / S) * BK; nsp = nm * nN * S; }
    __host__ __device__ bool next(int i, Unit& u) const {
        const long L = (long)i * G + c;
        if (L >= nwg) { const long L2 = L - (long)((nwg + G - 1) / G) * G; if (L2 < 0 || L2 >= nsp) return false;
            const int ks = (int)(L2 % sS), un = (int)(L2 / sS); u.pm = sM0 + un % sNM; u.pn = un / sNM; u.k0 = ks * sKs; u.nt = sKs / BK; u.sp = ks; return true; }
        int wgid = (int)L; { const int q = nwg / NXCD, r = nwg % NXCD, xcd = wgid % NXCD, off = wgid / NXCD; wgid = (xcd < r ? xcd * (q + 1) : r * (q + 1) + (xcd - r) * q) + off; }
        const int nig = WGM * nN, gid = wgid / nig, fm = gid * WGM, gsz = (nM - fm) < WGM ? (nM - fm) : WGM;
        u.pm = pm0 + fm + ((wgid % nig) % gsz); u.pn = (wgid % nig) / gsz; u.k0 = 0; u.nt = ntK; u.sp = -1; return true;
    }
    __device__ __forceinline__ void a_ready(const Unit&) const {}
    __device__ __forceinline__ void done(const Unit&) const {}
};

__device__ __forceinline__ unsigned cvt_pk_bf16(float lo, float hi) { unsigned r; asm volatile("v_cvt_pk_bf16_f32 %0, %1, %2" : "=v"(r) : "v"(lo), "v"(hi)); return r; }
typedef float f32x2 __attribute__((ext_vector_type(2)));
template <class Epi, class Sched, bool ALIGN_EPI = false, bool SP2 = false>
__device__ __forceinline__ void gemm_phase(PG8_LAS unsigned char* lds, const Gemm g, const Sched& S, const Epi& E) {
    int tid_ = threadIdx.x; asm volatile("" : "+v"(tid_)); const int tid = tid_, wid = __builtin_amdgcn_readfirstlane(tid >> 6), lane = tid & 63, wr = wid >> 2, wc = wid & 3, fr = lane & 15, fq = lane >> 4;
    const int K = g.K;
    unsigned voffA[2], voffB[2];
#pragma unroll
    for (int i = 0; i < 2; ++i) { int R, C; stage_rc(tid * 16 + i * 8192, R, C); const int Rb = Epi::PERM ? ((R & ~31) + perm32(R & 31)) : R;
        voffA[i] = (unsigned)(R * K + C) * 2u; voffB[i] = (unsigned)(Rb * K + C) * 2u; }
    const size_t kstep = (size_t)(BK * 2);
    const size_t hstep = (size_t)HALF * K * 2;
    const size_t tstep = 2 * hstep;
    const unsigned ldsw = (unsigned)wid * 1024u;
    const int aoff = lds_byte(wr * 64 + fr, fq * 8), boff = lds_byte(wc * 32 + fr, fq * 8);
#define PG8_SA(b, h) (((b) * 2 + (h)) * HTB)
#define PG8_SB(b, h) ((4 + (b) * 2 + (h)) * HTB)
#define PG8_STAGE(bufoff, gbase, voff) do { _Pragma("unroll") for (int _i = 0; _i < 2; ++_i) \
        __builtin_amdgcn_global_load_lds((const unsigned*)((const char*)(gbase) + (voff)[_i]), (PG8_LAS unsigned*)(lds + (bufoff) + ldsw + _i * 8192), 16, 0, 0); } while (0)
#define PG8_LDA(dst, b, h) do { _Pragma("unroll") for (int m = 0; m < 4; ++m) _Pragma("unroll") for (int k = 0; k < 2; ++k) dst[m][k] = *(const PG8_LAS bf16x8*)(lds + PG8_SA(b, h) + aoff + m * 2048 + k * 1024); } while (0)
#define PG8_LDB(dst, b, h) do { _Pragma("unroll") for (int n = 0; n < 2; ++n) _Pragma("unroll") for (int k = 0; k < 2; ++k) dst[n][k] = *(const PG8_LAS bf16x8*)(lds + PG8_SB(b, h) + boff + n * 2048 + k * 1024); } while (0)
#define PG8_MMA(ai, bj, At, Bt) do { __builtin_amdgcn_s_setprio(1); _Pragma("unroll") for (int m = 0; m < 4; ++m) _Pragma("unroll") for (int n = 0; n < 2; ++n) _Pragma("unroll") for (int k = 0; k < 2; ++k) \
        acc[ai][bj][m][n] = __builtin_amdgcn_mfma_f32_16x16x32_bf16(Bt[n][k], At[m][k], acc[ai][bj][m][n], 0, 0, 0); __builtin_amdgcn_s_setprio(0); } while (0)
#define PG8_WAIT_V(n) asm volatile("s_waitcnt vmcnt(" #n ")" ::: "memory")
#define PG8_WAIT_L(n) asm volatile("s_waitcnt lgkmcnt(" #n ")" ::: "memory")
#define PG8_BAR __builtin_amdgcn_s_barrier()
#define PG8_SCHED __builtin_amdgcn_sched_barrier(0)
    Unit cur, nxt; int ui = 0;
    if (!S.next(0, cur)) return;
    f32x4 acc[2][2][4][2];
#pragma unroll
    for (int a = 0; a < 2; ++a)
#pragma unroll
        for (int b = 0; b < 2; ++b)
#pragma unroll
            for (int m = 0; m < 4; ++m)
#pragma unroll
                for (int n = 0; n < 2; ++n) acc[a][b][m][n] = (f32x4){0.f, 0.f, 0.f, 0.f};
    bf16x8 At[4][2], B0[2][2], B1[2][2];
    const char* cA = (const char*)g.A + (size_t)cur.pm * tstep + (size_t)cur.k0 * 2; const char* cB = (const char*)g.Bt + (size_t)cur.pn * tstep + (size_t)cur.k0 * 2;
    S.a_ready(cur);
    if constexpr (SP2) {
        PG8_STAGE(PG8_SB(0, 0), cB, voffB); PG8_STAGE(PG8_SB(0, 1), cB + hstep, voffB); PG8_STAGE(PG8_SA(0, 0), cA, voffA); PG8_STAGE(PG8_SA(0, 1), cA + hstep, voffA);
        if (wr == 1) PG8_BAR;
        PG8_WAIT_V(2); PG8_BAR;
        PG8_STAGE(PG8_SB(1, 0), cB + kstep, voffB); PG8_STAGE(PG8_SA(1, 0), cA + kstep, voffA); PG8_STAGE(PG8_SB(1, 1), cB + hstep + kstep, voffB);
        PG8_WAIT_V(6); PG8_BAR;
    } else {
        PG8_STAGE(PG8_SB(0, 0), cB, voffB); PG8_STAGE(PG8_SA(0, 0), cA, voffA); PG8_STAGE(PG8_SB(0, 1), cB + hstep, voffB); PG8_STAGE(PG8_SA(0, 1), cA + hstep, voffA);
        if (wr == 1) PG8_BAR;
        PG8_WAIT_V(4); PG8_BAR;
        PG8_STAGE(PG8_SB(1, 0), cB + kstep, voffB); PG8_STAGE(PG8_SA(1, 0), cA + kstep, voffA); PG8_STAGE(PG8_SB(1, 1), cB + hstep + kstep, voffB);
        PG8_WAIT_V(6); PG8_BAR;
    }
    for (;;) {
        const bool has_next = S.next(ui + 1, nxt);
        const char* nA = has_next ? (const char*)g.A + (size_t)nxt.pm * tstep + (size_t)nxt.k0 * 2 : cA; const char* nB = has_next ? (const char*)g.Bt + (size_t)nxt.pn * tstep + (size_t)nxt.k0 * 2 : cB;
        const int nt = cur.nt;
        for (int t = 0; t < nt; t += 2) {
            const bool last = (t == nt - 2);
            const char* a1 = cA + (size_t)(t + 1) * kstep;
            const char* a2 = last ? nA : cA + (size_t)(t + 2) * kstep; const char* b2 = last ? nB : cB + (size_t)(t + 2) * kstep;
            const char* a3 = a2 + kstep; const char* b3 = b2 + kstep;
            if (last && has_next) S.a_ready(nxt);
            if constexpr (SP2) {
            PG8_LDB(B0, 0, 0); PG8_LDB(B1, 0, 1); PG8_SCHED; PG8_LDA(At, 0, 0); PG8_STAGE(PG8_SA(1, 1), a1 + hstep, voffA);
            PG8_WAIT_V(8); PG8_WAIT_L(0); PG8_BAR; PG8_MMA(0, 0, At, B0); PG8_MMA(0, 1, At, B1); PG8_BAR; PG8_SCHED;
            PG8_LDA(At, 0, 1); PG8_STAGE(PG8_SB(0, 0), b2, voffB); PG8_STAGE(PG8_SB(0, 1), b2 + hstep, voffB); PG8_STAGE(PG8_SA(0, 0), a2, voffA);
            PG8_WAIT_V(8); PG8_WAIT_L(0); PG8_BAR; PG8_MMA(1, 0, At, B0); PG8_MMA(1, 1, At, B1); PG8_BAR; PG8_SCHED;
            PG8_LDB(B0, 1, 0); PG8_LDB(B1, 1, 1); PG8_SCHED; PG8_LDA(At, 1, 0); PG8_STAGE(PG8_SA(0, 1), a2 + hstep, voffA);
            PG8_WAIT_V(8); PG8_WAIT_L(0); PG8_BAR; PG8_MMA(0, 0, At, B0); PG8_MMA(0, 1, At, B1); PG8_BAR; PG8_SCHED;
            PG8_LDA(At, 1, 1); PG8_STAGE(PG8_SB(1, 0), b3, voffB); PG8_STAGE(PG8_SB(1, 1), b3 + hstep, voffB); PG8_STAGE(PG8_SA(1, 0), a3, voffA);
            PG8_WAIT_V(8); PG8_WAIT_L(0); PG8_BAR; PG8_MMA(1, 0, At, B0); PG8_MMA(1, 1, At, B1); PG8_BAR; PG8_SCHED;
            } else {
            PG8_LDB(B0, 0, 0); PG8_SCHED; PG8_LDA(At, 0, 0); PG8_STAGE(PG8_SA(1, 1), a1 + hstep, voffA);
            PG8_WAIT_L(8); PG8_BAR; PG8_WAIT_L(0); PG8_MMA(0, 0, At, B0); PG8_BAR; PG8_SCHED;
            PG8_LDB(B1, 0, 1); PG8_STAGE(PG8_SB(0, 0), b2, voffB);
            PG8_BAR; PG8_WAIT_L(0); PG8_MMA(0, 1, At, B1); PG8_BAR;
            PG8_LDA(At, 0, 1); PG8_STAGE(PG8_SA(0, 0), a2, voffA);
            PG8_BAR; PG8_WAIT_L(0); PG8_MMA(1, 0, At, B0); PG8_BAR; PG8_SCHED;
            PG8_STAGE(PG8_SB(0, 1), b2 + hstep, voffB);
            PG8_WAIT_V(6); PG8_BAR; PG8_MMA(1, 1, At, B1); PG8_BAR;
            PG8_LDB(B0, 1, 0); PG8_SCHED; PG8_LDA(At, 1, 0); PG8_STAGE(PG8_SA(0, 1), a2 + hstep, voffA);
            PG8_WAIT_L(8); PG8_BAR; PG8_WAIT_L(0); PG8_MMA(0, 0, At, B0); PG8_BAR; PG8_SCHED;
            PG8_LDB(B1, 1, 1); PG8_STAGE(PG8_SB(1, 0), b3, voffB);
            PG8_BAR; PG8_WAIT_L(0); PG8_MMA(0, 1, At, B1); PG8_BAR;
            PG8_LDA(At, 1, 1); PG8_STAGE(PG8_SA(1, 0), a3, voffA);
            PG8_BAR; PG8_WAIT_L(0); PG8_MMA(1, 0, At, B0); PG8_BAR; PG8_SCHED;
            PG8_STAGE(PG8_SB(1, 1), b3 + hstep, voffB);
            PG8_WAIT_V(6); PG8_BAR; PG8_MMA(1, 1, At, B1); PG8_BAR;
            }
        }
        if constexpr (ALIGN_EPI) { if (wr == 0) PG8_BAR; }
        if constexpr (!Epi::AFTER_DRAIN) { E(acc, cur, wr, wc, fr, fq); S.done(cur); }
        if (!has_next) break;
#pragma unroll
        for (int a = 0; a < 2; ++a)
#pragma unroll
            for (int b = 0; b < 2; ++b)
#pragma unroll
                for (int m = 0; m < 4; ++m)
#pragma unroll
                    for (int n = 0; n < 2; ++n) acc[a][b][m][n] = (f32x4){0.f, 0.f, 0.f, 0.f};
        cur = nxt; cA = nA; cB = nB; ++ui;
        if constexpr (ALIGN_EPI) { if (wr == 1) PG8_BAR; }
    }
    PG8_WAIT_V(0);
    if constexpr (!ALIGN_EPI) { if (wr == 0) PG8_BAR; }
    PG8_BAR;
    if constexpr (Epi::AFTER_DRAIN) { E.fused(acc, cur, wr, wc, fr, fq, lds, wid, lane); S.done(cur); }
#undef PG8_SA
#undef PG8_SB
#undef PG8_STAGE
#undef PG8_LDA
#undef PG8_LDB
#undef PG8_MMA
#undef PG8_WAIT_V
#undef PG8_WAIT_L
#undef PG8_BAR
#undef PG8_SCHED
}
}
#define LAS __attribute__((address_space(3)))
#define XB_TMO      128
#define XB_XCNT(j)  (256  + 64 * (j))
#define XB_XSUB(j)  (1280 + 64 * (j))
#define XB_XGEN(j)  (2304 + 64 * (j))
#define XB_TOP      3328
#define XB_TOPGEN   3392
#define XCD_BAR_WORDS 3456
#define XB_SPIN_CAP (1u << 18)

__device__ __forceinline__ unsigned xb_ld(unsigned* p)              { return __hip_atomic_load(p, __ATOMIC_RELAXED, __HIP_MEMORY_SCOPE_AGENT); }
__device__ __forceinline__ unsigned xb_add(unsigned* p, unsigned v) { return __hip_atomic_fetch_add(p, v, __ATOMIC_RELAXED, __HIP_MEMORY_SCOPE_AGENT); }
__device__ __forceinline__ unsigned xb_xcc_id() { return (unsigned)__builtin_amdgcn_s_getreg((3 << 11) | 20) & 0xFu; }
#define XB_SPIN(cond, bar) do { unsigned _sp = 0; while (cond) { __builtin_amdgcn_s_sleep(1); \
    if ((++_sp & 255u) == 0u) { if (xb_ld(&(bar)[XB_TMO])) break; if (_sp > XB_SPIN_CAP) { atomicAdd(&(bar)[XB_TMO], 1u); break; } } } } while (0)

struct XcdBarrier {
    unsigned* bar; unsigned x;
    volatile LAS unsigned* st;
};

__device__ __forceinline__ XcdBarrier xcd_barrier_post(unsigned* bar, volatile LAS unsigned* st) {
    XcdBarrier b; b.bar = bar; b.x = xb_xcc_id(); b.st = st;
    if (threadIdx.x == 0) (void)xb_add(&bar[XB_XCNT(b.x)], 1u);
    return b;
}
__device__ __forceinline__ void xcd_barrier_complete(unsigned* bar, unsigned x, unsigned& nloc, unsigned& nx) {
    const unsigned G = gridDim.x * gridDim.y * gridDim.z;
    unsigned sum, cnt, mine, sp = 0u;
    for (;;) {
        sum = 0u; cnt = 0u; mine = 0u;
#pragma unroll
        for (unsigned j = 0; j < 16; ++j) { const unsigned c = xb_ld(&bar[XB_XCNT(j)]); sum += c; cnt += (c > 0u) ? 1u : 0u; mine = (j == x) ? c : mine; }
        if (sum == G) break;
        __builtin_amdgcn_s_sleep(1);
        if ((++sp & 255u) == 0u) { if (xb_ld(&bar[XB_TMO])) break; if (sp > XB_SPIN_CAP) { atomicAdd(&bar[XB_TMO], 1u); break; } }
    }
    nloc = mine > 0u ? mine : 1u; nx = cnt > 0u ? cnt : 1u;
}

__device__ __forceinline__ void xcd_barrier(const XcdBarrier& b) {
    asm volatile("s_waitcnt vmcnt(0)" ::: "memory");
    __syncthreads();
    if (threadIdx.x == 0) {
        unsigned* bar = b.bar;
        __builtin_amdgcn_s_waitcnt(0);
        unsigned nloc = b.st[0], nx = b.st[1];
        if (nloc == 0u) { xcd_barrier_complete(bar, b.x, nloc, nx); b.st[0] = nloc; b.st[1] = nx; }
        const unsigned old = xb_add(&bar[XB_XSUB(b.x)], 1u);
        const unsigned gen = old / nloc;
        if (old + 1u == (gen + 1u) * nloc) {
            __builtin_amdgcn_fence(__ATOMIC_RELEASE, "agent");
            asm volatile("s_waitcnt vmcnt(0)" ::: "memory");
            const unsigned og = xb_add(&bar[XB_TOP], 1u);
            const unsigned tg = og / nx;
            if (og + 1u == (tg + 1u) * nx) xb_add(&bar[XB_TOPGEN], 1u);
            else XB_SPIN(xb_ld(&bar[XB_TOPGEN]) == tg, bar);
            __builtin_amdgcn_fence(__ATOMIC_ACQUIRE, "agent");
            xb_add(&bar[XB_XGEN(b.x)], 1u);
            asm volatile("s_waitcnt vmcnt(0)" ::: "memory");
        } else {
            XB_SPIN(xb_ld(&bar[XB_XGEN(b.x)]) == gen, bar);
            __builtin_amdgcn_fence(__ATOMIC_ACQUIRE, "agent");
            asm volatile("s_waitcnt vmcnt(0)" ::: "memory");
        }
    }
    __syncthreads();
}

using pg8::bf16_t; using pg8::bf16x8; using pg8::f32x4; using pg8::u32x4; using pg8::Unit;
typedef unsigned u32x2 __attribute__((ext_vector_type(2)));
typedef unsigned short u16;
constexpr int MP_ROWS = 32768;
constexpr int DM = 1024, MP = 32768, MS = 512, MT = MP + MS, SEQ = 8192;
constexpr float EPS = 1e-5f, LOG2E = 1.4426950408889634f, C2 = 0.125f * 1.4426950408889634f;
constexpr size_t MiB = 1u << 20;
constexpr size_t WS_SS = 492 * MiB, SS_SLOT = (size_t)MT * 16;
constexpr size_t WS_CTL = 0, CTL_BYTES = 131072;
constexpr size_t WS_SPK = 166 * MiB;
constexpr size_t WS_ROPE = 2 * MiB;
constexpr size_t WS_DB = 3 * MiB;
constexpr size_t WS_W = 6 * MiB;
constexpr size_t WS_XB = 100 * MiB;
constexpr size_t WS_POOL = 232 * MiB;
constexpr size_t ACT = (size_t)MT * DM * 2;
constexpr size_t WS_END = WS_POOL + 4 * ACT;
constexpr size_t OY = 0, OKP = 34078720, OVP = 34340864, OSP = 34603008, OKS = 35651584, OVS = 36175872, OSS = 36700160;
constexpr size_t WM = 1048576;
#ifndef NHALF
#define NHALF 1
#endif
constexpr int HROWS = MP_ROWS / NHALF;
struct Params { const float* in[17]; float* out; unsigned char* ws; int ph_lo, ph_hi; };
typedef const __attribute__((address_space(4))) Params* KP;
__device__ __forceinline__ KP kargs() { KP k = (KP)__builtin_amdgcn_kernarg_segment_ptr(); asm volatile("" : "+s"(k)); return k; }

__device__ __forceinline__ unsigned pkbf(float lo, float hi) { typedef float f2 __attribute__((ext_vector_type(2))); typedef __bf16 b2 __attribute__((ext_vector_type(2))); f2 v = {lo, hi}; b2 b = __builtin_convertvector(v, b2); return __builtin_bit_cast(unsigned, b); }
__device__ __forceinline__ float bflo(unsigned u) { return __uint_as_float(u << 16); }
__device__ __forceinline__ float bfhi(unsigned u) { return __uint_as_float(u & 0xffff0000u); }
__device__ __forceinline__ float bf2f(u16 u) { return __uint_as_float((unsigned)u << 16); }
__device__ __forceinline__ u16 f2bf(float f) { return (u16)(pkbf(f, 0.f) & 0xffffu); }
__device__ __forceinline__ unsigned pkh(float lo, float hi) { _Float16 a = (_Float16)lo, b = (_Float16)hi; return (unsigned)__builtin_bit_cast(u16, a) | ((unsigned)__builtin_bit_cast(u16, b) << 16); }
__device__ __forceinline__ f32x4 mfma16(bf16x8 a, bf16x8 b, f32x4 c) { return __builtin_amdgcn_mfma_f32_16x16x32_bf16(a, b, c, 0, 0, 0); }
__device__ __forceinline__ int row_pos(int r) { return r < MP ? (r & (SEQ - 1)) : 2048 + ((r - MP) & 63); }
__device__ __forceinline__ float row_rs(const float* ss, int r) { const f32x4* q = (const f32x4*)(ss + (size_t)r * 16); f32x4 a = q[0], b = q[1], c = q[2], d = q[3]; a = (a + b) + (c + d); return rsqrtf(((a[0] + a[1]) + (a[2] + a[3])) * (1.f / 1024.f) + EPS); }
__device__ __forceinline__ float silu(float v) { return v * __builtin_amdgcn_rcpf(1.f + __builtin_amdgcn_exp2f(-1.4426950408889634f * v)); }

#ifndef COLPERM
#define COLPERM 1
#endif
#ifndef NT_STORE
#define NT_STORE 0
#endif
#if NT_STORE == 2
__device__ __forceinline__ void st16_wt(void* p, u32x4 v) { asm volatile("global_store_dwordx4 %0, %1, off sc0 sc1" :: "v"(p), "v"(v) : "memory"); }
#define ST16(p, v) st16_wt((void*)(p), (v))
#define ST8(p, v) (*(u32x2*)(p) = (v))
#define STF4(p, v) (*(f32x4*)(p) = (v))
#elif NT_STORE
#define ST16(p, v) __builtin_nontemporal_store((v), (u32x4*)(p))
#define ST8(p, v) __builtin_nontemporal_store((v), (u32x2*)(p))
#define STF4(p, v) __builtin_nontemporal_store((v), (f32x4*)(p))
#else
#define ST16(p, v) (*(u32x4*)(p) = (v))
#define ST8(p, v) (*(u32x2*)(p) = (v))
#define STF4(p, v) (*(f32x4*)(p) = (v))
#endif
#define EPI_ROW(idx) (u.pm * 256 + ((idx) >> 2) * 128 + wr * 64 + ((idx) & 3) * 16 + fr)
#define EPI_LOAD_RS(rsv, ss) float rsv[8]; { f32x4 pv_[8]; \
    _Pragma("unroll") for (int idx = 0; idx < 8; ++idx) pv_[idx] = *(const f32x4*)((ss) + (size_t)EPI_ROW(idx) * 16 + fq * 4); \
    _Pragma("unroll") for (int idx = 0; idx < 8; ++idx) { float s_ = (pv_[idx][0] + pv_[idx][1]) + (pv_[idx][2] + pv_[idx][3]); s_ += __shfl_xor(s_, 16); s_ += __shfl_xor(s_, 32); rsv[idx] = rsqrtf(s_ * (1.f / 1024.f) + EPS); } }
struct EpiQKV {
    static constexpr bool PERM = true, AFTER_DRAIN = false;
    unsigned char* ws; float* out; int j, slot;
    __device__ __forceinline__ void operator()(const f32x4 (&acc)[2][2][4][2], const Unit& u, int wr, int wc, int fr, int fq, unsigned mask) const {
        const float* ss = (const float*)(ws + WS_SS) + (size_t)slot * SS_SLOT; const float* rope = (const float*)(ws + WS_ROPE);
        const int pn = u.pn; const bool rot = (pn <= 4) && ((wc & 1) == 0); const float qs = pn < 4 ? C2 : 1.f; const bool rl_ = rot && fq < 2;
        EPI_LOAD_RS(rsv, ss)
        const f32x4 one4 = {1.f, 1.f, 1.f, 1.f}, zero4 = {0.f, 0.f, 0.f, 0.f};
        f32x4 c0 = one4, c1 = one4, s0 = zero4, s1 = zero4, dc0 = one4, dc1 = one4, ds0 = zero4, ds1 = zero4;
        if (rl_) { const float* t = rope + row_pos(EPI_ROW(0)) * 16; c0 = *(const f32x4*)t; c1 = *(const f32x4*)(t + 4); s0 = *(const f32x4*)(t + 8); s1 = *(const f32x4*)(t + 12);
            const float* d = rope + 16 * 16; dc0 = *(const f32x4*)d; dc1 = *(const f32x4*)(d + 4); ds0 = *(const f32x4*)(d + 8); ds1 = *(const f32x4*)(d + 12); }
        const float sgn = fq == 0 ? -1.f : 1.f;
#pragma unroll
        for (int idx = 0; idx < 8; ++idx) {
            const int ai = idx >> 2, m = idx & 3;
            if (idx > 0) {
                const bool back = (idx == 4) && (u.pm >= 128);
                const float dsg = back ? -1.f : 1.f;
#pragma unroll 1
                for (int st_ = (idx == 4 ? (back ? 3 : 5) : 1); st_ > 0; --st_) { const f32x4 e0 = ds0 * dsg, e1 = ds1 * dsg; const f32x4 a0 = c0 * dc0 - s0 * e0, b0 = s0 * dc0 + c0 * e0, a1 = c1 * dc1 - s1 * e1, b1 = s1 * dc1 + c1 * e1; c0 = a0; s0 = b0; c1 = a1; s1 = b1; }
            }
            if (!((mask >> idx) & 1u)) continue;
            int rl = ai * 128 + wr * 64 + m * 16 + fr; asm volatile("" : "+v"(rl)); const int r = u.pm * 256 + rl;
            const float rs = rsv[idx];
            const f32x4 sn0 = s0 * sgn, sn1 = s1 * sgn;
            float* nk = nullptr;
            if (pn >= 4) {
                if (u.pm < 128) { const int t = (u.pm & 31) * 256 + rl; if (t >= 8064) nk = out + (pn == 4 ? OKP : OVP) + ((size_t)((j * 4 + (u.pm >> 5)) * 128 + (t - 8064))) * 256; }
                else { const int rr = r - MP; nk = out + (pn == 4 ? OKS : OVS) + ((size_t)((j * 8 + (rr >> 6)) * 128 + 64 + (rr & 63))) * 256; }
            }
#pragma unroll
            for (int bj = 0; bj < 2; ++bj) {
                f32x4 v0 = acc[ai][bj][m][0] * rs, v1 = acc[ai][bj][m][1] * rs;
                if (rot) {
                    f32x4 p0, p1;
#pragma unroll
                    for (int e = 0; e < 4; ++e) { p0[e] = __shfl_xor(v0[e], 16); p1[e] = __shfl_xor(v1[e], 16); }
                    v0 = v0 * c0 + p0 * sn0; v1 = v1 * c1 + p1 * sn1;
                }
                v0 = v0 * qs; v1 = v1 * qs;
                const int cw = bj * 128 + wc * 32 + 8 * fq;
                bf16_t* dst = pn < 4 ? (bf16_t*)(ws + WS_POOL) + (size_t)r * 1024 + pn * 256 + cw : (bf16_t*)(ws + WS_POOL + 2 * ACT) + (pn == 4 ? (size_t)0 : (size_t)MT * 256) + (size_t)r * 256 + cw;
                u32x4 w; w.x = pkbf(v0[0], v0[1]); w.y = pkbf(v0[2], v0[3]); w.z = pkbf(v1[0], v1[1]); w.w = pkbf(v1[2], v1[3]);
                ST16(dst, w);
                if (nk) { *(f32x4*)(nk + cw) = v0; *(f32x4*)(nk + cw + 4) = v1; }
            }
        }
    }
};
struct EpiRes {
    static constexpr bool PERM = true, AFTER_DRAIN = false;
    bf16_t* XB; float* ssn;
    __device__ __forceinline__ void operator()(const f32x4 (&acc)[2][2][4][2], const Unit& u, int wr, int wc, int fr, int fq, unsigned mask) const {
        const int col0 = u.pn * 256 + wc * 32 + 8 * fq;
        u32x4 xin[8][2];
#pragma unroll
        for (int idx = 0; idx < 8; ++idx) { const bf16_t* xp = XB + (size_t)EPI_ROW(idx) * 1024 + col0; xin[idx][0] = *(const u32x4*)xp; xin[idx][1] = *(const u32x4*)(xp + 128); }
#pragma unroll
        for (int idx = 0; idx < 8; ++idx) {
            const int ai = idx >> 2, m = idx & 3;
            if (!((mask >> idx) & 1u)) continue;
            int r = EPI_ROW(idx); asm volatile("" : "+v"(r)); bf16_t* xo = XB + (size_t)r * 1024 + col0; float sq = 0.f;
#pragma unroll
            for (int bj = 0; bj < 2; ++bj) { const u32x4 cx = xin[idx][bj]; const f32x4 a0 = acc[ai][bj][m][0], a1 = acc[ai][bj][m][1]; u32x4 w;
                w.x = pkbf(bflo(cx.x) + a0[0], bfhi(cx.x) + a0[1]); w.y = pkbf(bflo(cx.y) + a0[2], bfhi(cx.y) + a0[3]); w.z = pkbf(bflo(cx.z) + a1[0], bfhi(cx.z) + a1[1]); w.w = pkbf(bflo(cx.w) + a1[2], bfhi(cx.w) + a1[3]);
                ST16(xo + bj * 128, w);
#pragma unroll
                for (int e = 0; e < 4; ++e) { const float lo = bflo(w[e]), hi = bfhi(w[e]); sq += lo * lo + hi * hi; } }
            sq += __shfl_xor(sq, 16); sq += __shfl_xor(sq, 32);
            if (fq == 0) ssn[(size_t)r * 16 + u.pn * 4 + wc] = sq;
        }
    }
};
struct EpiUp {
    static constexpr bool PERM = true, AFTER_DRAIN = false;
    const float* ss; bf16_t* H; int rowmask;
    __device__ __forceinline__ void operator()(const f32x4 (&acc)[2][2][4][2], const Unit& u, int wr, int wc, int fr, int fq, unsigned mask) const {
        EPI_LOAD_RS(rsv, ss)
#pragma unroll
        for (int idx = 0; idx < 8; ++idx) {
            const int ai = idx >> 2, m = idx & 3;
            if (!((mask >> idx) & 1u)) continue;
            int r = EPI_ROW(idx); asm volatile("" : "+v"(r)); const float rs = rsv[idx];
#pragma unroll
            for (int bj = 0; bj < 2; ++bj) {
                f32x4 v0 = acc[ai][bj][m][0] * rs, v1 = acc[ai][bj][m][1] * rs;
#pragma unroll
                for (int e = 0; e < 4; ++e) { const float a = fmaxf(v0[e], 0.f), b = fmaxf(v1[e], 0.f); v0[e] = a * a; v1[e] = b * b; }
                u32x4 w; w.x = pkbf(v0[0], v0[1]); w.y = pkbf(v0[2], v0[3]); w.z = pkbf(v1[0], v1[1]); w.w = pkbf(v1[2], v1[3]);
                if (rowmask == 0x7ffffffe) ST16(H + ((size_t)(u.pm * 16 + u.pn) * 65536 + (size_t)(r & 255) * 256) + (COLPERM ? wc * 64 + bj * 32 : bj * 128 + wc * 32) + 8 * fq, w);
                else ST16(H + (size_t)(r & rowmask) * 4096 + u.pn * 256 + (COLPERM ? wc * 64 + bj * 32 : bj * 128 + wc * 32) + 8 * fq, w);
            }
        }
    }
};
struct EpiHin {
    static constexpr bool PERM = true, AFTER_DRAIN = false;
    const float* ss; u16* base;
    __device__ __forceinline__ void operator()(const f32x4 (&acc)[2][2][4][2], const Unit& u, int wr, int wc, int fr, int fq, unsigned mask) const {
        const int sel = u.pn >> 2; u16* ob = base + (size_t)sel * (ACT / 2);
        EPI_LOAD_RS(rsv, ss)
#pragma unroll
        for (int idx = 0; idx < 8; ++idx) {
            const int ai = idx >> 2, m = idx & 3;
            if (!((mask >> idx) & 1u)) continue;
            int r = EPI_ROW(idx); asm volatile("" : "+v"(r)); const float rs = rsv[idx];
#pragma unroll
            for (int bj = 0; bj < 2; ++bj) {
                f32x4 v0 = acc[ai][bj][m][0] * rs, v1 = acc[ai][bj][m][1] * rs; u32x4 w;
                if (sel == 1) { w.x = pkh(v0[0], v0[1]); w.y = pkh(v0[2], v0[3]); w.z = pkh(v1[0], v1[1]); w.w = pkh(v1[2], v1[3]); }
                else {
                    if (sel != 2) {
#pragma unroll
                        for (int e = 0; e < 4; ++e) { v0[e] = silu(v0[e]); v1[e] = silu(v1[e]); }
                    }
                    w.x = pkbf(v0[0], v0[1]); w.y = pkbf(v0[2], v0[3]); w.z = pkbf(v1[0], v1[1]); w.w = pkbf(v1[2], v1[3]);
                }
                ST16(ob + (size_t)r * 1024 + (u.pn & 3) * 256 + (COLPERM ? wc * 64 + bj * 32 : bj * 128 + wc * 32) + 8 * fq, w);
            }
        }
    }
};

template <class Epi> struct EpiMix {
    static constexpr bool PERM = Epi::PERM, AFTER_DRAIN = false;
    Epi E; float* P; unsigned* cnt; int S, m0, nm; unsigned pmask;
    __device__ __forceinline__ void operator()(f32x4 (&acc)[2][2][4][2], const Unit& u, int wr, int wc, int fr, int fq) const {
        unsigned mask = pmask;
        if (u.sp >= 0 && pmask == 0u) return;
        if (u.sp >= 0) {
            const int wid = wr * 4 + wc, lane = fq * 16 + fr, tile = (u.pm - m0) + nm * u.pn;
            float* pw = P + ((size_t)(tile * S + u.sp) * 8 + wid) * 8192 + lane * 4;
#pragma unroll
            for (int i = 0; i < 32; ++i) *(f32x4*)(pw + i * 256) = acc[i >> 4][(i >> 3) & 1][(i >> 1) & 3][i & 1];
            __builtin_amdgcn_fence(__ATOMIC_RELEASE, "agent");
            unsigned* cw = cnt + tile * 8 + wid;
            if (lane == 0) (void)__hip_atomic_fetch_add(cw, 1u, __ATOMIC_RELAXED, __HIP_MEMORY_SCOPE_AGENT);
            { unsigned sp_ = 0; while ((unsigned)__builtin_amdgcn_readfirstlane((int)__hip_atomic_load(cw, __ATOMIC_RELAXED, __HIP_MEMORY_SCOPE_AGENT)) < (unsigned)S) { __builtin_amdgcn_s_sleep(2); if (++sp_ > (1u << 22)) break; } }
            __builtin_amdgcn_fence(__ATOMIC_ACQUIRE, "agent");
            mask = S == 8 ? (1u << u.sp) : (3u << (2 * u.sp));
            const float* pr = P + ((size_t)(tile * S) * 8 + wid) * 8192 + lane * 4;
#pragma unroll
            for (int c = 0; c < 8; ++c) if ((mask >> c) & 1u) {
                f32x4 t0 = {0.f, 0.f, 0.f, 0.f}, t1 = t0, t2 = t0, t3 = t0; const int i0 = (c >> 2) * 16 + (c & 3) * 2;
#pragma unroll 2
                for (int s = 0; s < S; ++s) { const float* ps = pr + (size_t)s * 8 * 8192 + i0 * 256;
                    t0 += *(const f32x4*)(ps); t1 += *(const f32x4*)(ps + 256); t2 += *(const f32x4*)(ps + 8 * 256); t3 += *(const f32x4*)(ps + 9 * 256); }
                acc[c >> 2][0][c & 3][0] = t0; acc[c >> 2][0][c & 3][1] = t1; acc[c >> 2][1][c & 3][0] = t2; acc[c >> 2][1][c & 3][1] = t3;
            }
        }
        E(acc, u, wr, wc, fr, fq, mask);
    }
};

__device__ __forceinline__ int colperm(int a) { return (a & ~255) | (((a >> 5) & 1) << 7) | (((a >> 6) & 3) << 5) | (a & 31); }
__device__ __forceinline__ void p0_transpose_item(const float* W, const float* g, int K, int N, bf16_t* WT, float* scr, int item, int lane, bool perm) {
    const int nblk = N / 32, kb = item / nblk, nb = item % nblk, k0 = 64 * kb, n0 = 32 * nb;
    float wv[32];
#pragma unroll
    for (int i = 0; i < 32; ++i) { const int kk = 2 * i + (lane >> 5); wv[i] = W[(size_t)(k0 + kk) * N + n0 + (lane & 31)]; }
#pragma unroll
    for (int i = 0; i < 32; ++i) { const int kk = 2 * i + (lane >> 5); const float gs = g ? g[k0 + kk] : 1.f; scr[kk * 33 + (lane & 31)] = wv[i] * gs; }
    asm volatile("s_waitcnt lgkmcnt(0)" ::: "memory");
    const int c = lane & 7;
#pragma unroll
    for (int jj = 0; jj < 4; ++jj) { const int n = (lane >> 3) + 8 * jj; const float* s = scr + (8 * c) * 33 + n;
        u32x4 o; o.x = pkbf(s[0 * 33], s[1 * 33]); o.y = pkbf(s[2 * 33], s[3 * 33]); o.z = pkbf(s[4 * 33], s[5 * 33]); o.w = pkbf(s[6 * 33], s[7 * 33]);
        *(u32x4*)(WT + (size_t)(perm ? colperm(n0 + n) : n0 + n) * K + k0 + 8 * c) = o; }
    asm volatile("s_waitcnt lgkmcnt(0)" ::: "memory");
}
__device__ __forceinline__ size_t wlayer_base(int layer) { return layer == 0 ? 0 : layer == 1 ? (size_t)(10.5 * WM) : layer == 2 ? (size_t)(23.5 * WM) : (size_t)(34 * WM); }
__device__ __forceinline__ size_t wmat_off(int layer, int which) {
    const size_t b = wlayer_base(layer);
    if (layer & 1) return b + (which == 0 ? 0 : which == 1 ? 4 * WM : which == 2 ? 5 * WM : 9 * WM);
    return b + (which == 0 ? 0 : which == 1 ? (size_t)(1.5 * WM) : which == 2 ? (size_t)(2.5 * WM) : (size_t)(6.5 * WM));
}
__device__ __forceinline__ void prologue(KP pk, char* lds, int vcu, int G) {
    int tid_ = threadIdx.x; asm volatile("" : "+v"(tid_)); const int tid = tid_, lane = tid & 63, w = __builtin_amdgcn_readfirstlane(tid >> 6);
    const int gw = vcu * 8 + w, NGW = G * 8, gt = vcu * 512 + tid, NTH = G * 512;
    float* scr = (float*)(lds + w * 16384);
    bf16_t* WB = (bf16_t*)(pk->ws + WS_W);
    for (int it = gw; it < 24064; it += NGW) {
        int layer, r;
        if (it < 5376) { layer = 0; r = it; } else if (it < 12032) { layer = 1; r = it - 5376; } else if (it < 17408) { layer = 2; r = it - 12032; } else { layer = 3; r = it - 17408; }
        const int j = layer >> 1; const int n0 = (layer & 1) ? 2048 : 768; int which;
        if (r < n0) which = 0; else if (r < n0 + 512) { which = 1; r -= n0; } else if (r < n0 + 2560) { which = 2; r -= n0 + 512; } else { which = 3; r -= n0 + 2560; }
        const float* W; const float* g = nullptr; int K = 1024, N = 1024;
        if (which == 0) { g = pk->in[5] + layer * 1024; if (layer & 1) { W = pk->in[10] + (size_t)j * 4 * WM; N = 4096; } else { W = pk->in[7] + (size_t)j * 1536 * 1024; N = 1536; } }
        else if (which == 1) { W = ((layer & 1) ? pk->in[13] : pk->in[8]) + (size_t)j * WM; }
        else if (which == 2) { W = pk->in[14] + (size_t)layer * 4 * WM; g = pk->in[6] + layer * 1024; N = 4096; }
        else { W = pk->in[15] + (size_t)layer * 4 * WM; K = 4096; }
        p0_transpose_item(W, g, K, N, WB + wmat_off(layer, which), scr, r, lane, COLPERM && (which == 2 || (which == 0 && (layer & 1))));
    }
    bf16_t* XB = (bf16_t*)(pk->ws + WS_XB); float* ss0 = (float*)(pk->ws + WS_SS);
    for (int r0 = gw; r0 < MT; r0 += 2 * NGW) {
        const int r1 = r0 + NGW; const bool has1 = r1 < MT; const int rr[2] = {r0, has1 ? r1 : r0};
        f32x4 v[2][4];
#pragma unroll
        for (int t = 0; t < 2; ++t) { const int r = rr[t]; const float* src = r < MP ? pk->in[0] + (size_t)r * 1024 : pk->in[1] + (size_t)(r - MP) * 1024;
#pragma unroll
            for (int q = 0; q < 4; ++q) v[t][q] = *(const f32x4*)(src + 256 * q + 4 * lane); }
#pragma unroll
        for (int t = 0; t < 2; ++t) { const int r = rr[t]; float s = 0.f;
            if (t == 1 && !has1) break;
#pragma unroll
            for (int q = 0; q < 4; ++q) { u32x2 o; o.x = pkbf(v[t][q][0], v[t][q][1]); o.y = pkbf(v[t][q][2], v[t][q][3]); *(u32x2*)(XB + (size_t)r * 1024 + 256 * q + 4 * lane) = o;
                const float a = bflo(o.x), b = bfhi(o.x), c = bflo(o.y), d = bfhi(o.y); s += (a * a + b * b) + (c * c + d * d); }
#pragma unroll
            for (int o = 1; o < 64; o <<= 1) s += __shfl_xor(s, o);
            if (lane < 16) ss0[(size_t)r * 16 + lane] = lane == 0 ? s : 0.f; }
    }
    { u32x4* ctl = (u32x4*)(pk->ws + WS_CTL); const u32x4 z = {0u, 0u, 0u, 0u}; for (int e = gt; e < (int)(CTL_BYTES / 16); e += NTH) ctl[e] = z; }
    float* rope = (float*)(pk->ws + WS_ROPE);
    for (int e = gt; e < 65536; e += NTH) { const int pos = e >> 3, i = e & 7; const float inv = exp2f(-(float)i * 2.3664460711655217f); const float ang = (float)pos * inv;
        const double rev = (double)ang * 0.15915494309189535; const float fr = (float)(rev - __builtin_rint(rev));
        rope[pos * 16 + i] = __builtin_amdgcn_cosf(fr); rope[pos * 16 + 8 + i] = __builtin_amdgcn_sinf(fr); }
    for (int e = gt; e < 65536; e += NTH) { const int jj = e >> 15, rem = e & 32767, sb = rem >> 12, row = (rem >> 6) & 63, c4 = rem & 63;
        const size_t so = ((size_t)((jj * 8 + sb) * 128 + 64 + row)) * 256 + 4 * c4, dof = ((size_t)((jj * 8 + sb) * 128 + row)) * 256 + 4 * c4;
        *(f32x4*)(pk->out + OKS + dof) = *(const f32x4*)(pk->in[2] + so); *(f32x4*)(pk->out + OVS + dof) = *(const f32x4*)(pk->in[3] + so); }
}

__device__ __forceinline__ void attn_phase(KP pk, char* lds, int j, int vcu, int G) {
    int tid_ = threadIdx.x; asm volatile("" : "+v"(tid_)); const int tid = tid_, lane = tid & 63, w = __builtin_amdgcn_readfirstlane(tid >> 6), l15 = lane & 15, q4 = lane >> 4;
    bf16_t* Ks = (bf16_t*)lds; bf16_t* Vt = (bf16_t*)(lds + 27648);
    const bf16_t* Qb = (const bf16_t*)(pk->ws + WS_POOL); bf16_t* Ob = (bf16_t*)(pk->ws + WS_POOL + ACT);
    const bf16_t* Kb = (const bf16_t*)(pk->ws + WS_POOL + 2 * ACT); const bf16_t* Vb = Kb + (size_t)MT * 256;
    const float* ck = pk->in[2] + (size_t)j * 8 * 128 * 256; const float* cv = pk->in[3] + (size_t)j * 8 * 128 * 256; const float* sinks = pk->in[9] + j * 16;
    for (int unit = vcu; unit < 2080; unit += G) {
        int qrow0, kvh, kt0, sb = -1;
        if (unit < 2048) { const int b = unit >> 9, c = (unit >> 2) & 127; kvh = unit & 3; qrow0 = b * 8192 + c * 64; kt0 = c >= 2 ? 0 : (c == 1 ? 4 : 8); }
        else { const int u2 = unit - 2048; sb = u2 >> 2; kvh = u2 & 3; qrow0 = MP + sb * 64; kt0 = 0; }
        __syncthreads();
#pragma unroll
        for (int i = 0; i < 3; ++i) { const int ch = tid + 512 * i, key = ch >> 3, dc = ch & 7; u32x4 kv = {0u, 0u, 0u, 0u}, vv = kv;
            if (key >= 16 * kt0) {
                if (sb >= 0 && key < 128) { const size_t so = ((size_t)(sb * 128 + key) * 4 + kvh) * 64 + 8 * dc;
                    const f32x4 a = *(const f32x4*)(ck + so), b = *(const f32x4*)(ck + so + 4), c = *(const f32x4*)(cv + so), d = *(const f32x4*)(cv + so + 4);
                    kv.x = pkbf(a[0], a[1]); kv.y = pkbf(a[2], a[3]); kv.z = pkbf(b[0], b[1]); kv.w = pkbf(b[2], b[3]);
                    vv.x = pkbf(c[0], c[1]); vv.y = pkbf(c[2], c[3]); vv.z = pkbf(d[0], d[1]); vv.w = pkbf(d[2], d[3]); }
                else { const size_t so = (size_t)(qrow0 - 128 + key) * 256 + kvh * 64 + 8 * dc; kv = *(const u32x4*)(Kb + so); vv = *(const u32x4*)(Vb + so); }
            }
            *(u32x4*)(Ks + key * 72 + 8 * dc) = kv;
#pragma unroll
            for (int e = 0; e < 8; ++e) Vt[(8 * dc + e) * 200 + ((((key >> 3) ^ dc) << 3) | (key & 7))] = (u16)(vv[e >> 1] >> (16 * (e & 1)));
        }
        __syncthreads();
#pragma unroll 1
        for (int qt = 0; qt < 2; ++qt) {
            const int qi = 2 * w + qt, g = qi >> 2, t0 = 16 * (qi & 3), head = kvh * 4 + g;
            const bf16_t* qp = Qb + (size_t)(qrow0 + t0 + l15) * 1024 + head * 64 + 8 * q4;
            const bf16x8 qf0 = *(const bf16x8*)qp, qf1 = *(const bf16x8*)(qp + 32);
            f32x4 s[12]; const float sink2 = sinks[head] * LOG2E; float mx = sink2;
#pragma unroll
            for (int kt = 0; kt < 12; ++kt) { const bf16_t* kp = Ks + (16 * kt + l15) * 72 + 8 * q4;
                f32x4 a = {0.f, 0.f, 0.f, 0.f}; a = mfma16(*(const bf16x8*)kp, qf0, a); a = mfma16(*(const bf16x8*)(kp + 32), qf1, a);
                if (kt < kt0) a = (f32x4){-INFINITY, -INFINITY, -INFINITY, -INFINITY};
                s[kt] = a; mx = fmaxf(fmaxf(mx, fmaxf(a[0], a[1])), fmaxf(a[2], a[3])); if ((kt & 3) == 3) asm volatile("" ::: "memory"); }
            mx = fmaxf(mx, __shfl_xor(mx, 16)); mx = fmaxf(mx, __shfl_xor(mx, 32));
            float ls = 0.f;
#pragma unroll
            for (int kt = 0; kt < 12; ++kt)
#pragma unroll
                for (int e = 0; e < 4; ++e) { const float pe = __builtin_amdgcn_exp2f(s[kt][e] - mx); s[kt][e] = pe; ls += pe; }
            ls += __shfl_xor(ls, 16); ls += __shfl_xor(ls, 32); ls += __builtin_amdgcn_exp2f(sink2 - mx);
            const float rl = 1.f / ls;
            f32x4 o[4];
#pragma unroll
            for (int dt = 0; dt < 4; ++dt) o[dt] = (f32x4){0.f, 0.f, 0.f, 0.f};
#pragma unroll
            for (int kp = 0; kp < 6; ++kp) { u32x4 pw; pw.x = pkbf(s[2 * kp][0], s[2 * kp][1]); pw.y = pkbf(s[2 * kp][2], s[2 * kp][3]); pw.z = pkbf(s[2 * kp + 1][0], s[2 * kp + 1][1]); pw.w = pkbf(s[2 * kp + 1][2], s[2 * kp + 1][3]);
                const bf16x8 pf = __builtin_bit_cast(bf16x8, pw);
#pragma unroll
                for (int dt = 0; dt < 4; ++dt) { const int vd = 16 * dt + l15, vsw = (vd >> 3) & 7, vc0 = 4 * kp + (q4 >> 1); const bf16_t* vrow = Vt + vd * 200 + 4 * (q4 & 1); const u32x2 lo = *(const u32x2*)(vrow + ((vc0 ^ vsw) << 3)), hi = *(const u32x2*)(vrow + (((vc0 + 2) ^ vsw) << 3));
                    u32x4 aw; aw.x = lo.x; aw.y = lo.y; aw.z = hi.x; aw.w = hi.y; o[dt] = mfma16(__builtin_bit_cast(bf16x8, aw), pf, o[dt]); } if (kp & 1) asm volatile("" ::: "memory"); }
            bf16_t* stg = (bf16_t*)(lds + 53248) + w * 1152;
#pragma unroll
            for (int dt = 0; dt < 4; ++dt) { u32x2 ow; ow.x = pkbf(o[dt][0] * rl, o[dt][1] * rl); ow.y = pkbf(o[dt][2] * rl, o[dt][3] * rl); *(u32x2*)(stg + l15 * 72 + 16 * dt + 4 * q4) = ow; }
            asm volatile("s_waitcnt lgkmcnt(0)" ::: "memory");
#pragma unroll
            for (int i = 0; i < 2; ++i) { const int row = 8 * i + (lane >> 3), chn = lane & 7; *(u32x4*)(Ob + (size_t)(qrow0 + t0 + row) * 1024 + head * 64 + 8 * chn) = *(const u32x4*)(stg + row * 72 + 8 * chn); }
            asm volatile("s_waitcnt lgkmcnt(0)" ::: "memory");
        }
    }
}

__device__ __forceinline__ void hgrn_item(int it, int& m0, int& h) { if (it < 4096) { h = it & 7; m0 = (it >> 10) * 8192 + ((it >> 3) & 127) * 64; } else { const int x = it - 4096; h = x & 7; m0 = MP + (x >> 3) * 64; } }
constexpr int HL_ZS = 0, HL_TOT = 16384, HL_KT = 18432, HL_VT = 36864, HL_QS = 55296, HL_KS = 72704, HL_ST = 90112, HL_SSQ = 124928;

#define HGRN_STAGE_ZV() \
    _Pragma("unroll") for (int i = 0; i < 2; ++i) { const int ch = tid + 512 * i, row = ch >> 4, cc = ch & 15; \
        *(u32x4*)(ZS + row * 128 + 8 * cc) = zfr[i]; const u32x4 vv = vr[i]; \
        _Pragma("unroll") for (int e = 0; e < 8; ++e) VT[(8 * cc + e) * 72 + ((((row >> 3) ^ (cc & 7)) << 3) | (row & 7))] = (u16)(vv[e >> 1] >> (16 * (e & 1))); }
#define HGRN_GATES() \
    float kk[16], bl[16]; float cum = 0.f; \
    _Pragma("unroll") for (int i = 0; i < 16; ++i) { const float z = fminf(fmaxf((float)ZS[(16 * seg + i) * 128 + k], -30.f), 30.f); const float ez = __builtin_amdgcn_exp2f(-1.4426950408889634f * z), sg = __builtin_amdgcn_rcpf(1.f + ez); cum += __logf(lbv + oml * sg); bl[i] = cum; kk[i] = oml * ez * sg; } \
    TOT[seg * 128 + k] = cum; \
    __syncthreads(); \
    const float t0_ = TOT[k], t1_ = TOT[128 + k], t2_ = TOT[256 + k], t3_ = TOT[384 + k]; \
    const float off = seg == 0 ? 0.f : seg == 1 ? t0_ : seg == 2 ? t0_ + t1_ : t0_ + t1_ + t2_; const float b31 = t0_ + t1_;

__device__ __forceinline__ void hgrn_passA(KP pk, char* lds, int j, int vcu, int G, bool dost) {
    int tid_ = threadIdx.x; asm volatile("" : "+v"(tid_)); const int tid = tid_, lane = tid & 63, w = __builtin_amdgcn_readfirstlane(tid >> 6), l15 = lane & 15, q4 = lane >> 4, k = tid & 127, seg = tid >> 7;
    _Float16* ZS = (_Float16*)(lds + HL_ZS); float* TOT = (float*)(lds + HL_TOT); bf16_t* KT = (bf16_t*)(lds + HL_KT); bf16_t* VT = (bf16_t*)(lds + HL_VT);
    const u16* ZF = (const u16*)(pk->ws + WS_POOL + ACT); const u16* VH = (const u16*)(pk->ws + WS_POOL + 2 * ACT);
    bf16_t* UB = (bf16_t*)(pk->out + OY); float* DB = (float*)(pk->ws + WS_DB);
    float lbv = 0.f, oml = 1.f; int hprev = -1;
    u32x4 zfr[2], vr[2];
#define PA_LOAD(itx) { int m0_, h_; hgrn_item(itx, m0_, h_); _Pragma("unroll") for (int i = 0; i < 2; ++i) { const int ch = tid + 512 * i; const size_t go = (size_t)(m0_ + (ch >> 4)) * 1024 + h_ * 128 + 8 * (ch & 15); zfr[i] = *(const u32x4*)(ZF + go); vr[i] = *(const u32x4*)(VH + go); } }
    if (vcu < 4160) PA_LOAD(vcu)
    for (int it = vcu; it < 4160; it += G) {
        int m0, h; hgrn_item(it, m0, h);
        if (j == 1 && h != hprev) { const float a = pk->in[11][h * 128 + k], b = pk->in[11][1024 + h * 128 + k]; lbv = 1.f / (1.f + __expf(a - b)); oml = 1.f - lbv; hprev = h; }
        __syncthreads();
        HGRN_STAGE_ZV()
        if (it + G < 4160) PA_LOAD(it + G)
        __syncthreads();
        HGRN_GATES()
        { u32x4 w0, w1; unsigned wk[8];
#pragma unroll
          for (int i = 0; i < 8; ++i) wk[i] = pkbf(kk[2 * i] * __expf(b31 - (off + bl[2 * i])), kk[2 * i + 1] * __expf(b31 - (off + bl[2 * i + 1])));
          w0.x = wk[0]; w0.y = wk[1]; w0.z = wk[2]; w0.w = wk[3]; w1.x = wk[4]; w1.y = wk[5]; w1.z = wk[6]; w1.w = wk[7];
          *(u32x4*)(KT + k * 72 + 16 * seg) = w0; *(u32x4*)(KT + k * 72 + 16 * seg + 8) = w1; }
        if (seg == 0) DB[(size_t)it * 128 + k] = __expf(b31 + t2_ + t3_);
        __syncthreads();
        const int kr = 16 * w + l15;
        const bf16x8 b0 = *(const bf16x8*)(KT + kr * 72 + 8 * q4), b1 = *(const bf16x8*)(KT + kr * 72 + 32 + 8 * q4);
        const float sc = __expf(TOT[256 + kr] + TOT[384 + kr]);
        bf16_t* stg = (bf16_t*)(lds + HL_QS) + w * 2176;
#pragma unroll
        for (int vt = 0; vt < 8; ++vt) { const int vv_ = 16 * vt + l15, vsw = (vv_ >> 3) & 7; const bf16_t* vp = VT + vv_ * 72; f32x4 a = {0.f, 0.f, 0.f, 0.f};
            a = mfma16(*(const bf16x8*)(vp + ((q4 ^ vsw) << 3)), b0, a); a = mfma16(*(const bf16x8*)(vp + (((4 + q4) ^ vsw) << 3)), b1, a);
            u32x2 ow; ow.x = pkbf(a[0] * sc, a[1] * sc); ow.y = pkbf(a[2] * sc, a[3] * sc); *(u32x2*)(stg + l15 * 136 + 16 * vt + 4 * q4) = ow; }
        asm volatile("s_waitcnt lgkmcnt(0)" ::: "memory");
        { bf16_t* up = UB + (size_t)it * 16384 + (16 * w) * 128;
#pragma unroll
          for (int i = 0; i < 4; ++i) { const int row = 4 * i + (lane >> 4), chn = lane & 15; if (dost) *(u32x4*)(up + row * 128 + 8 * chn) = *(const u32x4*)(stg + row * 136 + 8 * chn); } }
    }
#undef PA_LOAD
}
__device__ __forceinline__ void hgrn_passB(KP pk, int j, int G, bool dost) {
    int tid_ = threadIdx.x; asm volatile("" : "+v"(tid_)); const int gt = blockIdx.x * 512 + tid_, NTH = G * 512;
    bf16_t* UB = (bf16_t*)(pk->out + OY); const float* DB = (const float*)(pk->ws + WS_DB);
    for (int e = gt; e < 131072; e += NTH) {
        const int bh = e >> 12, k = (e >> 5) & 127, v4 = e & 31, b = bh >> 3, h = bh & 7;
        f32x4 S = {0.f, 0.f, 0.f, 0.f};
        bf16_t* ub = UB + (size_t)(b * 1024 + h) * 16384 + k * 128 + 4 * v4; const float* db = DB + (size_t)(b * 1024 + h) * 128 + k;
#pragma unroll 1
        for (int c0 = 0; c0 < 128; c0 += 8) {
            u32x2 uu[8]; float d[8];
#pragma unroll
            for (int i = 0; i < 8; ++i) { uu[i] = *(const u32x2*)(ub + (size_t)(c0 + i) * 8 * 16384); d[i] = db[(size_t)(c0 + i) * 1024]; }
#pragma unroll
            for (int i = 0; i < 8; ++i) { u32x2 sw; sw.x = pkbf(S[0], S[1]); sw.y = pkbf(S[2], S[3]); if (dost) *(u32x2*)(ub + (size_t)(c0 + i) * 8 * 16384) = sw;
                S[0] = d[i] * S[0] + bflo(uu[i].x); S[1] = d[i] * S[1] + bfhi(uu[i].x); S[2] = d[i] * S[2] + bflo(uu[i].y); S[3] = d[i] * S[3] + bfhi(uu[i].y); }
        }
        if (dost) *(f32x4*)(pk->out + OSP + (size_t)(j * 32 + bh) * 16384 + k * 128 + 4 * v4) = S;
    }
    for (int e = gt; e < 262144; e += NTH) {
        const int sbh = e >> 12, k = (e >> 5) & 127, v4 = e & 31, it = 4096 + sbh; const size_t eo = (size_t)k * 128 + 4 * v4;
        const f32x4 S0 = *(const f32x4*)(pk->in[4] + (size_t)(j * 64 + sbh) * 16384 + eo);
        bf16_t* ub = UB + (size_t)it * 16384 + eo; const u32x2 uu = *(const u32x2*)ub; const float d = DB[(size_t)it * 128 + k];
        u32x2 sw; sw.x = pkbf(S0[0], S0[1]); sw.y = pkbf(S0[2], S0[3]); if (dost) *(u32x2*)ub = sw;
        f32x4 S; S[0] = d * S0[0] + bflo(uu.x); S[1] = d * S0[1] + bfhi(uu.x); S[2] = d * S0[2] + bflo(uu.y); S[3] = d * S0[3] + bfhi(uu.y);
        if (dost) *(f32x4*)(pk->out + OSS + (size_t)(j * 64 + sbh) * 16384 + eo) = S;
    }
}
__device__ __forceinline__ void hgrn_passC(KP pk, char* lds, int j, int vcu, int G, bool dost) {
    int tid_ = threadIdx.x; asm volatile("" : "+v"(tid_)); const int tid = tid_, lane = tid & 63, w = __builtin_amdgcn_readfirstlane(tid >> 6), l15 = lane & 15, q4 = lane >> 4, k = tid & 127, seg = tid >> 7;
    _Float16* ZS = (_Float16*)(lds + HL_ZS); float* TOT = (float*)(lds + HL_TOT); bf16_t* VT = (bf16_t*)(lds + HL_VT);
    u16* QG = (u16*)(lds + HL_KT); bf16_t* QS = (bf16_t*)(lds + HL_QS); bf16_t* KS = (bf16_t*)(lds + HL_KS); bf16_t* ST = (bf16_t*)(lds + HL_ST); float* SSQ = (float*)(lds + HL_SSQ);
    u16* QH = (u16*)(pk->ws + WS_POOL); const u16* ZF = (const u16*)(pk->ws + WS_POOL + ACT); const u16* VH = (const u16*)(pk->ws + WS_POOL + 2 * ACT); const u16* GH = (const u16*)(pk->ws + WS_POOL + 3 * ACT);
    const bf16_t* UB = (const bf16_t*)(pk->out + OY); const float* onorm = pk->in[12] + j * 128;
    const int tt = w & 3, vh = w >> 2;
    float lbv = 0.f, oml = 1.f; int hprev = -1;
    float* ONL = (float*)(lds + HL_SSQ + 512); if (tid < 128) ONL[tid] = onorm[tid];
    u32x4 zfr[2], vr[2], qr[2], sr[4];
#define PC_LOAD(itx) { int m0_, h_; hgrn_item(itx, m0_, h_); _Pragma("unroll") for (int i = 0; i < 2; ++i) { const int ch = tid + 512 * i; const size_t go = (size_t)(m0_ + (ch >> 4)) * 1024 + h_ * 128 + 8 * (ch & 15); \
        zfr[i] = *(const u32x4*)(ZF + go); vr[i] = *(const u32x4*)(VH + go); qr[i] = *(const u32x4*)(QH + go); } \
        _Pragma("unroll") for (int i = 0; i < 4; ++i) { const int ch = tid + 512 * i; sr[i] = *(const u32x4*)(UB + (size_t)(itx) * 16384 + (ch >> 4) * 128 + 8 * (ch & 15)); } }
    if (vcu < 4160) PC_LOAD(vcu)
    for (int it = vcu; it < 4160; it += G) {
        int m0, h; hgrn_item(it, m0, h);
        if (j == 1 && h != hprev) { const float a = pk->in[11][h * 128 + k], b = pk->in[11][1024 + h * 128 + k]; lbv = 1.f / (1.f + __expf(a - b)); oml = 1.f - lbv; hprev = h; }
        __syncthreads();
        HGRN_STAGE_ZV()
#pragma unroll
        for (int i = 0; i < 2; ++i) { const int ch = tid + 512 * i; *(u32x4*)(QG + (ch >> 4) * 128 + 8 * (ch & 15)) = qr[i]; }
        u32x4 sc_[4];
#pragma unroll
        for (int i = 0; i < 4; ++i) sc_[i] = sr[i];
        u32x4 gr[2];
#pragma unroll
        for (int i = 0; i < 2; ++i) { const int ch = tid + 512 * i; gr[i] = *(const u32x4*)(GH + (size_t)(m0 + (ch >> 4)) * 1024 + h * 128 + 8 * (ch & 15)); }
        if (it + G < 4160) PC_LOAD(it + G)
        __syncthreads();
        HGRN_GATES()
        { u16* GS = (u16*)(lds + HL_ZS);
#pragma unroll
          for (int i = 0; i < 2; ++i) { const int ch = tid + 512 * i; *(u32x4*)(GS + (ch >> 4) * 128 + 8 * (ch & 15)) = gr[i]; } }
        float qv[16];
#pragma unroll
        for (int i = 0; i < 16; ++i) qv[i] = bf2f(QG[(16 * seg + i) * 128 + k]);
#pragma unroll
        for (int i = 0; i < 16; ++i) { const float bt = off + bl[i]; KS[(16 * seg + i) * 136 + k] = f2bf(kk[i] * __expf(b31 - bt)); QS[(16 * seg + i) * 136 + k] = f2bf(qv[i] * __expf(bt - b31)); }
#pragma unroll
        for (int i = 0; i < 4; ++i) { const int ch = tid + 512 * i, kr = ch >> 4, vc = ch & 15; const float sc = __expf(TOT[kr] + TOT[128 + kr]);
            const u32x4 sv = sc_[i];
#pragma unroll
            for (int e = 0; e < 8; ++e) { const unsigned wv = sv[e >> 1]; const float f = (e & 1) ? bfhi(wv) : bflo(wv); ST[(8 * vc + e) * 136 + ((((kr >> 3) ^ vc) << 3) | (kr & 7))] = f2bf(f * sc); } }
        __syncthreads();
        bf16x8 qf[4];
#pragma unroll
        for (int ks = 0; ks < 4; ++ks) qf[ks] = *(const bf16x8*)(QS + (16 * tt + l15) * 136 + 32 * ks + 8 * q4);
        f32x4 sc4[4];
#pragma unroll
        for (int st = 0; st < 4; ++st) { f32x4 a = {0.f, 0.f, 0.f, 0.f};
            if (st <= tt) {
#pragma unroll
                for (int ks = 0; ks < 4; ++ks) a = mfma16(*(const bf16x8*)(KS + (16 * st + l15) * 136 + 32 * ks + 8 * q4), qf[ks], a);
                if (st == tt) {
#pragma unroll
                    for (int r = 0; r < 4; ++r) if (4 * q4 + r > l15) a[r] = 0.f;
                }
            }
            sc4[st] = a; }
        f32x4 o[4];
#pragma unroll
        for (int vi = 0; vi < 4; ++vi) { const int vt = 4 * vh + vi; f32x4 a = {0.f, 0.f, 0.f, 0.f};
#pragma unroll
            for (int kp = 0; kp < 2; ++kp) if (2 * kp <= tt) {
                u32x4 pw; pw.x = pkbf(sc4[2 * kp][0], sc4[2 * kp][1]); pw.y = pkbf(sc4[2 * kp][2], sc4[2 * kp][3]); pw.z = pkbf(sc4[2 * kp + 1][0], sc4[2 * kp + 1][1]); pw.w = pkbf(sc4[2 * kp + 1][2], sc4[2 * kp + 1][3]);
                const int vv_ = 16 * vt + l15, vsw = (vv_ >> 3) & 7, vc0 = 4 * kp + (q4 >> 1); const bf16_t* vrow = VT + vv_ * 72 + 4 * (q4 & 1); const u32x2 lo = *(const u32x2*)(vrow + ((vc0 ^ vsw) << 3)), hi = *(const u32x2*)(vrow + (((vc0 + 2) ^ vsw) << 3));
                u32x4 aw; aw.x = lo.x; aw.y = lo.y; aw.z = hi.x; aw.w = hi.y; a = mfma16(__builtin_bit_cast(bf16x8, aw), __builtin_bit_cast(bf16x8, pw), a); }
#pragma unroll
            for (int ks = 0; ks < 4; ++ks) a = mfma16(*(const bf16x8*)(ST + (16 * vt + l15) * 136 + (((4 * ks + q4) ^ (((16 * vt + l15) >> 3) & 15)) << 3)), qf[ks], a);
            o[vi] = a; }
        float sq = 0.f;
#pragma unroll
        for (int vi = 0; vi < 4; ++vi) sq += (o[vi][0] * o[vi][0] + o[vi][1] * o[vi][1]) + (o[vi][2] * o[vi][2] + o[vi][3] * o[vi][3]);
        sq += __shfl_xor(sq, 16); sq += __shfl_xor(sq, 32);
        if (q4 == 0) SSQ[vh * 64 + 16 * tt + l15] = sq;
        __syncthreads();
        const float rn = rsqrtf((SSQ[16 * tt + l15] + SSQ[64 + 16 * tt + l15]) * (1.f / 128.f) + EPS);
        bf16_t* stg = (bf16_t*)(lds + HL_QS) + w * 1152;
#pragma unroll
        for (int vi = 0; vi < 4; ++vi) { const int v0 = 16 * (4 * vh + vi) + 4 * q4; const f32x4 gn = *(const f32x4*)(ONL + v0);
            const u32x2 g2 = *(const u32x2*)((const u16*)(lds + HL_ZS) + (16 * tt + l15) * 128 + v0); u32x2 ow;
            ow.x = pkbf(o[vi][0] * rn * gn[0] * bflo(g2.x), o[vi][1] * rn * gn[1] * bfhi(g2.x)); ow.y = pkbf(o[vi][2] * rn * gn[2] * bflo(g2.y), o[vi][3] * rn * gn[3] * bfhi(g2.y));
            *(u32x2*)(stg + l15 * 72 + 16 * vi + 4 * q4) = ow; }
        asm volatile("s_waitcnt lgkmcnt(0)" ::: "memory");
        if (dost) {
#pragma unroll
            for (int i = 0; i < 2; ++i) { const int row = 8 * i + (lane >> 3), chn = lane & 7; *(u32x4*)(QH + (size_t)(m0 + 16 * tt + row) * 1024 + h * 128 + 64 * vh + 8 * chn) = *(const u32x4*)(stg + row * 72 + 8 * chn); } }
    }
#undef PC_LOAD
}
__device__ __forceinline__ void final_phase(KP pk, int vcu, int G) {
    int tid_ = threadIdx.x; asm volatile("" : "+v"(tid_)); const int tid = tid_, lane = tid & 63, w = tid >> 6; const int gw = vcu * 8 + w, NGW = G * 8;
    float* Y = pk->out + OY; const bf16_t* XB = (const bf16_t*)(pk->ws + WS_XB); const float* ss = (const float*)(pk->ws + WS_SS) + (size_t)(8 % 3) * SS_SLOT; const float* fn = pk->in[16];
    f32x4 g[4];
#pragma unroll
    for (int q = 0; q < 4; ++q) g[q] = *(const f32x4*)(fn + 256 * q + 4 * lane);
    for (int r0 = gw; r0 < MT; r0 += 4 * NGW) {
        u32x2 xv[4][4]; float pv[4];
#pragma unroll
        for (int t = 0; t < 4; ++t) { const int r = r0 + t * NGW < MT ? r0 + t * NGW : r0;
            pv[t] = lane < 16 ? ss[(size_t)r * 16 + lane] : 0.f;
#pragma unroll
            for (int q = 0; q < 4; ++q) xv[t][q] = *(const u32x2*)(XB + (size_t)r * 1024 + 256 * q + 4 * lane); }
#pragma unroll
        for (int t = 0; t < 4; ++t) { const int r = r0 + t * NGW; if (r >= MT) break;
            float s = pv[t];
#pragma unroll
            for (int o = 1; o < 16; o <<= 1) s += __shfl_xor(s, o);
            s = __shfl(s, 0); const float rs = rsqrtf(s * (1.f / 1024.f) + EPS);
#pragma unroll
            for (int q = 0; q < 4; ++q) { f32x4 y; y[0] = bflo(xv[t][q].x) * rs * g[q][0]; y[1] = bfhi(xv[t][q].x) * rs * g[q][1]; y[2] = bflo(xv[t][q].y) * rs * g[q][2]; y[3] = bfhi(xv[t][q].y) * rs * g[q][3];
                *(f32x4*)(Y + (size_t)r * 1024 + 256 * q + 4 * lane) = y; } }
    }
}

#ifndef STAG_MODE
#define STAG_MODE 0
#endif
#ifndef STAG_T
#define STAG_T 26
#endif
__device__ __forceinline__ void stagger(int bx, int usec_total) {
    if (STAG_MODE == 0) return;
    const int grp = STAG_MODE == 1 ? (bx & 7) : ((bx >> 3) & 7);
    const unsigned long long t0 = __builtin_amdgcn_s_memrealtime(); const unsigned long long dt = (unsigned long long)(grp * usec_total * 100 / 8);
    while (__builtin_amdgcn_s_memrealtime() - t0 < dt) __builtin_amdgcn_s_sleep(8);
}

constexpr int LDS_BYTES = 147456;
constexpr int PH_A = 3 + 2 * NHALF, PH_H = 5 + 2 * NHALF, NPHASE = 2 + 2 * (PH_A + PH_H);
#ifndef SKIPMASK
#define SKIPMASK 0
#endif
#ifndef PROBE_KIND
#define PROBE_KIND -1
#endif
#ifndef PROBE_REP
#define PROBE_REP 1
#endif
#ifndef PROBE_NOEPI
#define PROBE_NOEPI 0
#endif
__global__ void __launch_bounds__(512, 2) fwd_kernel(Params p_unused) {
    extern __shared__ __attribute__((aligned(16))) unsigned char lds[];
    cg::grid_group grid = cg::this_grid();
    const int G = gridDim.x, bx = blockIdx.x; const int vcu = (G % 8 == 0) ? (bx % 8) * (G / 8) + bx / 8 : bx;
    volatile LAS unsigned* misc = (volatile LAS unsigned*)((LAS unsigned char*)lds + 131072 + 320);
    if (threadIdx.x < 64) misc[threadIdx.x] = 0u;
    __syncthreads();
    int ph, ph_hi; XcdBarrier bar; { KP k0 = kargs(); ph = k0->ph_lo; ph_hi = k0->ph_hi; bar.bar = (unsigned*)(k0->ws + WS_CTL) + 4096; bar.x = 0u; bar.st = misc + 8; }
    for (; ph < ph_hi; ++ph) {
        int layer = 0, kind, half = 0;
        if (ph == 0) kind = 0; else if (ph == NPHASE - 1) kind = 10;
        else { int q = ph - 1; if (q < PH_A) { layer = 0; } else if (q < PH_A + PH_H) { layer = 1; q -= PH_A; } else if (q < 2 * PH_A + PH_H) { layer = 2; q -= PH_A + PH_H; } else { layer = 3; q -= 2 * PH_A + PH_H; }
            if (layer & 1) { if (q < 4) kind = 6 + q; else if (q == 4) kind = 3; else { kind = 4 + ((q - 5) & 1); half = (q - 5) >> 1; } }
            else { if (q < 3) kind = 1 + q; else { kind = 4 + ((q - 3) & 1); half = (q - 3) >> 1; } } }
        const int j = layer >> 1;
        int nrep = 1; if (kind == PROBE_KIND) nrep = PROBE_REP;
        for (int rep = 0; rep < nrep; ++rep) {
        if (rep) xcd_barrier(bar);
        KP pk = kargs();
        if (kind == 0) { if (!(SKIPMASK & 1)) prologue(pk, (char*)lds, vcu, G); }
        else if (kind == 1 && !(SKIPMASK & 2)) {
            stagger(bx, STAG_T);
            unsigned char* ws = pk->ws; float* out = pk->out; bf16_t* WB = (bf16_t*)(ws + WS_W); float* ssb = (float*)(ws + WS_SS);
            pg8::Gemm g{(bf16_t*)(ws + WS_XB), WB + wmat_off(layer, 0), MT, 1536, 1024}; pg8::StaticOrder S; S.init(MP, 1536, 1024, G, bx); S.split(128, 2, 4);
            EpiQKV E{ws, out, j, (2 * layer) % 3};
            EpiMix<EpiQKV> EM{E, (float*)(ws + WS_SPK), (unsigned*)(ws + WS_CTL + 32768) + ph * 256, 4, 128, 2, (PROBE_NOEPI && rep + 1 < nrep) ? 0u : 0xffu};
            pg8::gemm_phase<EpiMix<EpiQKV>, pg8::StaticOrder, PG_ALIGN, PG_SP2>((PG8_LAS unsigned char*)lds, g, S, EM);
        } else if (kind == 2) { if (!(SKIPMASK & 4)) attn_phase(pk, (char*)lds, j, vcu, G); }
        else if ((kind == 3 || kind == 5) && !(SKIPMASK & 8)) {
            unsigned char* ws = pk->ws; bf16_t* WB = (bf16_t*)(ws + WS_W); float* ssb = (float*)(ws + WS_SS);
            const bool dn = kind == 5; const int K = dn ? 4096 : 1024;
            const bf16_t* A = dn ? (const bf16_t*)(ws + WS_POOL) - (size_t)(half * HROWS) * 4096 : ((layer & 1) ? (const bf16_t*)(ws + WS_POOL) : (const bf16_t*)(ws + WS_POOL + ACT));
            pg8::Gemm g{A, WB + wmat_off(layer, dn ? 3 : 1), MT, 1024, K}; pg8::StaticOrder S;
            if (dn) { S.init(HROWS, 1024, K, G, bx, half * (HROWS / 256)); if (half == NHALF - 1) S.split(128, 2, 8); } else { S.init(MP, 1024, K, G, bx); S.split(128, 2, 4); }
            EpiRes E{(bf16_t*)(ws + WS_XB), ssb + (size_t)((2 * layer + (dn ? 2 : 1)) % 3) * SS_SLOT};
            EpiMix<EpiRes> EM{E, (float*)(ws + WS_SPK), (unsigned*)(ws + WS_CTL + 32768) + ph * 256, dn ? 8 : 4, 128, 2, (PROBE_NOEPI && rep + 1 < nrep) ? 0u : 0xffu};
            pg8::gemm_phase<EpiMix<EpiRes>, pg8::StaticOrder, PG_ALIGN, PG_SP2>((PG8_LAS unsigned char*)lds, g, S, EM);
        } else if (kind == 4 && !(SKIPMASK & 16)) {
            unsigned char* ws = pk->ws; bf16_t* WB = (bf16_t*)(ws + WS_W); float* ssb = (float*)(ws + WS_SS);
            pg8::Gemm g{(bf16_t*)(ws + WS_XB), WB + wmat_off(layer, 2), MT, 4096, 1024}; pg8::StaticOrder S; S.init(HROWS, 4096, 1024, G, bx, half * (HROWS / 256)); if (half == NHALF - 1) S.split(128, 2, 4);
            EpiUp E{ssb + (size_t)((2 * layer + 1) % 3) * SS_SLOT, (bf16_t*)(ws + WS_POOL) - (size_t)(half * HROWS) * 4096, (PROBE_NOEPI == 2 && rep + 1 < nrep) ? 255 : (PROBE_NOEPI == 3 && rep + 1 < nrep) ? 0x7ffffffe : 0x7fffffff};
            EpiMix<EpiUp> EM{E, (float*)(ws + WS_SPK), (unsigned*)(ws + WS_CTL + 32768) + ph * 256, 4, 128, 2, 0xffu};
            pg8::gemm_phase<EpiMix<EpiUp>, pg8::StaticOrder, PG_ALIGN, PG_SP2>((PG8_LAS unsigned char*)lds, g, S, EM);
        } else if (kind == 6 && !(SKIPMASK & 32)) {
            stagger(bx, STAG_T);
            unsigned char* ws = pk->ws; bf16_t* WB = (bf16_t*)(ws + WS_W); float* ssb = (float*)(ws + WS_SS);
            pg8::Gemm g{(bf16_t*)(ws + WS_XB), WB + wmat_off(layer, 0), MT, 4096, 1024}; pg8::StaticOrder S; S.init(MP, 4096, 1024, G, bx); S.split(128, 2, 4);
            EpiHin E{ssb + (size_t)((2 * layer) % 3) * SS_SLOT, (u16*)(ws + WS_POOL)};
            EpiMix<EpiHin> EM{E, (float*)(ws + WS_SPK), (unsigned*)(ws + WS_CTL + 32768) + ph * 256, 4, 128, 2, (PROBE_NOEPI && rep + 1 < nrep) ? 0u : 0xffu};
            pg8::gemm_phase<EpiMix<EpiHin>, pg8::StaticOrder, PG_ALIGN, PG_SP2>((PG8_LAS unsigned char*)lds, g, S, EM);
        } else if (kind == 7) { if (!(SKIPMASK & 64)) hgrn_passA(pk, (char*)lds, j, vcu, G, !(PROBE_NOEPI && rep + 1 < nrep)); }
        else if (kind == 8) { if (!(SKIPMASK & 128)) hgrn_passB(pk, j, G, !(PROBE_NOEPI && rep + 1 < nrep)); }
        else if (kind == 9) { if (!(SKIPMASK & 256)) hgrn_passC(pk, (char*)lds, j, vcu, G, !(PROBE_NOEPI && rep + 1 < nrep)); }
        else if (kind == 10) { if (!(SKIPMASK & 512)) final_phase(pk, vcu, G); }
        }
        if (PROBE_KIND == 99 && ph == 3) for (int e = 0; e < PROBE_REP; ++e) xcd_barrier(bar);
        if (ph + 1 < ph_hi) { if (ph == 0) { grid.sync(); KP k1 = kargs(); bar = xcd_barrier_post((unsigned*)(k1->ws + WS_CTL) + 4096, misc + 8); } else xcd_barrier(bar); }
    }
}

#ifndef MK_PER_PHASE
#define MK_PER_PHASE 0
#endif
extern "C" void kernel_launch(void* const* d_in, const int* in_sizes, int n_in, void* d_out, int out_size, void* d_ws, size_t ws_size, hipStream_t stream) {
    static int grid = 0;
    if (grid == 0) {
        int dev = 0, cus = 0, per_cu = 0;
        hipGetDevice(&dev); hipDeviceGetAttribute(&cus, hipDeviceAttributeMultiprocessorCount, dev);
        hipFuncSetAttribute((const void*)fwd_kernel, hipFuncAttributeMaxDynamicSharedMemorySize, LDS_BYTES);
        hipOccupancyMaxActiveBlocksPerMultiprocessor(&per_cu, (const void*)fwd_kernel, 512, LDS_BYTES);
        (void)hipGetLastError();
        if (per_cu < 1) { fprintf(stderr, "kernel_launch: occupancy query says %d blocks/CU\n", per_cu); per_cu = 1; }
        grid = cus;
        if (n_in != 17 || ws_size < WS_SS + 3 * SS_SLOT * 4) { fprintf(stderr, "kernel_launch: unexpected n_in %d / ws_size %zu (need %zu)\n", n_in, ws_size, (size_t)WS_END); }
    }
    Params p{};
    for (int i = 0; i < 17; ++i) p.in[i] = (const float*)d_in[i];
    p.out = (float*)d_out; p.ws = (unsigned char*)d_ws;
#if MK_PER_PHASE
    for (int ph = 0; ph < NPHASE; ++ph) { p.ph_lo = ph; p.ph_hi = ph + 1; hipLaunchKernelGGL(fwd_kernel, dim3(grid), dim3(512), LDS_BYTES, stream, p); }
#else
    p.ph_lo = 0; p.ph_hi = NPHASE;
    void* args[] = {&p};
    hipError_t e = hipLaunchCooperativeKernel((const void*)fwd_kernel, dim3(grid), dim3(512), args, LDS_BYTES, stream);
    if (e != hipSuccess) fprintf(stderr, "cooperative launch failed: %s (grid %d)\n", hipGetErrorString(e), grid);
#endif
}
```

```cpp
#include <hip/hip_runtime.h>
#include <hip/hip_cooperative_groups.h>
#include <cstdio>
#include <cstdint>
namespace cg = cooperative_groups;
#ifndef PG_WGM
#define PG_WGM 8
#endif
#ifndef PG_ALIGN
#define PG_ALIGN true
#endif
#ifndef PG_SP2
#define PG_SP2 true
#endif
namespace pg8 {
#define PG8_LAS __attribute__((address_space(3)))
typedef unsigned short bf16_t;
typedef short bf16x8 __attribute__((ext_vector_type(8)));
typedef float f32x4 __attribute__((ext_vector_type(4)));
typedef unsigned u32x4 __attribute__((ext_vector_type(4)));
constexpr int BM = 256, BK = 64, HALF = 128, HTB = HALF * BK * 2  , STAGE_BYTES = 8 * HTB, NXCD = 8, WGM = PG_WGM;

__host__ __device__ __forceinline__ int lds_byte(int r, int c) { const int st = (r >> 4) * 2 + (c >> 5), rr = r & 15, cc = c & 31, ob = rr * 64 + cc * 2; return st * 1024 + (ob ^ (((ob >> 9) & 1) << 5)); }
__host__ __device__ __forceinline__ void stage_rc(int b, int& R, int& C) { const int st = b / 1024, sb = b % 1024, swz = sb ^ (((sb >> 9) & 1) << 5); R = (st >> 1) * 16 + swz / 64; C = (st & 1) * 32 + (swz % 64) / 2; }
__host__ __device__ __forceinline__ int perm32(int rho) { const int n = rho >> 4, i = rho & 15; return 8 * (i >> 2) + 4 * n + (i & 3); }

struct Unit { int pm, pn, k0, nt, sp; };
struct Gemm { const bf16_t* A; const bf16_t* Bt; int M, N, K; };

struct StaticOrder {
    int nM, nN, nwg, G, c, ntK, pm0;
    int sM0, sNM, sS, sKs, nsp;
    __host__ __device__ void init(int M, int N, int K, int G_, int c_, int pm0_ = 0) { pm0 = pm0_; nM = M / BM; nN = N / BM; nwg = nM * nN; G = G_; c = c_; ntK = K / BK; sM0 = 0; sNM = 0; sS = 1; sKs = K; nsp = 0; }
    __host__ __device__ void split(int m0, int nm, int S) { sM0 = m0; sNM = nm; sS = S; sKs = (ntK / S) * BK; nsp = nm * nN * S; }
    __host__ __device__ bool next(int i, Unit& u) const {
        const long L = (long)i * G + c;
        if (L >= nwg) { const long L2 = L - (long)((nwg + G - 1) / G) * G; if (L2 < 0 || L2 >= nsp) return false;
            const int ks = (int)(L2 % sS), un = (int)(L2 / sS); u.pm = sM0 + un % sNM; u.pn = un / sNM; u.k0 = ks * sKs; u.nt = sKs / BK; u.sp = ks; return true; }
        int wgid = (int)L; { const int q = nwg / NXCD, r = nwg % NXCD, xcd = wgid % NXCD, off = wgid / NXCD; wgid = (xcd < r ? xcd * (q + 1) : r * (q + 1) + (xcd - r) * q) + off; }
        const int nig = WGM * nN, gid = wgid / nig, fm = gid * WGM, gsz = (nM - fm) < WGM ? (nM - fm) : WGM;
        u.pm = pm0 + fm + ((wgid % nig) % gsz); u.pn = (wgid % nig) / gsz; u.k0 = 0; u.nt = ntK; u.sp = -1; return true;
    }
    __device__ __forceinline__ void a_ready(const Unit&) const {}
    __device__ __forceinline__ void done(const Unit&) const {}
};

__device__ __forceinline__ unsigned cvt_pk_bf16(float lo, float hi) { unsigned r; asm volatile("v_cvt_pk_bf16_f32 %0, %1, %2" : "=v"(r) : "v"(lo), "v"(hi)); return r; }
typedef float f32x2 __attribute__((ext_vector_type(2)));
template <class Epi, class Sched, bool ALIGN_EPI = false, bool SP2 = false>
__device__ __forceinline__ void gemm_phase(PG8_LAS unsigned char* lds, const Gemm g, const Sched& S, const Epi& E) {
    int tid_ = threadIdx.x; asm volatile("" : "+v"(tid_)); const int tid = tid_, wid = __builtin_amdgcn_readfirstlane(tid >> 6), lane = tid & 63, wr = wid >> 2, wc = wid & 3, fr = lane & 15, fq = lane >> 4;
    const int K = g.K;
    unsigned voffA[2], voffB[2];
#pragma unroll
    for (int i = 0; i < 2; ++i) { int R, C; stage_rc(tid * 16 + i * 8192, R, C); const int Rb = Epi::PERM ? ((R & ~31) + perm32(R & 31)) : R;
        voffA[i] = (unsigned)(R * K + C) * 2u; voffB[i] = (unsigned)(Rb * K + C) * 2u; }
    const size_t kstep = (size_t)(BK * 2);
    const size_t hstep = (size_t)HALF * K * 2;
    const size_t tstep = 2 * hstep;
    const unsigned ldsw = (unsigned)wid * 1024u;
    const int aoff = lds_byte(wr * 64 + fr, fq * 8), boff = lds_byte(wc * 32 + fr, fq * 8);
#define PG8_SA(b, h) (((b) * 2 + (h)) * HTB)
#define PG8_SB(b, h) ((4 + (b) * 2 + (h)) * HTB)
#define PG8_STAGE(bufoff, gbase, voff) do { _Pragma("unroll") for (int _i = 0; _i < 2; ++_i) \
        __builtin_amdgcn_global_load_lds((const unsigned*)((const char*)(gbase) + (voff)[_i]), (PG8_LAS unsigned*)(lds + (bufoff) + ldsw + _i * 8192), 16, 0, 0); } while (0)
#define PG8_LDA(dst, b, h) do { _Pragma("unroll") for (int m = 0; m < 4; ++m) _Pragma("unroll") for (int k = 0; k < 2; ++k) dst[m][k] = *(const PG8_LAS bf16x8*)(lds + PG8_SA(b, h) + aoff + m * 2048 + k * 1024); } while (0)
#define PG8_LDB(dst, b, h) do { _Pragma("unroll") for (int n = 0; n < 2; ++n) _Pragma("unroll") for (int k = 0; k < 2; ++k) dst[n][k] = *(const PG8_LAS bf16x8*)(lds + PG8_SB(b, h) + boff + n * 2048 + k * 1024); } while (0)
#define PG8_MMA(ai, bj, At, Bt) do { __builtin_amdgcn_s_setprio(1); _Pragma("unroll") for (int m = 0; m < 4; ++m) _Pragma("unroll") for (int n = 0; n < 2; ++n) _Pragma("unroll") for (int k = 0; k < 2; ++k) \
        acc[ai][bj][m][n] = __builtin_amdgcn_mfma_f32_16x16x32_bf16(Bt[n][k], At[m][k], acc[ai][bj][m][n], 0, 0, 0); __builtin_amdgcn_s_setprio(0); } while (0)
#define PG8_WAIT_V(n) asm volatile("s_waitcnt vmcnt(" #n ")" ::: "memory")
#define PG8_WAIT_L(n) asm volatile("s_waitcnt lgkmcnt(" #n ")" ::: "memory")
#define PG8_BAR __builtin_amdgcn_s_barrier()
#define PG8_SCHED __builtin_amdgcn_sched_barrier(0)
    Unit cur, nxt; int ui = 0;
    if (!S.next(0, cur)) return;
    f32x4 acc[2][2][4][2];
#pragma unroll
    for (int a = 0; a < 2; ++a)
#pragma unroll
        for (int b = 0; b < 2; ++b)
#pragma unroll
            for (int m = 0; m < 4; ++m)
#pragma unroll
                for (int n = 0; n < 2; ++n) acc[a][b][m][n] = (f32x4){0.f, 0.f, 0.f, 0.f};
    bf16x8 At[4][2], B0[2][2], B1[2][2];
    const char* cA = (const char*)g.A + (size_t)cur.pm * tstep + (size_t)cur.k0 * 2; const char* cB = (const char*)g.Bt + (size_t)cur.pn * tstep + (size_t)cur.k0 * 2;
    S.a_ready(cur);
    if constexpr (SP2) {
        PG8_STAGE(PG8_SB(0, 0), cB, voffB); PG8_STAGE(PG8_SB(0, 1), cB + hstep, voffB); PG8_STAGE(PG8_SA(0, 0), cA, voffA); PG8_STAGE(PG8_SA(0, 1), cA + hstep, voffA);
        if (wr == 1) PG8_BAR;
        PG8_WAIT_V(2); PG8_BAR;
        PG8_STAGE(PG8_SB(1, 0), cB + kstep, voffB); PG8_STAGE(PG8_SA(1, 0), cA + kstep, voffA); PG8_STAGE(PG8_SB(1, 1), cB + hstep + kstep, voffB);
        PG8_WAIT_V(6); PG8_BAR;
    } else {
        PG8_STAGE(PG8_SB(0, 0), cB, voffB); PG8_STAGE(PG8_SA(0, 0), cA, voffA); PG8_STAGE(PG8_SB(0, 1), cB + hstep, voffB); PG8_STAGE(PG8_SA(0, 1), cA + hstep, voffA);
        if (wr == 1) PG8_BAR;
        PG8_WAIT_V(4); PG8_BAR;
        PG8_STAGE(PG8_SB(1, 0), cB + kstep, voffB); PG8_STAGE(PG8_SA(1, 0), cA + kstep, voffA); PG8_STAGE(PG8_SB(1, 1), cB + hstep + kstep, voffB);
        PG8_WAIT_V(6); PG8_BAR;
    }
    for (;;) {
        const bool has_next = S.next(ui + 1, nxt);
        const char* nA = has_next ? (const char*)g.A + (size_t)nxt.pm * tstep + (size_t)nxt.k0 * 2 : cA; const char* nB = has_next ? (const char*)g.Bt + (size_t)nxt.pn * tstep + (size_t)nxt.k0 * 2 : cB;
        const int nt = cur.nt;
        for (int t = 0; t < nt; t += 2) {
            const bool last = (t == nt - 2);
            const char* a1 = cA + (size_t)(t + 1) * kstep;
            const char* a2 = last ? nA : cA + (size_t)(t + 2) * kstep; const char* b2 = last ? nB : cB + (size_t)(t + 2) * kstep;
            const char* a3 = a2 + kstep; const char* b3 = b2 + kstep;
            if (last && has_next) S.a_ready(nxt);
            if constexpr (SP2) {
            PG8_LDB(B0, 0, 0); PG8_LDB(B1, 0, 1); PG8_SCHED; PG8_LDA(At, 0, 0); PG8_STAGE(PG8_SA(1, 1), a1 + hstep, voffA);
            PG8_WAIT_V(8); PG8_WAIT_L(0); PG8_BAR; PG8_MMA(0, 0, At, B0); PG8_MMA(0, 1, At, B1); PG8_BAR; PG8_SCHED;
            PG8_LDA(At, 0, 1); PG8_STAGE(PG8_SB(0, 0), b2, voffB); PG8_STAGE(PG8_SB(0, 1), b2 + hstep, voffB); PG8_STAGE(PG8_SA(0, 0), a2, voffA);
            PG8_WAIT_V(8); PG8_WAIT_L(0); PG8_BAR; PG8_MMA(1, 0, At, B0); PG8_MMA(1, 1, At, B1); PG8_BAR; PG8_SCHED;
            PG8_LDB(B0, 1, 0); PG8_LDB(B1, 1, 1); PG8_SCHED; PG8_LDA(At, 1, 0); PG8_STAGE(PG8_SA(0, 1), a2 + hstep, voffA);
            PG8_WAIT_V(8); PG8_WAIT_L(0); PG8_BAR; PG8_MMA(0, 0, At, B0); PG8_MMA(0, 1, At, B1); PG8_BAR; PG8_SCHED;
            PG8_LDA(At, 1, 1); PG8_STAGE(PG8_SB(1, 0), b3, voffB); PG8_STAGE(PG8_SB(1, 1), b3 + hstep, voffB); PG8_STAGE(PG8_SA(1, 0), a3, voffA);
            PG8_WAIT_V(8); PG8_WAIT_L(0); PG8_BAR; PG8_MMA(1, 0, At, B0); PG8_MMA(1, 1, At, B1); PG8_BAR; PG8_SCHED;
            } else {
            PG8_LDB(B0, 0, 0); PG8_SCHED; PG8_LDA(At, 0, 0); PG8_STAGE(PG8_SA(1, 1), a1 + hstep, voffA);
            PG8_WAIT_L(8); PG8_BAR; PG8_WAIT_L(0); PG8_MMA(0, 0, At, B0); PG8_BAR; PG8_SCHED;
            PG8_LDB(B1, 0, 1); PG8_STAGE(PG8_SB(0, 0), b2, voffB);
            PG8_BAR; PG8_WAIT_L(0); PG8_MMA(0, 1, At, B1); PG8_BAR;
            PG8_LDA(At, 0, 1); PG8_STAGE(PG8_SA(0, 0), a2, voffA);
            PG8_BAR; PG8_WAIT_L(0); PG8_MMA(1, 0, At, B0); PG8_BAR; PG8_SCHED;
            PG8_STAGE(PG8_SB(0, 1), b2 + hstep, voffB);
            PG8_WAIT_V(6); PG8_BAR; PG8_MMA(1, 1, At, B1); PG8_BAR;
            PG8_LDB(B0, 1, 0); PG8_SCHED; PG8_LDA(At, 1, 0); PG8_STAGE(PG8_SA(0, 1), a2 + hstep, voffA);
            PG8_WAIT_L(8); PG8_BAR; PG8_WAIT_L(0); PG8_MMA(0, 0, At, B0); PG8_BAR; PG8_SCHED;
            PG8_LDB(B1, 1, 1); PG8_STAGE(PG8_SB(1, 0), b3, voffB);
            PG8_BAR; PG8_WAIT_L(0); PG8_MMA(0, 1, At, B1); PG8_BAR;
            PG8_LDA(At, 1, 1); PG8_STAGE(PG8_SA(1, 0), a3, voffA);
            PG8_BAR; PG8_WAIT_L(0); PG8_MMA(1, 0, At, B0); PG8_BAR; PG8_SCHED;
            PG8_STAGE(PG8_SB(1, 1), b3 + hstep, voffB);
            PG8_WAIT_V(6); PG8_BAR; PG8_MMA(1, 1, At, B1); PG8_BAR;
            }
        }
        if constexpr (ALIGN_EPI) { if (wr == 0) PG8_BAR; }
        if constexpr (!Epi::AFTER_DRAIN) { E(acc, cur, wr, wc, fr, fq); S.done(cur); }
        if (!has_next) break;
#pragma unroll
        for (int a = 0; a < 2; ++a)
#pragma unroll
            for (int b = 0; b < 2; ++b)
#pragma unroll
                for (int m = 0; m < 4; ++m)
#pragma unroll
                    for (int n = 0; n < 2; ++n) acc[a][b][m][n] = (f32x4){0.f, 0.f, 0.f, 0.f};
        cur = nxt; cA = nA; cB = nB; ++ui;
        if constexpr (ALIGN_EPI) { if (wr == 1) PG8_BAR; }
    }
    PG8_WAIT_V(0);
    if constexpr (!ALIGN_EPI) { if (wr == 0) PG8_BAR; }
    PG8_BAR;
    if constexpr (Epi::AFTER_DRAIN) { E.fused(acc, cur, wr, wc, fr, fq, lds, wid, lane); S.done(cur); }
#undef PG8_SA
#undef PG8_SB
#undef PG8_STAGE
#undef PG8_LDA
#undef PG8_LDB
#undef PG8_MMA
#undef PG8_WAIT_V
#undef PG8_WAIT_L
#undef PG8_BAR
#undef PG8_SCHED
}
}
#define LAS __attribute__((address_space(3)))
#define XB_TMO      128
#define XB_XCNT(j)  (256  + 64 * (j))
#define XB_XSUB(j)  (1280 + 64 * (j))
#define XB_XGEN(j)  (2304 + 64 * (j))
#define XB_TOP      3328
#define XB_TOPGEN   3392
#define XCD_BAR_WORDS 3456
#define XB_SPIN_CAP (1u << 18)

__device__ __forceinline__ unsigned xb_ld(unsigned* p)              { return __hip_atomic_load(p, __ATOMIC_RELAXED, __HIP_MEMORY_SCOPE_AGENT); }
__device__ __forceinline__ unsigned xb_add(unsigned* p, unsigned v) { return __hip_atomic_fetch_add(p, v, __ATOMIC_RELAXED, __HIP_MEMORY_SCOPE_AGENT); }
__device__ __forceinline__ unsigned xb_xcc_id() { return (unsigned)__builtin_amdgcn_s_getreg((3 << 11) | 20) & 0xFu; }
#define XB_SPIN(cond, bar) do { unsigned _sp = 0; while (cond) { __builtin_amdgcn_s_sleep(1); \
    if ((++_sp & 255u) == 0u) { if (xb_ld(&(bar)[XB_TMO])) break; if (_sp > XB_SPIN_CAP) { atomicAdd(&(bar)[XB_TMO], 1u); break; } } } } while (0)

struct XcdBarrier {
    unsigned* bar; unsigned x;
    volatile LAS unsigned* st;
};

__device__ __forceinline__ XcdBarrier xcd_barrier_post(unsigned* bar, volatile LAS unsigned* st) {
    XcdBarrier b; b.bar = bar; b.x = xb_xcc_id(); b.st = st;
    if (threadIdx.x == 0) (void)xb_add(&bar[XB_XCNT(b.x)], 1u);
    return b;
}
__device__ __forceinline__ void xcd_barrier_complete(unsigned* bar, unsigned x, unsigned& nloc, unsigned& nx) {
    const unsigned G = gridDim.x * gridDim.y * gridDim.z;
    unsigned sum, cnt, mine, sp = 0u;
    for (;;) {
        sum = 0u; cnt = 0u; mine = 0u;
#pragma unroll
        for (unsigned j = 0; j < 16; ++j) { const unsigned c = xb_ld(&bar[XB_XCNT(j)]); sum += c; cnt += (c > 0u) ? 1u : 0u; mine = (j == x) ? c : mine; }
        if (sum == G) break;
        __builtin_amdgcn_s_sleep(1);
        if ((++sp & 255u) == 0u) { if (xb_ld(&bar[XB_TMO])) break; if (sp > XB_SPIN_CAP) { atomicAdd(&bar[XB_TMO], 1u); break; } }
    }
    nloc = mine > 0u ? mine : 1u; nx = cnt > 0u ? cnt : 1u;
}

__device__ __forceinline__ void xcd_barrier(const XcdBarrier& b) {
    asm volatile("s_waitcnt vmcnt(0)" ::: "memory");
    __syncthreads();
    if (threadIdx.x == 0) {
        unsigned* bar = b.bar;
        __builtin_amdgcn_s_waitcnt(0);
        unsigned nloc = b.st[0], nx = b.st[1];
        if (nloc == 0u) { xcd_barrier_complete(bar, b.x, nloc, nx); b.st[0] = nloc; b.st[1] = nx; }
        const unsigned old = xb_add(&bar[XB_XSUB(b.x)], 1u);
        const unsigned gen = old / nloc;
        if (old + 1u == (gen + 1u) * nloc) {
            __builtin_amdgcn_fence(__ATOMIC_RELEASE, "agent");
            asm volatile("s_waitcnt vmcnt(0)" ::: "memory");
            const unsigned og = xb_add(&bar[XB_TOP], 1u);
            const unsigned tg = og / nx;
            if (og + 1u == (tg + 1u) * nx) xb_add(&bar[XB_TOPGEN], 1u);
            else XB_SPIN(xb_ld(&bar[XB_TOPGEN]) == tg, bar);
            __builtin_amdgcn_fence(__ATOMIC_ACQUIRE, "agent");
            xb_add(&bar[XB_XGEN(b.x)], 1u);
            asm volatile("s_waitcnt vmcnt(0)" ::: "memory");
        } else {
            XB_SPIN(xb_ld(&bar[XB_XGEN(b.x)]) == gen, bar);
            __builtin_amdgcn_fence(__ATOMIC_ACQUIRE, "agent");
            asm volatile("s_waitcnt vmcnt(0)" ::: "memory");
        }
    }
    __syncthreads();
}

using pg8::bf16_t; using pg8::bf16x8; using pg8::f32x4; using pg8::u32x4; using pg8::Unit;
typedef unsigned u32x2 __attribute__((ext_vector_type(2)));
typedef unsigned short u16;
constexpr int MP_ROWS = 32768;
constexpr int DM = 1024, MP = 32768, MS = 512, MT = MP + MS, SEQ = 8192;
constexpr float EPS = 1e-5f, LOG2E = 1.4426950408889634f, C2 = 0.125f * 1.4426950408889634f;
constexpr size_t MiB = 1u << 20;
constexpr size_t WS_SS = 492 * MiB, SS_SLOT = (size_t)MT * 16;
constexpr size_t WS_CTL = 0, CTL_BYTES = 131072;
constexpr size_t WS_SPK = 166 * MiB;
constexpr size_t WS_ROPE = 2 * MiB;
constexpr size_t WS_DB = 3 * MiB;
constexpr size_t WS_W = 6 * MiB;
constexpr size_t WS_XB = 100 * MiB;
constexpr size_t WS_POOL = 232 * MiB;
constexpr size_t ACT = (size_t)MT * DM * 2;
constexpr size_t WS_END = WS_POOL + 4 * ACT;
constexpr size_t OY = 0, OKP = 34078720, OVP = 34340864, OSP = 34603008, OKS = 35651584, OVS = 36175872, OSS = 36700160;
constexpr size_t WM = 1048576;
#ifndef NHALF
#define NHALF 1
#endif
constexpr int HROWS = MP_ROWS / NHALF;
struct Params { const float* in[17]; float* out; unsigned char* ws; int ph_lo, ph_hi; };
typedef const __attribute__((address_space(4))) Params* KP;
__device__ __forceinline__ KP kargs() { KP k = (KP)__builtin_amdgcn_kernarg_segment_ptr(); asm volatile("" : "+s"(k)); return k; }

__device__ __forceinline__ unsigned pkbf(float lo, float hi) { typedef float f2 __attribute__((ext_vector_type(2))); typedef __bf16 b2 __attribute__((ext_vector_type(2))); f2 v = {lo, hi}; b2 b = __builtin_convertvector(v, b2); return __builtin_bit_cast(unsigned, b); }
__device__ __forceinline__ float bflo(unsigned u) { return __uint_as_float(u << 16); }
__device__ __forceinline__ float bfhi(unsigned u) { return __uint_as_float(u & 0xffff0000u); }
__device__ __forceinline__ float bf2f(u16 u) { return __uint_as_float((unsigned)u << 16); }
__device__ __forceinline__ u16 f2bf(float f) { return (u16)(pkbf(f, 0.f) & 0xffffu); }
__device__ __forceinline__ unsigned pkh(float lo, float hi) { _Float16 a = (_Float16)lo, b = (_Float16)hi; return (unsigned)__builtin_bit_cast(u16, a) | ((unsigned)__builtin_bit_cast(u16, b) << 16); }
__device__ __forceinline__ f32x4 mfma16(bf16x8 a, bf16x8 b, f32x4 c) { return __builtin_amdgcn_mfma_f32_16x16x32_bf16(a, b, c, 0, 0, 0); }
__device__ __forceinline__ int row_pos(int r) { return r < MP ? (r & (SEQ - 1)) : 2048 + ((r - MP) & 63); }
__device__ __forceinline__ float row_rs(const float* ss, int r) { const f32x4* q = (const f32x4*)(ss + (size_t)r * 16); f32x4 a = q[0], b = q[1], c = q[2], d = q[3]; a = (a + b) + (c + d); return rsqrtf(((a[0] + a[1]) + (a[2] + a[3])) * (1.f / 1024.f) + EPS); }
__device__ __forceinline__ float silu(float v) { return v * __builtin_amdgcn_rcpf(1.f + __builtin_amdgcn_exp2f(-1.4426950408889634f * v)); }

#ifndef COLPERM
#define COLPERM 1
#endif
#ifndef NT_STORE
#define NT_STORE 0
#endif
#if NT_STORE == 2
__device__ __forceinline__ void st16_wt(void* p, u32x4 v) { asm volatile("global_store_dwordx4 %0, %1, off sc0 sc1" :: "v"(p), "v"(v) : "memory"); }
#define ST16(p, v) st16_wt((void*)(p), (v))
#define ST8(p, v) (*(u32x2*)(p) = (v))
#define STF4(p, v) (*(f32x4*)(p) = (v))
#elif NT_STORE
#define ST16(p, v) __builtin_nontemporal_store((v), (u32x4*)(p))
#define ST8(p, v) __builtin_nontemporal_store((v), (u32x2*)(p))
#define STF4(p, v) __builtin_nontemporal_store((v), (f32x4*)(p))
#else
#define ST16(p, v) (*(u32x4*)(p) = (v))
#define ST8(p, v) (*(u32x2*)(p) = (v))
#define STF4(p, v) (*(f32x4*)(p) = (v))
#endif
#define EPI_ROW(idx) (u.pm * 256 + ((idx) >> 2) * 128 + wr * 64 + ((idx) & 3) * 16 + fr)
#define EPI_LOAD_RS(rsv, ss) float rsv[8]; { f32x4 pv_[8]; \
    _Pragma("unroll") for (int idx = 0; idx < 8; ++idx) pv_[idx] = *(const f32x4*)((ss) + (size_t)EPI_ROW(idx) * 16 + fq * 4); \
    _Pragma("unroll") for (int idx = 0; idx < 8; ++idx) { float s_ = (pv_[idx][0] + pv_[idx][1]) + (pv_[idx][2] + pv_[idx][3]); s_ += __shfl_xor(s_, 16); s_ += __shfl_xor(s_, 32); rsv[idx] = rsqrtf(s_ * (1.f / 1024.f) + EPS); } }
struct EpiQKV {
    static constexpr bool PERM = true, AFTER_DRAIN = false;
    unsigned char* ws; float* out; int j, slot;
    __device__ __forceinline__ void operator()(const f32x4 (&acc)[2][2][4][2], const Unit& u, int wr, int wc, int fr, int fq, unsigned mask) const {
        const float* ss = (const float*)(ws + WS_SS) + (size_t)slot * SS_SLOT; const float* rope = (const float*)(ws + WS_ROPE);
        const int pn = u.pn; const bool rot = (pn <= 4) && ((wc & 1) == 0); const float qs = pn < 4 ? C2 : 1.f; const bool rl_ = rot && fq < 2;
        EPI_LOAD_RS(rsv, ss)
        const f32x4 one4 = {1.f, 1.f, 1.f, 1.f}, zero4 = {0.f, 0.f, 0.f, 0.f};
        f32x4 c0 = one4, c1 = one4, s0 = zero4, s1 = zero4, dc0 = one4, dc1 = one4, ds0 = zero4, ds1 = zero4;
        if (rl_) { const float* t = rope + row_pos(EPI_ROW(0)) * 16; c0 = *(const f32x4*)t; c1 = *(const f32x4*)(t + 4); s0 = *(const f32x4*)(t + 8); s1 = *(const f32x4*)(t + 12);
            const float* d = rope + 16 * 16; dc0 = *(const f32x4*)d; dc1 = *(const f32x4*)(d + 4); ds0 = *(const f32x4*)(d + 8); ds1 = *(const f32x4*)(d + 12); }
        const float sgn = fq == 0 ? -1.f : 1.f;
#pragma unroll
        for (int idx = 0; idx < 8; ++idx) {
            const int ai = idx >> 2, m = idx & 3;
            if (idx > 0) {
                const bool back = (idx == 4) && (u.pm >= 128);
                const float dsg = back ? -1.f : 1.f;
#pragma unroll 1
                for (int st_ = (idx == 4 ? (back ? 3 : 5) : 1); st_ > 0; --st_) { const f32x4 e0 = ds0 * dsg, e1 = ds1 * dsg; const f32x4 a0 = c0 * dc0 - s0 * e0, b0 = s0 * dc0 + c0 * e0, a1 = c1 * dc1 - s1 * e1, b1 = s1 * dc1 + c1 * e1; c0 = a0; s0 = b0; c1 = a1; s1 = b1; }
            }
            if (!((mask >> idx) & 1u)) continue;
            int rl = ai * 128 + wr * 64 + m * 16 + fr; asm volatile("" : "+v"(rl)); const int r = u.pm * 256 + rl;
            const float rs = rsv[idx];
            const f32x4 sn0 = s0 * sgn, sn1 = s1 * sgn;
            float* nk = nullptr;
            if (pn >= 4) {
                if (u.pm < 128) { const int t = (u.pm & 31) * 256 + rl; if (t >= 8064) nk = out + (pn == 4 ? OKP : OVP) + ((size_t)((j * 4 + (u.pm >> 5)) * 128 + (t - 8064))) * 256; }
                else { const int rr = r - MP; nk = out + (pn == 4 ? OKS : OVS) + ((size_t)((j * 8 + (rr >> 6)) * 128 + 64 + (rr & 63))) * 256; }
            }
#pragma unroll
            for (int bj = 0; bj < 2; ++bj) {
                f32x4 v0 = acc[ai][bj][m][0] * rs, v1 = acc[ai][bj][m][1] * rs;
                if (rot) {
                    f32x4 p0, p1;
#pragma unroll
                    for (int e = 0; e < 4; ++e) { p0[e] = __shfl_xor(v0[e], 16); p1[e] = __shfl_xor(v1[e], 16); }
                    v0 = v0 * c0 + p0 * sn0; v1 = v1 * c1 + p1 * sn1;
                }
                v0 = v0 * qs; v1 = v1 * qs;
                const int cw = bj * 128 + wc * 32 + 8 * fq;
                bf16_t* dst = pn < 4 ? (bf16_t*)(ws + WS_POOL) + (size_t)r * 1024 + pn * 256 + cw : (bf16_t*)(ws + WS_POOL + 2 * ACT) + (pn == 4 ? (size_t)0 : (size_t)MT * 256) + (size_t)r * 256 + cw;
                u32x4 w; w.x = pkbf(v0[0], v0[1]); w.y = pkbf(v0[2], v0[3]); w.z = pkbf(v1[0], v1[1]); w.w = pkbf(v1[2], v1[3]);
                ST16(dst, w);
                if (nk) { *(f32x4*)(nk + cw) = v0; *(f32x4*)(nk + cw + 4) = v1; }
            }
        }
    }
};
struct EpiRes {
    static constexpr bool PERM = true, AFTER_DRAIN = false;
    bf16_t* XB; float* ssn;
    __device__ __forceinline__ void operator()(const f32x4 (&acc)[2][2][4][2], const Unit& u, int wr, int wc, int fr, int fq, unsigned mask) const {
        const int col0 = u.pn * 256 + wc * 32 + 8 * fq;
        u32x4 xin[8][2];
#pragma unroll
        for (int idx = 0; idx < 8; ++idx) { const bf16_t* xp = XB + (size_t)EPI_ROW(idx) * 1024 + col0; xin[idx][0] = *(const u32x4*)xp; xin[idx][1] = *(const u32x4*)(xp + 128); }
#pragma unroll
        for (int idx = 0; idx < 8; ++idx) {
            const int ai = idx >> 2, m = idx & 3;
            if (!((mask >> idx) & 1u)) continue;
            int r = EPI_ROW(idx); asm volatile("" : "+v"(r)); bf16_t* xo = XB + (size_t)r * 1024 + col0; float sq = 0.f;
#pragma unroll
            for (int bj = 0; bj < 2; ++bj) { const u32x4 cx = xin[idx][bj]; const f32x4 a0 = acc[ai][bj][m][0], a1 = acc[ai][bj][m][1]; u32x4 w;
                w.x = pkbf(bflo(cx.x) + a0[0], bfhi(cx.x) + a0[1]); w.y = pkbf(bflo(cx.y) + a0[2], bfhi(cx.y) + a0[3]); w.z = pkbf(bflo(cx.z) + a1[0], bfhi(cx.z) + a1[1]); w.w = pkbf(bflo(cx.w) + a1[2], bfhi(cx.w) + a1[3]);
                ST16(xo + bj * 128, w);
#pragma unroll
                for (int e = 0; e < 4; ++e) { const float lo = bflo(w[e]), hi = bfhi(w[e]); sq += lo * lo + hi * hi; } }
            sq += __shfl_xor(sq, 16); sq += __shfl_xor(sq, 32);
            if (fq == 0) ssn[(size_t)r * 16 + u.pn * 4 + wc] = sq;
        }
    }
};
struct EpiUp {
    static constexpr bool PERM = true, AFTER_DRAIN = false;
    const float* ss; bf16_t* H; int rowmask;
    __device__ __forceinline__ void operator()(const f32x4 (&acc)[2][2][4][2], const Unit& u, int wr, int wc, int fr, int fq, unsigned mask) const {
        EPI_LOAD_RS(rsv, ss)
#pragma unroll
        for (int idx = 0; idx < 8; ++idx) {
            const int ai = idx >> 2, m = idx & 3;
            if (!((mask >> idx) & 1u)) continue;
            int r = EPI_ROW(idx); asm volatile("" : "+v"(r)); const float rs = rsv[idx];
#pragma unroll
            for (int bj = 0; bj < 2; ++bj) {
                f32x4 v0 = acc[ai][bj][m][0] * rs, v1 = acc[ai][bj][m][1] * rs;
#pragma unroll
                for (int e = 0; e < 4; ++e) { const float a = fmaxf(v0[e], 0.f), b = fmaxf(v1[e], 0.f); v0[e] = a * a; v1[e] = b * b; }
                u32x4 w; w.x = pkbf(v0[0], v0[1]); w.y = pkbf(v0[2], v0[3]); w.z = pkbf(v1[0], v1[1]); w.w = pkbf(v1[2], v1[3]);
                if (rowmask == 0x7ffffffe) ST16(H + ((size_t)(u.pm * 16 + u.pn) * 65536 + (size_t)(r & 255) * 256) + (COLPERM ? wc * 64 + bj * 32 : bj * 128 + wc * 32) + 8 * fq, w);
                else ST16(H + (size_t)(r & rowmask) * 4096 + u.pn * 256 + (COLPERM ? wc * 64 + bj * 32 : bj * 128 + wc * 32) + 8 * fq, w);
            }
        }
    }
};
struct EpiHin {
    static constexpr bool PERM = true, AFTER_DRAIN = false;
    const float* ss; u16* base;
    __device__ __forceinline__ void operator()(const f32x4 (&acc)[2][2][4][2], const Unit& u, int wr, int wc, int fr, int fq, unsigned mask) const {
        const int sel = u.pn >> 2; u16* ob = base + (size_t)sel * (ACT / 2);
        EPI_LOAD_RS(rsv, ss)
#pragma unroll
        for (int idx = 0; idx < 8; ++idx) {
            const int ai = idx >> 2, m = idx & 3;
            if (!((mask >> idx) & 1u)) continue;
            int r = EPI_ROW(idx); asm volatile("" : "+v"(r)); const float rs = rsv[idx];
#pragma unroll
            for (int bj = 0; bj < 2; ++bj) {
                f32x4 v0 = acc[ai][bj][m][0] * rs, v1 = acc[ai][bj][m][1] * rs; u32x4 w;
                if (sel == 1) { w.x = pkh(v0[0], v0[1]); w.y = pkh(v0[2], v0[3]); w.z = pkh(v1[0], v1[1]); w.w = pkh(v1[2], v1[3]); }
                else {
                    if (sel != 2) {
#pragma unroll
                        for (int e = 0; e < 4; ++e) { v0[e] = silu(v0[e]); v1[e] = silu(v1[e]); }
                    }
                    w.x = pkbf(v0[0], v0[1]); w.y = pkbf(v0[2], v0[3]); w.z = pkbf(v1[0], v1[1]); w.w = pkbf(v1[2], v1[3]);
                }
                ST16(ob + (size_t)r * 1024 + (u.pn & 3) * 256 + (COLPERM ? wc * 64 + bj * 32 : bj * 128 + wc * 32) + 8 * fq, w);
            }
        }
    }
};

template <class Epi> struct EpiMix {
    static constexpr bool PERM = Epi::PERM, AFTER_DRAIN = false;
    Epi E; float* P; unsigned* cnt; int S, m0, nm; unsigned pmask;
    __device__ __forceinline__ void operator()(f32x4 (&acc)[2][2][4][2], const Unit& u, int wr, int wc, int fr, int fq) const {
        unsigned mask = pmask;
        if (u.sp >= 0 && pmask == 0u) return;
        if (u.sp >= 0) {
            const int wid = wr * 4 + wc, lane = fq * 16 + fr, tile = (u.pm - m0) + nm * u.pn;
            float* pw = P + ((size_t)(tile * S + u.sp) * 8 + wid) * 8192 + lane * 4;
#pragma unroll
            for (int i = 0; i < 32; ++i) *(f32x4*)(pw + i * 256) = acc[i >> 4][(i >> 3) & 1][(i >> 1) & 3][i & 1];
            __builtin_amdgcn_fence(__ATOMIC_RELEASE, "agent");
            unsigned* cw = cnt + tile * 8 + wid;
            if (lane == 0) (void)__hip_atomic_fetch_add(cw, 1u, __ATOMIC_RELAXED, __HIP_MEMORY_SCOPE_AGENT);
            { unsigned sp_ = 0; while ((unsigned)__builtin_amdgcn_readfirstlane((int)__hip_atomic_load(cw, __ATOMIC_RELAXED, __HIP_MEMORY_SCOPE_AGENT)) < (unsigned)S) { __builtin_amdgcn_s_sleep(2); if (++sp_ > (1u << 22)) break; } }
            __builtin_amdgcn_fence(__ATOMIC_ACQUIRE, "agent");
            mask = S == 8 ? (1u << u.sp) : (3u << (2 * u.sp));
            const float* pr = P + ((size_t)(tile * S) * 8 + wid) * 8192 + lane * 4;
#pragma unroll
            for (int c = 0; c < 8; ++c) if ((mask >> c) & 1u) {
                f32x4 t0 = {0.f, 0.f, 0.f, 0.f}, t1 = t0, t2 = t0, t3 = t0; const int i0 = (c >> 2) * 16 + (c & 3) * 2;
#pragma unroll 2
                for (int s = 0; s < S; ++s) { const float* ps = pr + (size_t)s * 8 * 8192 + i0 * 256;
                    t0 += *(const f32x4*)(ps); t1 += *(const f32x4*)(ps + 256); t2 += *(const f32x4*)(ps + 8 * 256); t3 += *(const f32x4*)(ps + 9 * 256); }
                acc[c >> 2][0][c & 3][0] = t0; acc[c >> 2][0][c & 3][1] = t1; acc[c >> 2][1][c & 3][0] = t2; acc[c >> 2][1][c & 3][1] = t3;
            }
        }
        E(acc, u, wr, wc, fr, fq, mask);
    }
};

__device__ __forceinline__ int colperm(int a) { return (a & ~255) | (((a >> 5) & 1) << 7) | (((a >> 6) & 3) << 5) | (a & 31); }
__device__ __forceinline__ void p0_transpose_item(const float* W, const float* g, int K, int N, bf16_t* WT, float* scr, int item, int lane, bool perm) {
    const int nblk = N / 32, kb = item / nblk, nb = item % nblk, k0 = 64 * kb, n0 = 32 * nb;
    float wv[32];
#pragma unroll
    for (int i = 0; i < 32; ++i) { const int kk = 2 * i + (lane >> 5); wv[i] = W[(size_t)(k0 + kk) * N + n0 + (lane & 31)]; }
#pragma unroll
    for (int i = 0; i < 32; ++i) { const int kk = 2 * i + (lane >> 5); const float gs = g ? g[k0 + kk] : 1.f; scr[kk * 33 + (lane & 31)] = wv[i] * gs; }
    asm volatile("s_waitcnt lgkmcnt(0)" ::: "memory");
    const int c = lane & 7;
#pragma unroll
    for (int jj = 0; jj < 4; ++jj) { const int n = (lane >> 3) + 8 * jj; const float* s = scr + (8 * c) * 33 + n;
        u32x4 o; o.x = pkbf(s[0 * 33], s[1 * 33]); o.y = pkbf(s[2 * 33], s[3 * 33]); o.z = pkbf(s[4 * 33], s[5 * 33]); o.w = pkbf(s[6 * 33], s[7 * 33]);
        *(u32x4*)(WT + (size_t)(perm ? colperm(n0 + n) : n0 + n) * K + k0 + 8 * c) = o; }
    asm volatile("s_waitcnt lgkmcnt(0)" ::: "memory");
}
__device__ __forceinline__ size_t wlayer_base(int layer) { return layer == 0 ? 0 : layer == 1 ? (size_t)(10.5 * WM) : layer == 2 ? (size_t)(23.5 * WM) : (size_t)(34 * WM); }
__device__ __forceinline__ size_t wmat_off(int layer, int which) {
    const size_t b = wlayer_base(layer);
    if (layer & 1) return b + (which == 0 ? 0 : which == 1 ? 4 * WM : which == 2 ? 5 * WM : 9 * WM);
    return b + (which == 0 ? 0 : which == 1 ? (size_t)(1.5 * WM) : which == 2 ? (size_t)(2.5 * WM) : (size_t)(6.5 * WM));
}
__device__ __forceinline__ void prologue(KP pk, char* lds, int vcu, int G) {
    int tid_ = threadIdx.x; asm volatile("" : "+v"(tid_)); const int tid = tid_, lane = tid & 63, w = __builtin_amdgcn_readfirstlane(tid >> 6);
    const int gw = vcu * 8 + w, NGW = G * 8, gt = vcu * 512 + tid, NTH = G * 512;
    float* scr = (float*)(lds + w * 16384);
    bf16_t* WB = (bf16_t*)(pk->ws + WS_W);
    for (int it = gw; it < 24064; it += NGW) {
        int layer, r;
        if (it < 5376) { layer = 0; r = it; } else if (it < 12032) { layer = 1; r = it - 5376; } else if (it < 17408) { layer = 2; r = it - 12032; } else { layer = 3; r = it - 17408; }
        const int j = layer >> 1; const int n0 = (layer & 1) ? 2048 : 768; int which;
        if (r < n0) which = 0; else if (r < n0 + 512) { which = 1; r -= n0; } else if (r < n0 + 2560) { which = 2; r -= n0 + 512; } else { which = 3; r -= n0 + 2560; }
        const float* W; const float* g = nullptr; int K = 1024, N = 1024;
        if (which == 0) { g = pk->in[5] + layer * 1024; if (layer & 1) { W = pk->in[10] + (size_t)j * 4 * WM; N = 4096; } else { W = pk->in[7] + (size_t)j * 1536 * 1024; N = 1536; } }
        else if (which == 1) { W = ((layer & 1) ? pk->in[13] : pk->in[8]) + (size_t)j * WM; }
        else if (which == 2) { W = pk->in[14] + (size_t)layer * 4 * WM; g = pk->in[6] + layer * 1024; N = 4096; }
        else { W = pk->in[15] + (size_t)layer * 4 * WM; K = 4096; }
        p0_transpose_item(W, g, K, N, WB + wmat_off(layer, which), scr, r, lane, COLPERM && (which == 2 || (which == 0 && (layer & 1))));
    }
    bf16_t* XB = (bf16_t*)(pk->ws + WS_XB); float* ss0 = (float*)(pk->ws + WS_SS);
    for (int r0 = gw; r0 < MT; r0 += 2 * NGW) {
        const int r1 = r0 + NGW; const bool has1 = r1 < MT; const int rr[2] = {r0, has1 ? r1 : r0};
        f32x4 v[2][4];
#pragma unroll
        for (int t = 0; t < 2; ++t) { const int r = rr[t]; const float* src = r < MP ? pk->in[0] + (size_t)r * 1024 : pk->in[1] + (size_t)(r - MP) * 1024;
#pragma unroll
            for (int q = 0; q < 4; ++q) v[t][q] = *(const f32x4*)(src + 256 * q + 4 * lane); }
#pragma unroll
        for (int t = 0; t < 2; ++t) { const int r = rr[t]; float s = 0.f;
            if (t == 1 && !has1) break;
#pragma unroll
            for (int q = 0; q < 4; ++q) { u32x2 o; o.x = pkbf(v[t][q][0], v[t][q][1]); o.y = pkbf(v[t][q][2], v[t][q][3]); *(u32x2*)(XB + (size_t)r * 1024 + 256 * q + 4 * lane) = o;
                const float a = bflo(o.x), b = bfhi(o.x), c = bflo(o.y), d = bfhi(o.y); s += (a * a + b * b) + (c * c + d * d); }
#pragma unroll
            for (int o = 1; o < 64; o <<= 1) s += __shfl_xor(s, o);
            if (lane < 16) ss0[(size_t)r * 16 + lane] = lane == 0 ? s : 0.f; }
    }
    { u32x4* ctl = (u32x4*)(pk->ws + WS_CTL); const u32x4 z = {0u, 0u, 0u, 0u}; for (int e = gt; e < (int)(CTL_BYTES / 16); e += NTH) ctl[e] = z; }
    float* rope = (float*)(pk->ws + WS_ROPE);
    for (int e = gt; e < 65536; e += NTH) { const int pos = e >> 3, i = e & 7; const float inv = exp2f(-(float)i * 2.3664460711655217f); const float ang = (float)pos * inv;
        const double rev = (double)ang * 0.15915494309189535; const float fr = (float)(rev - __builtin_rint(rev));
        rope[pos * 16 + i] = __builtin_amdgcn_cosf(fr); rope[pos * 16 + 8 + i] = __builtin_amdgcn_sinf(fr); }
    for (int e = gt; e < 65536; e += NTH) { const int jj = e >> 15, rem = e & 32767, sb = rem >> 12, row = (rem >> 6) & 63, c4 = rem & 63;
        const size_t so = ((size_t)((jj * 8 + sb) * 128 + 64 + row)) * 256 + 4 * c4, dof = ((size_t)((jj * 8 + sb) * 128 + row)) * 256 + 4 * c4;
        *(f32x4*)(pk->out + OKS + dof) = *(const f32x4*)(pk->in[2] + so); *(f32x4*)(pk->out + OVS + dof) = *(const f32x4*)(pk->in[3] + so); }
}

__device__ __forceinline__ void attn_phase(KP pk, char* lds, int j, int vcu, int G) {
    int tid_ = threadIdx.x; asm volatile("" : "+v"(tid_)); const int tid = tid_, lane = tid & 63, w = __builtin_amdgcn_readfirstlane(tid >> 6), l15 = lane & 15, q4 = lane >> 4;
    bf16_t* Ks = (bf16_t*)lds; bf16_t* Vt = (bf16_t*)(lds + 27648);
    const bf16_t* Qb = (const bf16_t*)(pk->ws + WS_POOL); bf16_t* Ob = (bf16_t*)(pk->ws + WS_POOL + ACT);
    const bf16_t* Kb = (const bf16_t*)(pk->ws + WS_POOL + 2 * ACT); const bf16_t* Vb = Kb + (size_t)MT * 256;
    const float* ck = pk->in[2] + (size_t)j * 8 * 128 * 256; const float* cv = pk->in[3] + (size_t)j * 8 * 128 * 256; const float* sinks = pk->in[9] + j * 16;
    for (int unit = vcu; unit < 2080; unit += G) {
        int qrow0, kvh, kt0, sb = -1;
        if (unit < 2048) { const int b = unit >> 9, c = (unit >> 2) & 127; kvh = unit & 3; qrow0 = b * 8192 + c * 64; kt0 = c >= 2 ? 0 : (c == 1 ? 4 : 8); }
        else { const int u2 = unit - 2048; sb = u2 >> 2; kvh = u2 & 3; qrow0 = MP + sb * 64; kt0 = 0; }
        __syncthreads();
#pragma unroll
        for (int i = 0; i < 3; ++i) { const int ch = tid + 512 * i, key = ch >> 3, dc = ch & 7; u32x4 kv = {0u, 0u, 0u, 0u}, vv = kv;
            if (key >= 16 * kt0) {
                if (sb >= 0 && key < 128) { const size_t so = ((size_t)(sb * 128 + key) * 4 + kvh) * 64 + 8 * dc;
                    const f32x4 a = *(const f32x4*)(ck + so), b = *(const f32x4*)(ck + so + 4), c = *(const f32x4*)(cv + so), d = *(const f32x4*)(cv + so + 4);
                    kv.x = pkbf(a[0], a[1]); kv.y = pkbf(a[2], a[3]); kv.z = pkbf(b[0], b[1]); kv.w = pkbf(b[2], b[3]);
                    vv.x = pkbf(c[0], c[1]); vv.y = pkbf(c[2], c[3]); vv.z = pkbf(d[0], d[1]); vv.w = pkbf(d[2], d[3]); }
                else { const size_t so = (size_t)(qrow0 - 128 + key) * 256 + kvh * 64 + 8 * dc; kv = *(const u32x4*)(Kb + so); vv = *(const u32x4*)(Vb + so); }
            }
            *(u32x4*)(Ks + key * 72 + 8 * dc) = kv;
#pragma unroll
            for (int e = 0; e < 8; ++e) Vt[(8 * dc + e) * 200 + ((((key >> 3) ^ dc) << 3) | (key & 7))] = (u16)(vv[e >> 1] >> (16 * (e & 1)));
        }
        __syncthreads();
#pragma unroll 1
        for (int qt = 0; qt < 2; ++qt) {
            const int qi = 2 * w + qt, g = qi >> 2, t0 = 16 * (qi & 3), head = kvh * 4 + g;
            const bf16_t* qp = Qb + (size_t)(qrow0 + t0 + l15) * 1024 + head * 64 + 8 * q4;
            const bf16x8 qf0 = *(const bf16x8*)qp, qf1 = *(const bf16x8*)(qp + 32);
            f32x4 s[12]; const float sink2 = sinks[head] * LOG2E; float mx = sink2;
#pragma unroll
            for (int kt = 0; kt < 12; ++kt) { const bf16_t* kp = Ks + (16 * kt + l15) * 72 + 8 * q4;
                f32x4 a = {0.f, 0.f, 0.f, 0.f}; a = mfma16(*(const bf16x8*)kp, qf0, a); a = mfma16(*(const bf16x8*)(kp + 32), qf1, a);
                if (kt < kt0) a = (f32x4){-INFINITY, -INFINITY, -INFINITY, -INFINITY};
                s[kt] = a; mx = fmaxf(fmaxf(mx, fmaxf(a[0], a[1])), fmaxf(a[2], a[3])); if ((kt & 3) == 3) asm volatile("" ::: "memory"); }
            mx = fmaxf(mx, __shfl_xor(mx, 16)); mx = fmaxf(mx, __shfl_xor(mx, 32));
            float ls = 0.f;
#pragma unroll
            for (int kt = 0; kt < 12; ++kt)
#pragma unroll
                for (int e = 0; e < 4; ++e) { const float pe = __builtin_amdgcn_exp2f(s[kt][e] - mx); s[kt][e] = pe; ls += pe; }
            ls += __shfl_xor(ls, 16); ls += __shfl_xor(ls, 32); ls += __builtin_amdgcn_exp2f(sink2 - mx);
            const float rl = 1.f / ls;
            f32x4 o[4];
#pragma unroll
            for (int dt = 0; dt < 4; ++dt) o[dt] = (f32x4){0.f, 0.f, 0.f, 0.f};
#pragma unroll
            for (int kp = 0; kp < 6; ++kp) { u32x4 pw; pw.x = pkbf(s[2 * kp][0], s[2 * kp][1]); pw.y = pkbf(s[2 * kp][2], s[2 * kp][3]); pw.z = pkbf(s[2 * kp + 1][0], s[2 * kp + 1][1]); pw.w = pkbf(s[2 * kp + 1][2], s[2 * kp + 1][3]);
                const bf16x8 pf = __builtin_bit_cast(bf16x8, pw);
#pragma unroll
                for (int dt = 0; dt < 4; ++dt) { const int vd = 16 * dt + l15, vsw = (vd >> 3) & 7, vc0 = 4 * kp + (q4 >> 1); const bf16_t* vrow = Vt + vd * 200 + 4 * (q4 & 1); const u32x2 lo = *(const u32x2*)(vrow + ((vc0 ^ vsw) << 3)), hi = *(const u32x2*)(vrow + (((vc0 + 2) ^ vsw) << 3));
                    u32x4 aw; aw.x = lo.x; aw.y = lo.y; aw.z = hi.x; aw.w = hi.y; o[dt] = mfma16(__builtin_bit_cast(bf16x8, aw), pf, o[dt]); } if (kp & 1) asm volatile("" ::: "memory"); }
            bf16_t* stg = (bf16_t*)(lds + 53248) + w * 1152;
#pragma unroll
            for (int dt = 0; dt < 4; ++dt) { u32x2 ow; ow.x = pkbf(o[dt][0] * rl, o[dt][1] * rl); ow.y = pkbf(o[dt][2] * rl, o[dt][3] * rl); *(u32x2*)(stg + l15 * 72 + 16 * dt + 4 * q4) = ow; }
            asm volatile("s_waitcnt lgkmcnt(0)" ::: "memory");
#pragma unroll
            for (int i = 0; i < 2; ++i) { const int row = 8 * i + (lane >> 3), chn = lane & 7; *(u32x4*)(Ob + (size_t)(qrow0 + t0 + row) * 1024 + head * 64 + 8 * chn) = *(const u32x4*)(stg + row * 72 + 8 * chn); }
            asm volatile("s_waitcnt lgkmcnt(0)" ::: "memory");
        }
    }
}

__device__ __forceinline__ void hgrn_item(int it, int& m0, int& h) { if (it < 4096) { h = it & 7; m0 = (it >> 10) * 8192 + ((it >> 3) & 127) * 64; } else { const int x = it - 4096; h = x & 7; m0 = MP + (x >> 3) * 64; } }
constexpr int HL_ZS = 0, HL_TOT = 16384, HL_KT = 18432, HL_VT = 36864, HL_QS = 55296, HL_KS = 72704, HL_ST = 90112, HL_SSQ = 124928;

#define HGRN_STAGE_ZV() \
    _Pragma("unroll") for (int i = 0; i < 2; ++i) { const int ch = tid + 512 * i, row = ch >> 4, cc = ch & 15; \
        *(u32x4*)(ZS + row * 128 + 8 * cc) = zfr[i]; const u32x4 vv = vr[i]; \
        _Pragma("unroll") for (int e = 0; e < 8; ++e) VT[(8 * cc + e) * 72 + ((((row >> 3) ^ (cc & 7)) << 3) | (row & 7))] = (u16)(vv[e >> 1] >> (16 * (e & 1))); }
#define HGRN_GATES() \
    float kk[16], bl[16]; float cum = 0.f; \
    _Pragma("unroll") for (int i = 0; i < 16; ++i) { const float z = fminf(fmaxf((float)ZS[(16 * seg + i) * 128 + k], -30.f), 30.f); const float ez = __builtin_amdgcn_exp2f(-1.4426950408889634f * z), sg = __builtin_amdgcn_rcpf(1.f + ez); cum += __builtin_amdgcn_logf(lbv + oml * sg); bl[i] = cum; kk[i] = oml * ez * sg; } \
    TOT[seg * 128 + k] = cum; \
    __syncthreads(); \
    const float t0_ = TOT[k], t1_ = TOT[128 + k], t2_ = TOT[256 + k], t3_ = TOT[384 + k]; \
    const float off = seg == 0 ? 0.f : seg == 1 ? t0_ : seg == 2 ? t0_ + t1_ : t0_ + t1_ + t2_; const float b31 = t0_ + t1_;

__device__ __forceinline__ void hgrn_passA(KP pk, char* lds, int j, int vcu, int G, bool dost) {
    int tid_ = threadIdx.x; asm volatile("" : "+v"(tid_)); const int tid = tid_, lane = tid & 63, w = __builtin_amdgcn_readfirstlane(tid >> 6), l15 = lane & 15, q4 = lane >> 4, k = tid & 127, seg = tid >> 7;
    _Float16* ZS = (_Float16*)(lds + HL_ZS); float* TOT = (float*)(lds + HL_TOT); bf16_t* KT = (bf16_t*)(lds + HL_KT); bf16_t* VT = (bf16_t*)(lds + HL_VT);
    const u16* ZF = (const u16*)(pk->ws + WS_POOL + ACT); const u16* VH = (const u16*)(pk->ws + WS_POOL + 2 * ACT);
    bf16_t* UB = (bf16_t*)(pk->out + OY); float* DB = (float*)(pk->ws + WS_DB);
    float lbv = 0.f, oml = 1.f; int hprev = -1;
    u32x4 zfr[2], vr[2];
#define PA_LOAD(itx) { int m0_, h_; hgrn_item(itx, m0_, h_); _Pragma("unroll") for (int i = 0; i < 2; ++i) { const int ch = tid + 512 * i; const size_t go = (size_t)(m0_ + (ch >> 4)) * 1024 + h_ * 128 + 8 * (ch & 15); zfr[i] = *(const u32x4*)(ZF + go); vr[i] = *(const u32x4*)(VH + go); } }
    if (vcu < 4160) PA_LOAD(vcu)
    for (int it = vcu; it < 4160; it += G) {
        int m0, h; hgrn_item(it, m0, h);
        if (j == 1 && h != hprev) { const float a = pk->in[11][h * 128 + k], b = pk->in[11][1024 + h * 128 + k]; lbv = 1.f / (1.f + __expf(a - b)); oml = 1.f - lbv; hprev = h; }
        __syncthreads();
        HGRN_STAGE_ZV()
        if (it + G < 4160) PA_LOAD(it + G)
        __syncthreads();
        HGRN_GATES()
        { u32x4 w0, w1; unsigned wk[8];
#pragma unroll
          for (int i = 0; i < 8; ++i) wk[i] = pkbf(kk[2 * i] * __builtin_amdgcn_exp2f(b31 - (off + bl[2 * i])), kk[2 * i + 1] * __builtin_amdgcn_exp2f(b31 - (off + bl[2 * i + 1])));
          w0.x = wk[0]; w0.y = wk[1]; w0.z = wk[2]; w0.w = wk[3]; w1.x = wk[4]; w1.y = wk[5]; w1.z = wk[6]; w1.w = wk[7];
          *(u32x4*)(KT + k * 72 + 16 * seg) = w0; *(u32x4*)(KT + k * 72 + 16 * seg + 8) = w1; }
        if (seg == 0) DB[(size_t)it * 128 + k] = __builtin_amdgcn_exp2f(b31 + t2_ + t3_);
        __syncthreads();
        const int kr = 16 * w + l15;
        const bf16x8 b0 = *(const bf16x8*)(KT + kr * 72 + 8 * q4), b1 = *(const bf16x8*)(KT + kr * 72 + 32 + 8 * q4);
        const float sc = __builtin_amdgcn_exp2f(TOT[256 + kr] + TOT[384 + kr]);
        bf16_t* stg = (bf16_t*)(lds + HL_QS) + w * 2176;
#pragma unroll
        for (int vt = 0; vt < 8; ++vt) { const int vv_ = 16 * vt + l15, vsw = (vv_ >> 3) & 7; const bf16_t* vp = VT + vv_ * 72; f32x4 a = {0.f, 0.f, 0.f, 0.f};
            a = mfma16(*(const bf16x8*)(vp + ((q4 ^ vsw) << 3)), b0, a); a = mfma16(*(const bf16x8*)(vp + (((4 + q4) ^ vsw) << 3)), b1, a);
            u32x2 ow; ow.x = pkbf(a[0] * sc, a[1] * sc); ow.y = pkbf(a[2] * sc, a[3] * sc); *(u32x2*)(stg + l15 * 136 + 16 * vt + 4 * q4) = ow; }
        asm volatile("s_waitcnt lgkmcnt(0)" ::: "memory");
        { bf16_t* up = UB + (size_t)it * 16384 + (16 * w) * 128;
#pragma unroll
          for (int i = 0; i < 4; ++i) { const int row = 4 * i + (lane >> 4), chn = lane & 15; if (dost) *(u32x4*)(up + row * 128 + 8 * chn) = *(const u32x4*)(stg + row * 136 + 8 * chn); } }
    }
#undef PA_LOAD
}
__device__ __forceinline__ void hgrn_passB(KP pk, int j, int G, bool dost) {
    int tid_ = threadIdx.x; asm volatile("" : "+v"(tid_)); const int gt = blockIdx.x * 512 + tid_, NTH = G * 512;
    bf16_t* UB = (bf16_t*)(pk->out + OY); const float* DB = (const float*)(pk->ws + WS_DB);
    for (int e = gt; e < 131072; e += NTH) {
        const int bh = e >> 12, k = (e >> 5) & 127, v4 = e & 31, b = bh >> 3, h = bh & 7;
        f32x4 S = {0.f, 0.f, 0.f, 0.f};
        bf16_t* ub = UB + (size_t)(b * 1024 + h) * 16384 + k * 128 + 4 * v4; const float* db = DB + (size_t)(b * 1024 + h) * 128 + k;
#pragma unroll 1
        for (int c0 = 0; c0 < 128; c0 += 8) {
            u32x2 uu[8]; float d[8];
#pragma unroll
            for (int i = 0; i < 8; ++i) { uu[i] = *(const u32x2*)(ub + (size_t)(c0 + i) * 8 * 16384); d[i] = db[(size_t)(c0 + i) * 1024]; }
#pragma unroll
            for (int i = 0; i < 8; ++i) { u32x2 sw; sw.x = pkbf(S[0], S[1]); sw.y = pkbf(S[2], S[3]); if (dost) *(u32x2*)(ub + (size_t)(c0 + i) * 8 * 16384) = sw;
                S[0] = d[i] * S[0] + bflo(uu[i].x); S[1] = d[i] * S[1] + bfhi(uu[i].x); S[2] = d[i] * S[2] + bflo(uu[i].y); S[3] = d[i] * S[3] + bfhi(uu[i].y); }
        }
        if (dost) *(f32x4*)(pk->out + OSP + (size_t)(j * 32 + bh) * 16384 + k * 128 + 4 * v4) = S;
    }
    for (int e = gt; e < 262144; e += NTH) {
        const int sbh = e >> 12, k = (e >> 5) & 127, v4 = e & 31, it = 4096 + sbh; const size_t eo = (size_t)k * 128 + 4 * v4;
        const f32x4 S0 = *(const f32x4*)(pk->in[4] + (size_t)(j * 64 + sbh) * 16384 + eo);
        bf16_t* ub = UB + (size_t)it * 16384 + eo; const u32x2 uu = *(const u32x2*)ub; const float d = DB[(size_t)it * 128 + k];
        u32x2 sw; sw.x = pkbf(S0[0], S0[1]); sw.y = pkbf(S0[2], S0[3]); if (dost) *(u32x2*)ub = sw;
        f32x4 S; S[0] = d * S0[0] + bflo(uu.x); S[1] = d * S0[1] + bfhi(uu.x); S[2] = d * S0[2] + bflo(uu.y); S[3] = d * S0[3] + bfhi(uu.y);
        if (dost) *(f32x4*)(pk->out + OSS + (size_t)(j * 64 + sbh) * 16384 + eo) = S;
    }
}
__device__ __forceinline__ void hgrn_passC(KP pk, char* lds, int j, int vcu, int G, bool dost) {
    int tid_ = threadIdx.x; asm volatile("" : "+v"(tid_)); const int tid = tid_, lane = tid & 63, w = __builtin_amdgcn_readfirstlane(tid >> 6), l15 = lane & 15, q4 = lane >> 4, k = tid & 127, seg = tid >> 7;
    _Float16* ZS = (_Float16*)(lds + HL_ZS); float* TOT = (float*)(lds + HL_TOT); bf16_t* VT = (bf16_t*)(lds + HL_VT);
    u16* QG = (u16*)(lds + HL_KT); bf16_t* QS = (bf16_t*)(lds + HL_QS); bf16_t* KS = (bf16_t*)(lds + HL_KS); bf16_t* ST = (bf16_t*)(lds + HL_ST); float* SSQ = (float*)(lds + HL_SSQ);
    u16* QH = (u16*)(pk->ws + WS_POOL); const u16* ZF = (const u16*)(pk->ws + WS_POOL + ACT); const u16* VH = (const u16*)(pk->ws + WS_POOL + 2 * ACT); const u16* GH = (const u16*)(pk->ws + WS_POOL + 3 * ACT);
    const bf16_t* UB = (const bf16_t*)(pk->out + OY); const float* onorm = pk->in[12] + j * 128;
    const int tt = w & 3, vh = w >> 2;
    float lbv = 0.f, oml = 1.f; int hprev = -1;
    float* ONL = (float*)(lds + HL_SSQ + 512); if (tid < 128) ONL[tid] = onorm[tid];
    u32x4 zfr[2], vr[2], qr[2], sr[4];
#define PC_LOAD(itx) { int m0_, h_; hgrn_item(itx, m0_, h_); _Pragma("unroll") for (int i = 0; i < 2; ++i) { const int ch = tid + 512 * i; const size_t go = (size_t)(m0_ + (ch >> 4)) * 1024 + h_ * 128 + 8 * (ch & 15); \
        zfr[i] = *(const u32x4*)(ZF + go); vr[i] = *(const u32x4*)(VH + go); qr[i] = *(const u32x4*)(QH + go); } \
        _Pragma("unroll") for (int i = 0; i < 4; ++i) { const int ch = tid + 512 * i; sr[i] = *(const u32x4*)(UB + (size_t)(itx) * 16384 + (ch >> 4) * 128 + 8 * (ch & 15)); } }
    if (vcu < 4160) PC_LOAD(vcu)
    for (int it = vcu; it < 4160; it += G) {
        int m0, h; hgrn_item(it, m0, h);
        if (j == 1 && h != hprev) { const float a = pk->in[11][h * 128 + k], b = pk->in[11][1024 + h * 128 + k]; lbv = 1.f / (1.f + __expf(a - b)); oml = 1.f - lbv; hprev = h; }
        __syncthreads();
        HGRN_STAGE_ZV()
#pragma unroll
        for (int i = 0; i < 2; ++i) { const int ch = tid + 512 * i; *(u32x4*)(QG + (ch >> 4) * 128 + 8 * (ch & 15)) = qr[i]; }
        u32x4 sc_[4];
#pragma unroll
        for (int i = 0; i < 4; ++i) sc_[i] = sr[i];
        u32x4 gr[2];
#pragma unroll
        for (int i = 0; i < 2; ++i) { const int ch = tid + 512 * i; gr[i] = *(const u32x4*)(GH + (size_t)(m0 + (ch >> 4)) * 1024 + h * 128 + 8 * (ch & 15)); }
        if (it + G < 4160) PC_LOAD(it + G)
        __syncthreads();
        HGRN_GATES()
        { u16* GS = (u16*)(lds + HL_ZS);
#pragma unroll
          for (int i = 0; i < 2; ++i) { const int ch = tid + 512 * i; *(u32x4*)(GS + (ch >> 4) * 128 + 8 * (ch & 15)) = gr[i]; } }
        float qv[16];
#pragma unroll
        for (int i = 0; i < 16; ++i) qv[i] = bf2f(QG[(16 * seg + i) * 128 + k]);
#pragma unroll
        for (int i = 0; i < 16; ++i) { const float bt = off + bl[i]; KS[(16 * seg + i) * 136 + k] = f2bf(kk[i] * __builtin_amdgcn_exp2f(b31 - bt)); QS[(16 * seg + i) * 136 + k] = f2bf(qv[i] * __builtin_amdgcn_exp2f(bt - b31)); }
#pragma unroll
        for (int i = 0; i < 4; ++i) { const int ch = tid + 512 * i, kr = ch >> 4, vc = ch & 15; const float sc = __builtin_amdgcn_exp2f(TOT[kr] + TOT[128 + kr]);
            const u32x4 sv = sc_[i];
#pragma unroll
            for (int e = 0; e < 8; ++e) { const unsigned wv = sv[e >> 1]; const float f = (e & 1) ? bfhi(wv) : bflo(wv); ST[(8 * vc + e) * 136 + ((((kr >> 3) ^ vc) << 3) | (kr & 7))] = f2bf(f * sc); } }
        __syncthreads();
        bf16x8 qf[4];
#pragma unroll
        for (int ks = 0; ks < 4; ++ks) qf[ks] = *(const bf16x8*)(QS + (16 * tt + l15) * 136 + 32 * ks + 8 * q4);
        f32x4 sc4[4];
#pragma unroll
        for (int st = 0; st < 4; ++st) { f32x4 a = {0.f, 0.f, 0.f, 0.f};
            if (st <= tt) {
#pragma unroll
                for (int ks = 0; ks < 4; ++ks) a = mfma16(*(const bf16x8*)(KS + (16 * st + l15) * 136 + 32 * ks + 8 * q4), qf[ks], a);
                if (st == tt) {
#pragma unroll
                    for (int r = 0; r < 4; ++r) if (4 * q4 + r > l15) a[r] = 0.f;
                }
            }
            sc4[st] = a; }
        f32x4 o[4];
#pragma unroll
        for (int vi = 0; vi < 4; ++vi) { const int vt = 4 * vh + vi; f32x4 a = {0.f, 0.f, 0.f, 0.f};
#pragma unroll
            for (int kp = 0; kp < 2; ++kp) if (2 * kp <= tt) {
                u32x4 pw; pw.x = pkbf(sc4[2 * kp][0], sc4[2 * kp][1]); pw.y = pkbf(sc4[2 * kp][2], sc4[2 * kp][3]); pw.z = pkbf(sc4[2 * kp + 1][0], sc4[2 * kp + 1][1]); pw.w = pkbf(sc4[2 * kp + 1][2], sc4[2 * kp + 1][3]);
                const int vv_ = 16 * vt + l15, vsw = (vv_ >> 3) & 7, vc0 = 4 * kp + (q4 >> 1); const bf16_t* vrow = VT + vv_ * 72 + 4 * (q4 & 1); const u32x2 lo = *(const u32x2*)(vrow + ((vc0 ^ vsw) << 3)), hi = *(const u32x2*)(vrow + (((vc0 + 2) ^ vsw) << 3));
                u32x4 aw; aw.x = lo.x; aw.y = lo.y; aw.z = hi.x; aw.w = hi.y; a = mfma16(__builtin_bit_cast(bf16x8, aw), __builtin_bit_cast(bf16x8, pw), a); }
#pragma unroll
            for (int ks = 0; ks < 4; ++ks) a = mfma16(*(const bf16x8*)(ST + (16 * vt + l15) * 136 + (((4 * ks + q4) ^ (((16 * vt + l15) >> 3) & 15)) << 3)), qf[ks], a);
            o[vi] = a; }
        float sq = 0.f;
#pragma unroll
        for (int vi = 0; vi < 4; ++vi) sq += (o[vi][0] * o[vi][0] + o[vi][1] * o[vi][1]) + (o[vi][2] * o[vi][2] + o[vi][3] * o[vi][3]);
        sq += __shfl_xor(sq, 16); sq += __shfl_xor(sq, 32);
        if (q4 == 0) SSQ[vh * 64 + 16 * tt + l15] = sq;
        __syncthreads();
        const float rn = rsqrtf((SSQ[16 * tt + l15] + SSQ[64 + 16 * tt + l15]) * (1.f / 128.f) + EPS);
        bf16_t* stg = (bf16_t*)(lds + HL_QS) + w * 1152;
#pragma unroll
        for (int vi = 0; vi < 4; ++vi) { const int v0 = 16 * (4 * vh + vi) + 4 * q4; const f32x4 gn = *(const f32x4*)(ONL + v0);
            const u32x2 g2 = *(const u32x2*)((const u16*)(lds + HL_ZS) + (16 * tt + l15) * 128 + v0); u32x2 ow;
            ow.x = pkbf(o[vi][0] * rn * gn[0] * bflo(g2.x), o[vi][1] * rn * gn[1] * bfhi(g2.x)); ow.y = pkbf(o[vi][2] * rn * gn[2] * bflo(g2.y), o[vi][3] * rn * gn[3] * bfhi(g2.y));
            *(u32x2*)(stg + l15 * 72 + 16 * vi + 4 * q4) = ow; }
        asm volatile("s_waitcnt lgkmcnt(0)" ::: "memory");
        if (dost) {
#pragma unroll
            for (int i = 0; i < 2; ++i) { const int row = 8 * i + (lane >> 3), chn = lane & 7; *(u32x4*)(QH + (size_t)(m0 + 16 * tt + row) * 1024 + h * 128 + 64 * vh + 8 * chn) = *(const u32x4*)(stg + row * 72 + 8 * chn); } }
    }
#undef PC_LOAD
}
__device__ __forceinline__ void final_phase(KP pk, int vcu, int G) {
    int tid_ = threadIdx.x; asm volatile("" : "+v"(tid_)); const int tid = tid_, lane = tid & 63, w = tid >> 6; const int gw = vcu * 8 + w, NGW = G * 8;
    float* Y = pk->out + OY; const bf16_t* XB = (const bf16_t*)(pk->ws + WS_XB); const float* ss = (const float*)(pk->ws + WS_SS) + (size_t)(8 % 3) * SS_SLOT; const float* fn = pk->in[16];
    f32x4 g[4];
#pragma unroll
    for (int q = 0; q < 4; ++q) g[q] = *(const f32x4*)(fn + 256 * q + 4 * lane);
    for (int r0 = gw; r0 < MT; r0 += 4 * NGW) {
        u32x2 xv[4][4]; float pv[4];
#pragma unroll
        for (int t = 0; t < 4; ++t) { const int r = r0 + t * NGW < MT ? r0 + t * NGW : r0;
            pv[t] = lane < 16 ? ss[(size_t)r * 16 + lane] : 0.f;
#pragma unroll
            for (int q = 0; q < 4; ++q) xv[t][q] = *(const u32x2*)(XB + (size_t)r * 1024 + 256 * q + 4 * lane); }
#pragma unroll
        for (int t = 0; t < 4; ++t) { const int r = r0 + t * NGW; if (r >= MT) break;
            float s = pv[t];
#pragma unroll
            for (int o = 1; o < 16; o <<= 1) s += __shfl_xor(s, o);
            s = __shfl(s, 0); const float rs = rsqrtf(s * (1.f / 1024.f) + EPS);
#pragma unroll
            for (int q = 0; q < 4; ++q) { f32x4 y; y[0] = bflo(xv[t][q].x) * rs * g[q][0]; y[1] = bfhi(xv[t][q].x) * rs * g[q][1]; y[2] = bflo(xv[t][q].y) * rs * g[q][2]; y[3] = bfhi(xv[t][q].y) * rs * g[q][3];
                *(f32x4*)(Y + (size_t)r * 1024 + 256 * q + 4 * lane) = y; } }
    }
}

#ifndef STAG_MODE
#define STAG_MODE 0
#endif
#ifndef STAG_T
#define STAG_T 26
#endif
__device__ __forceinline__ void stagger(int bx, int usec_total) {
    if (STAG_MODE == 0) return;
    const int grp = STAG_MODE == 1 ? (bx & 7) : ((bx >> 3) & 7);
    const unsigned long long t0 = __builtin_amdgcn_s_memrealtime(); const unsigned long long dt = (unsigned long long)(grp * usec_total * 100 / 8);
    while (__builtin_amdgcn_s_memrealtime() - t0 < dt) __builtin_amdgcn_s_sleep(8);
}

constexpr int LDS_BYTES = 147456;
constexpr int PH_A = 3 + 2 * NHALF, PH_H = 5 + 2 * NHALF, NPHASE = 2 + 2 * (PH_A + PH_H);
#ifndef SKIPMASK
#define SKIPMASK 0
#endif
#ifndef PROBE_KIND
#define PROBE_KIND -1
#endif
#ifndef PROBE_REP
#define PROBE_REP 1
#endif
#ifndef PROBE_NOEPI
#define PROBE_NOEPI 0
#endif
__global__ void __launch_bounds__(512, 2) fwd_kernel(Params p_unused) {
    extern __shared__ __attribute__((aligned(16))) unsigned char lds[];
    cg::grid_group grid = cg::this_grid();
    const int G = gridDim.x, bx = blockIdx.x; const int vcu = (G % 8 == 0) ? (bx % 8) * (G / 8) + bx / 8 : bx;
    volatile LAS unsigned* misc = (volatile LAS unsigned*)((LAS unsigned char*)lds + 131072 + 320);
    if (threadIdx.x < 64) misc[threadIdx.x] = 0u;
    __syncthreads();
    int ph, ph_hi; XcdBarrier bar; { KP k0 = kargs(); ph = k0->ph_lo; ph_hi = k0->ph_hi; bar.bar = (unsigned*)(k0->ws + WS_CTL) + 4096; bar.x = 0u; bar.st = misc + 8; }
    for (; ph < ph_hi; ++ph) {
        int layer = 0, kind, half = 0;
        if (ph == 0) kind = 0; else if (ph == NPHASE - 1) kind = 10;
        else { int q = ph - 1; if (q < PH_A) { layer = 0; } else if (q < PH_A + PH_H) { layer = 1; q -= PH_A; } else if (q < 2 * PH_A + PH_H) { layer = 2; q -= PH_A + PH_H; } else { layer = 3; q -= 2 * PH_A + PH_H; }
            if (layer & 1) { if (q < 4) kind = 6 + q; else if (q == 4) kind = 3; else { kind = 4 + ((q - 5) & 1); half = (q - 5) >> 1; } }
            else { if (q < 3) kind = 1 + q; else { kind = 4 + ((q - 3) & 1); half = (q - 3) >> 1; } } }
        const int j = layer >> 1;
        int nrep = 1; if (kind == PROBE_KIND) nrep = PROBE_REP;
        for (int rep = 0; rep < nrep; ++rep) {
        if (rep) xcd_barrier(bar);
        KP pk = kargs();
        if (kind == 0) { if (!(SKIPMASK & 1)) prologue(pk, (char*)lds, vcu, G); }
        else if (kind == 1 && !(SKIPMASK & 2)) {
            stagger(bx, STAG_T);
            unsigned char* ws = pk->ws; float* out = pk->out; bf16_t* WB = (bf16_t*)(ws + WS_W); float* ssb = (float*)(ws + WS_SS);
            pg8::Gemm g{(bf16_t*)(ws + WS_XB), WB + wmat_off(layer, 0), MT, 1536, 1024}; pg8::StaticOrder S; S.init(MP, 1536, 1024, G, bx); S.split(128, 2, 4);
            EpiQKV E{ws, out, j, (2 * layer) % 3};
            EpiMix<EpiQKV> EM{E, (float*)(ws + WS_SPK), (unsigned*)(ws + WS_CTL + 32768) + ph * 256, 4, 128, 2, (PROBE_NOEPI && rep + 1 < nrep) ? 0u : 0xffu};
            pg8::gemm_phase<EpiMix<EpiQKV>, pg8::StaticOrder, PG_ALIGN, PG_SP2>((PG8_LAS unsigned char*)lds, g, S, EM);
        } else if (kind == 2) { if (!(SKIPMASK & 4)) attn_phase(pk, (char*)lds, j, vcu, G); }
        else if ((kind == 3 || kind == 5) && !(SKIPMASK & 8)) {
            unsigned char* ws = pk->ws; bf16_t* WB = (bf16_t*)(ws + WS_W); float* ssb = (float*)(ws + WS_SS);
            const bool dn = kind == 5; const int K = dn ? 4096 : 1024;
            const bf16_t* A = dn ? (const bf16_t*)(ws + WS_POOL) - (size_t)(half * HROWS) * 4096 : ((layer & 1) ? (const bf16_t*)(ws + WS_POOL) : (const bf16_t*)(ws + WS_POOL + ACT));
            pg8::Gemm g{A, WB + wmat_off(layer, dn ? 3 : 1), MT, 1024, K}; pg8::StaticOrder S;
            if (dn) { S.init(HROWS, 1024, K, G, bx, half * (HROWS / 256)); if (half == NHALF - 1) S.split(128, 2, 8); } else { S.init(MP, 1024, K, G, bx); S.split(128, 2, 4); }
            EpiRes E{(bf16_t*)(ws + WS_XB), ssb + (size_t)((2 * layer + (dn ? 2 : 1)) % 3) * SS_SLOT};
            EpiMix<EpiRes> EM{E, (float*)(ws + WS_SPK), (unsigned*)(ws + WS_CTL + 32768) + ph * 256, dn ? 8 : 4, 128, 2, (PROBE_NOEPI && rep + 1 < nrep) ? 0u : 0xffu};
            pg8::gemm_phase<EpiMix<EpiRes>, pg8::StaticOrder, PG_ALIGN, PG_SP2>((PG8_LAS unsigned char*)lds, g, S, EM);
        } else if (kind == 4 && !(SKIPMASK & 16)) {
            unsigned char* ws = pk->ws; bf16_t* WB = (bf16_t*)(ws + WS_W); float* ssb = (float*)(ws + WS_SS);
            pg8::Gemm g{(bf16_t*)(ws + WS_XB), WB + wmat_off(layer, 2), MT, 4096, 1024}; pg8::StaticOrder S; S.init(HROWS, 4096, 1024, G, bx, half * (HROWS / 256)); if (half == NHALF - 1) S.split(128, 2, 4);
            EpiUp E{ssb + (size_t)((2 * layer + 1) % 3) * SS_SLOT, (bf16_t*)(ws + WS_POOL) - (size_t)(half * HROWS) * 4096, (PROBE_NOEPI == 2 && rep + 1 < nrep) ? 255 : (PROBE_NOEPI == 3 && rep + 1 < nrep) ? 0x7ffffffe : 0x7fffffff};
            EpiMix<EpiUp> EM{E, (float*)(ws + WS_SPK), (unsigned*)(ws + WS_CTL + 32768) + ph * 256, 4, 128, 2, 0xffu};
            pg8::gemm_phase<EpiMix<EpiUp>, pg8::StaticOrder, PG_ALIGN, PG_SP2>((PG8_LAS unsigned char*)lds, g, S, EM);
        } else if (kind == 6 && !(SKIPMASK & 32)) {
            stagger(bx, STAG_T);
            unsigned char* ws = pk->ws; bf16_t* WB = (bf16_t*)(ws + WS_W); float* ssb = (float*)(ws + WS_SS);
            pg8::Gemm g{(bf16_t*)(ws + WS_XB), WB + wmat_off(layer, 0), MT, 4096, 1024}; pg8::StaticOrder S; S.init(MP, 4096, 1024, G, bx); S.split(128, 2, 4);
            EpiHin E{ssb + (size_t)((2 * layer) % 3) * SS_SLOT, (u16*)(ws + WS_POOL)};
            EpiMix<EpiHin> EM{E, (float*)(ws + WS_SPK), (unsigned*)(ws + WS_CTL + 32768) + ph * 256, 4, 128, 2, (PROBE_NOEPI && rep + 1 < nrep) ? 0u : 0xffu};
            pg8::gemm_phase<EpiMix<EpiHin>, pg8::StaticOrder, PG_ALIGN, PG_SP2>((PG8_LAS unsigned char*)lds, g, S, EM);
        } else if (kind == 7) { if (!(SKIPMASK & 64)) hgrn_passA(pk, (char*)lds, j, vcu, G, !(PROBE_NOEPI && rep + 1 < nrep)); }
        else if (kind == 8) { if (!(SKIPMASK & 128)) hgrn_passB(pk, j, G, !(PROBE_NOEPI && rep + 1 < nrep)); }
        else if (kind == 9) { if (!(SKIPMASK & 256)) hgrn_passC(pk, (char*)lds, j, vcu, G, !(PROBE_NOEPI && rep + 1 < nrep)); }
        else if (kind == 10) { if (!(SKIPMASK & 512)) final_phase(pk, vcu, G); }
        }
        if (PROBE_KIND == 99 && ph == 3) for (int e = 0; e < PROBE_REP; ++e) xcd_barrier(bar);
        if (ph + 1 < ph_hi) { if (ph == 0) { grid.sync(); KP k1 = kargs(); bar = xcd_barrier_post((unsigned*)(k1->ws + WS_CTL) + 4096, misc + 8); } else xcd_barrier(bar); }
    }
}

#ifndef MK_PER_PHASE
#define MK_PER_PHASE 0
#endif
extern "C" void kernel_launch(void* const* d_in, const int* in_sizes, int n_in, void* d_out, int out_size, void* d_ws, size_t ws_size, hipStream_t stream) {
    static int grid = 0;
    if (grid == 0) {
        int dev = 0, cus = 0, per_cu = 0;
        hipGetDevice(&dev); hipDeviceGetAttribute(&cus, hipDeviceAttributeMultiprocessorCount, dev);
        hipFuncSetAttribute((const void*)fwd_kernel, hipFuncAttributeMaxDynamicSharedMemorySize, LDS_BYTES);
        hipOccupancyMaxActiveBlocksPerMultiprocessor(&per_cu, (const void*)fwd_kernel, 512, LDS_BYTES);
        (void)hipGetLastError();
        if (per_cu < 1) { fprintf(stderr, "kernel_launch: occupancy query says %d blocks/CU\n", per_cu); per_cu = 1; }
        grid = cus;
        if (n_in != 17 || ws_size < WS_SS + 3 * SS_SLOT * 4) { fprintf(stderr, "kernel_launch: unexpected n_in %d / ws_size %zu (need %zu)\n", n_in, ws_size, (size_t)WS_END); }
    }
    Params p{};
    for (int i = 0; i < 17; ++i) p.in[i] = (const float*)d_in[i];
    p.out = (float*)d_out; p.ws = (unsigned char*)d_ws;
#if MK_PER_PHASE
    for (int ph = 0; ph < NPHASE; ++ph) { p.ph_lo = ph; p.ph_hi = ph + 1; hipLaunchKernelGGL(fwd_kernel, dim3(grid), dim3(512), LDS_BYTES, stream, p); }
#else
    p.ph_lo = 0; p.ph_hi = NPHASE;
    void* args[] = {&p};
    hipError_t e = hipLaunchCooperativeKernel((const void*)fwd_kernel, dim3(grid), dim3(512), args, LDS_BYTES, stream);
    if (e != hipSuccess) fprintf(stderr, "cooperative launch failed: %s (grid %d)\n", hipGetErrorString(e), grid);
#endif
}
```

```cpp
#include <hip/hip_runtime.h>
#include <hip/hip_cooperative_groups.h>
#include <cstdio>
#include <cstdint>
namespace cg = cooperative_groups;
#ifndef PG_WGM
#define PG_WGM 8
#endif
#ifndef PG_ALIGN
#define PG_ALIGN true
#endif
#ifndef PG_SP2
#define PG_SP2 true
#endif
namespace pg8 {
#define PG8_LAS __attribute__((address_space(3)))
typedef unsigned short bf16_t;
typedef short bf16x8 __attribute__((ext_vector_type(8)));
typedef float f32x4 __attribute__((ext_vector_type(4)));
typedef unsigned u32x4 __attribute__((ext_vector_type(4)));
constexpr int BM = 256, BK = 64, HALF = 128, HTB = HALF * BK * 2  , STAGE_BYTES = 8 * HTB, NXCD = 8, WGM = PG_WGM;

__host__ __device__ __forceinline__ int lds_byte(int r, int c) { const int st = (r >> 4) * 2 + (c >> 5), rr = r & 15, cc = c & 31, ob = rr * 64 + cc * 2; return st * 1024 + (ob ^ (((ob >> 9) & 1) << 5)); }
__host__ __device__ __forceinline__ void stage_rc(int b, int& R, int& C) { const int st = b / 1024, sb = b % 1024, swz = sb ^ (((sb >> 9) & 1) << 5); R = (st >> 1) * 16 + swz / 64; C = (st & 1) * 32 + (swz % 64) / 2; }
__host__ __device__ __forceinline__ int perm32(int rho) { const int n = rho >> 4, i = rho & 15; return 8 * (i >> 2) + 4 * n + (i & 3); }

struct Unit { int pm, pn, k0, nt, sp; };
struct Gemm { const bf16_t* A; const bf16_t* Bt; int M, N, K; };

struct StaticOrder {
    int nM, nN, nwg, G, c, ntK, pm0;
    int sM0, sNM, sS, sKs, nsp;
    __host__ __device__ void init(int M, int N, int K, int G_, int c_, int pm0_ = 0) { pm0 = pm0_; nM = M / BM; nN = N / BM; nwg = nM * nN; G = G_; c = c_; ntK = K / BK; sM0 = 0; sNM = 0; sS = 1; sKs = K; nsp = 0; }
    __host__ __device__ void split(int m0, int nm, int S) { sM0 = m0; sNM = nm; sS = S; sKs = (ntK / S) * BK; nsp = nm * nN * S; }
    __host__ __device__ bool next(int i, Unit& u) const {
        const long L = (long)i * G + c;
        if (L >= nwg) { const long L2 = L - (long)((nwg + G - 1) / G) * G; if (L2 < 0 || L2 >= nsp) return false;
            const int ks = (int)(L2 % sS), un = (int)(L2 / sS); u.pm = sM0 + un % sNM; u.pn = un / sNM; u.k0 = ks * sKs; u.nt = sKs / BK; u.sp = ks; return true; }
        int wgid = (int)L; { const int q = nwg / NXCD, r = nwg % NXCD, xcd = wgid % NXCD, off = wgid / NXCD; wgid = (xcd < r ? xcd * (q + 1) : r * (q + 1) + (xcd - r) * q) + off; }
        const int nig = WGM * nN, gid = wgid / nig, fm = gid * WGM, wi = wgid - gid * nig;
        if (nM % WGM == 0) { u.pm = pm0 + fm + (wi & (WGM - 1)); u.pn = wi / WGM; }
        else { const int gsz = (nM - fm) < WGM ? (nM - fm) : WGM; u.pm = pm0 + fm + (wi % gsz); u.pn = wi / gsz; }
        u.k0 = 0; u.nt = ntK; u.sp = -1; return true;
    }
    __device__ __forceinline__ void a_ready(const Unit&) const {}
    __device__ __forceinline__ void done(const Unit&) const {}
};

__device__ __forceinline__ unsigned cvt_pk_bf16(float lo, float hi) { unsigned r; asm volatile("v_cvt_pk_bf16_f32 %0, %1, %2" : "=v"(r) : "v"(lo), "v"(hi)); return r; }
typedef float f32x2 __attribute__((ext_vector_type(2)));
template <class Epi, class Sched, bool ALIGN_EPI = false, bool SP2 = false>
__device__ __forceinline__ void gemm_phase(PG8_LAS unsigned char* lds, const Gemm g, const Sched& S, const Epi& E) {
    int tid_ = threadIdx.x; asm volatile("" : "+v"(tid_)); const int tid = tid_, wid = __builtin_amdgcn_readfirstlane(tid >> 6), lane = tid & 63, wr = wid >> 2, wc = wid & 3, fr = lane & 15, fq = lane >> 4;
    const int K = g.K;
    unsigned voffA[2], voffB[2];
#pragma unroll
    for (int i = 0; i < 2; ++i) { int R, C; stage_rc(tid * 16 + i * 8192, R, C); const int Rb = Epi::PERM ? ((R & ~31) + perm32(R & 31)) : R;
        voffA[i] = (unsigned)(R * K + C) * 2u; voffB[i] = (unsigned)(Rb * K + C) * 2u; }
    const size_t kstep = (size_t)(BK * 2);
    const size_t hstep = (size_t)HALF * K * 2;
    const size_t tstep = 2 * hstep;
    const unsigned ldsw = (unsigned)wid * 1024u;
    const int aoff = lds_byte(wr * 64 + fr, fq * 8), boff = lds_byte(wc * 32 + fr, fq * 8);
#define PG8_SA(b, h) (((b) * 2 + (h)) * HTB)
#define PG8_SB(b, h) ((4 + (b) * 2 + (h)) * HTB)
#define PG8_STAGE(bufoff, gbase, voff) do { _Pragma("unroll") for (int _i = 0; _i < 2; ++_i) \
        __builtin_amdgcn_global_load_lds((const unsigned*)((const char*)(gbase) + (voff)[_i]), (PG8_LAS unsigned*)(lds + (bufoff) + ldsw + _i * 8192), 16, 0, 0); } while (0)
#define PG8_LDA(dst, b, h) do { _Pragma("unroll") for (int m = 0; m < 4; ++m) _Pragma("unroll") for (int k = 0; k < 2; ++k) dst[m][k] = *(const PG8_LAS bf16x8*)(lds + PG8_SA(b, h) + aoff + m * 2048 + k * 1024); } while (0)
#define PG8_LDB(dst, b, h) do { _Pragma("unroll") for (int n = 0; n < 2; ++n) _Pragma("unroll") for (int k = 0; k < 2; ++k) dst[n][k] = *(const PG8_LAS bf16x8*)(lds + PG8_SB(b, h) + boff + n * 2048 + k * 1024); } while (0)
#define PG8_MMA(ai, bj, At, Bt) do { __builtin_amdgcn_s_setprio(1); _Pragma("unroll") for (int m = 0; m < 4; ++m) _Pragma("unroll") for (int n = 0; n < 2; ++n) _Pragma("unroll") for (int k = 0; k < 2; ++k) \
        acc[ai][bj][m][n] = __builtin_amdgcn_mfma_f32_16x16x32_bf16(Bt[n][k], At[m][k], acc[ai][bj][m][n], 0, 0, 0); __builtin_amdgcn_s_setprio(0); } while (0)
#define PG8_WAIT_V(n) asm volatile("s_waitcnt vmcnt(" #n ")" ::: "memory")
#define PG8_WAIT_L(n) asm volatile("s_waitcnt lgkmcnt(" #n ")" ::: "memory")
#define PG8_BAR __builtin_amdgcn_s_barrier()
#define PG8_SCHED __builtin_amdgcn_sched_barrier(0)
    Unit cur, nxt; int ui = 0;
    if (!S.next(0, cur)) return;
    f32x4 acc[2][2][4][2];
#pragma unroll
    for (int a = 0; a < 2; ++a)
#pragma unroll
        for (int b = 0; b < 2; ++b)
#pragma unroll
            for (int m = 0; m < 4; ++m)
#pragma unroll
                for (int n = 0; n < 2; ++n) acc[a][b][m][n] = (f32x4){0.f, 0.f, 0.f, 0.f};
    bf16x8 At[4][2], B0[2][2], B1[2][2];
    const char* cA = (const char*)g.A + (size_t)cur.pm * tstep + (size_t)cur.k0 * 2; const char* cB = (const char*)g.Bt + (size_t)cur.pn * tstep + (size_t)cur.k0 * 2;
    S.a_ready(cur);
    if constexpr (SP2) {
        PG8_STAGE(PG8_SB(0, 0), cB, voffB); PG8_STAGE(PG8_SB(0, 1), cB + hstep, voffB); PG8_STAGE(PG8_SA(0, 0), cA, voffA); PG8_STAGE(PG8_SA(0, 1), cA + hstep, voffA);
        if (wr == 1) PG8_BAR;
        PG8_WAIT_V(2); PG8_BAR;
        PG8_STAGE(PG8_SB(1, 0), cB + kstep, voffB); PG8_STAGE(PG8_SA(1, 0), cA + kstep, voffA); PG8_STAGE(PG8_SB(1, 1), cB + hstep + kstep, voffB);
        PG8_WAIT_V(6); PG8_BAR;
    } else {
        PG8_STAGE(PG8_SB(0, 0), cB, voffB); PG8_STAGE(PG8_SA(0, 0), cA, voffA); PG8_STAGE(PG8_SB(0, 1), cB + hstep, voffB); PG8_STAGE(PG8_SA(0, 1), cA + hstep, voffA);
        if (wr == 1) PG8_BAR;
        PG8_WAIT_V(4); PG8_BAR;
        PG8_STAGE(PG8_SB(1, 0), cB + kstep, voffB); PG8_STAGE(PG8_SA(1, 0), cA + kstep, voffA); PG8_STAGE(PG8_SB(1, 1), cB + hstep + kstep, voffB);
        PG8_WAIT_V(6); PG8_BAR;
    }
    for (;;) {
        const bool has_next = S.next(ui + 1, nxt);
        const char* nA = has_next ? (const char*)g.A + (size_t)nxt.pm * tstep + (size_t)nxt.k0 * 2 : cA; const char* nB = has_next ? (const char*)g.Bt + (size_t)nxt.pn * tstep + (size_t)nxt.k0 * 2 : cB;
        const int nt = cur.nt;
        for (int t = 0; t < nt; t += 2) {
            const bool last = (t == nt - 2);
            const char* a1 = cA + (size_t)(t + 1) * kstep;
            const char* a2 = last ? nA : cA + (size_t)(t + 2) * kstep; const char* b2 = last ? nB : cB + (size_t)(t + 2) * kstep;
            const char* a3 = a2 + kstep; const char* b3 = b2 + kstep;
            if (last && has_next) S.a_ready(nxt);
            if constexpr (SP2) {
            PG8_LDB(B0, 0, 0); PG8_LDB(B1, 0, 1); PG8_SCHED; PG8_LDA(At, 0, 0); PG8_STAGE(PG8_SA(1, 1), a1 + hstep, voffA);
            PG8_WAIT_V(8); PG8_WAIT_L(0); PG8_BAR; PG8_MMA(0, 0, At, B0); PG8_MMA(0, 1, At, B1); PG8_BAR; PG8_SCHED;
            PG8_LDA(At, 0, 1); PG8_STAGE(PG8_SB(0, 0), b2, voffB); PG8_STAGE(PG8_SB(0, 1), b2 + hstep, voffB); PG8_STAGE(PG8_SA(0, 0), a2, voffA);
            PG8_WAIT_V(8); PG8_WAIT_L(0); PG8_BAR; PG8_MMA(1, 0, At, B0); PG8_MMA(1, 1, At, B1); PG8_BAR; PG8_SCHED;
            PG8_LDB(B0, 1, 0); PG8_LDB(B1, 1, 1); PG8_SCHED; PG8_LDA(At, 1, 0); PG8_STAGE(PG8_SA(0, 1), a2 + hstep, voffA);
            PG8_WAIT_V(8); PG8_WAIT_L(0); PG8_BAR; PG8_MMA(0, 0, At, B0); PG8_MMA(0, 1, At, B1); PG8_BAR; PG8_SCHED;
            PG8_LDA(At, 1, 1); PG8_STAGE(PG8_SB(1, 0), b3, voffB); PG8_STAGE(PG8_SB(1, 1), b3 + hstep, voffB); PG8_STAGE(PG8_SA(1, 0), a3, voffA);
            PG8_WAIT_V(8); PG8_WAIT_L(0); PG8_BAR; PG8_MMA(1, 0, At, B0); PG8_MMA(1, 1, At, B1); PG8_BAR; PG8_SCHED;
            } else {
            PG8_LDB(B0, 0, 0); PG8_SCHED; PG8_LDA(At, 0, 0); PG8_STAGE(PG8_SA(1, 1), a1 + hstep, voffA);
            PG8_WAIT_L(8); PG8_BAR; PG8_WAIT_L(0); PG8_MMA(0, 0, At, B0); PG8_BAR; PG8_SCHED;
            PG8_LDB(B1, 0, 1); PG8_STAGE(PG8_SB(0, 0), b2, voffB);
            PG8_BAR; PG8_WAIT_L(0); PG8_MMA(0, 1, At, B1); PG8_BAR;
            PG8_LDA(At, 0, 1); PG8_STAGE(PG8_SA(0, 0), a2, voffA);
            PG8_BAR; PG8_WAIT_L(0); PG8_MMA(1, 0, At, B0); PG8_BAR; PG8_SCHED;
            PG8_STAGE(PG8_SB(0, 1), b2 + hstep, voffB);
            PG8_WAIT_V(6); PG8_BAR; PG8_MMA(1, 1, At, B1); PG8_BAR;
            PG8_LDB(B0, 1, 0); PG8_SCHED; PG8_LDA(At, 1, 0); PG8_STAGE(PG8_SA(0, 1), a2 + hstep, voffA);
            PG8_WAIT_L(8); PG8_BAR; PG8_WAIT_L(0); PG8_MMA(0, 0, At, B0); PG8_BAR; PG8_SCHED;
            PG8_LDB(B1, 1, 1); PG8_STAGE(PG8_SB(1, 0), b3, voffB);
            PG8_BAR; PG8_WAIT_L(0); PG8_MMA(0, 1, At, B1); PG8_BAR;
            PG8_LDA(At, 1, 1); PG8_STAGE(PG8_SA(1, 0), a3, voffA);
            PG8_BAR; PG8_WAIT_L(0); PG8_MMA(1, 0, At, B0); PG8_BAR; PG8_SCHED;
            PG8_STAGE(PG8_SB(1, 1), b3 + hstep, voffB);
            PG8_WAIT_V(6); PG8_BAR; PG8_MMA(1, 1, At, B1); PG8_BAR;
            }
        }
        if constexpr (ALIGN_EPI) { if (wr == 0) PG8_BAR; }
        if constexpr (!Epi::AFTER_DRAIN) { E(acc, cur, wr, wc, fr, fq); S.done(cur); }
        if (!has_next) break;
#pragma unroll
        for (int a = 0; a < 2; ++a)
#pragma unroll
            for (int b = 0; b < 2; ++b)
#pragma unroll
                for (int m = 0; m < 4; ++m)
#pragma unroll
                    for (int n = 0; n < 2; ++n) acc[a][b][m][n] = (f32x4){0.f, 0.f, 0.f, 0.f};
        cur = nxt; cA = nA; cB = nB; ++ui;
        if constexpr (ALIGN_EPI) { if (wr == 1) PG8_BAR; }
    }
    PG8_WAIT_V(0);
    if constexpr (!ALIGN_EPI) { if (wr == 0) PG8_BAR; }
    PG8_BAR;
    if constexpr (Epi::AFTER_DRAIN) { E.fused(acc, cur, wr, wc, fr, fq, lds, wid, lane); S.done(cur); }
#undef PG8_SA
#undef PG8_SB
#undef PG8_STAGE
#undef PG8_LDA
#undef PG8_LDB
#undef PG8_MMA
#undef PG8_WAIT_V
#undef PG8_WAIT_L
#undef PG8_BAR
#undef PG8_SCHED
}
}
#define LAS __attribute__((address_space(3)))
#define XB_TMO      128
#define XB_XCNT(j)  (256  + 64 * (j))
#define XB_XSUB(j)  (1280 + 64 * (j))
#define XB_XGEN(j)  (2304 + 64 * (j))
#define XB_TOP      3328
#define XB_TOPGEN   3392
#define XCD_BAR_WORDS 3456
#define XB_SPIN_CAP (1u << 18)

__device__ __forceinline__ unsigned xb_ld(unsigned* p)              { return __hip_atomic_load(p, __ATOMIC_RELAXED, __HIP_MEMORY_SCOPE_AGENT); }
__device__ __forceinline__ unsigned xb_add(unsigned* p, unsigned v) { return __hip_atomic_fetch_add(p, v, __ATOMIC_RELAXED, __HIP_MEMORY_SCOPE_AGENT); }
__device__ __forceinline__ unsigned xb_xcc_id() { return (unsigned)__builtin_amdgcn_s_getreg((3 << 11) | 20) & 0xFu; }
#define XB_SPIN(cond, bar) do { unsigned _sp = 0; while (cond) { __builtin_amdgcn_s_sleep(1); \
    if ((++_sp & 255u) == 0u) { if (xb_ld(&(bar)[XB_TMO])) break; if (_sp > XB_SPIN_CAP) { atomicAdd(&(bar)[XB_TMO], 1u); break; } } } } while (0)

struct XcdBarrier {
    unsigned* bar; unsigned x;
    volatile LAS unsigned* st;
};

__device__ __forceinline__ XcdBarrier xcd_barrier_post(unsigned* bar, volatile LAS unsigned* st) {
    XcdBarrier b; b.bar = bar; b.x = xb_xcc_id(); b.st = st;
    if (threadIdx.x == 0) (void)xb_add(&bar[XB_XCNT(b.x)], 1u);
    return b;
}
__device__ __forceinline__ void xcd_barrier_complete(unsigned* bar, unsigned x, unsigned& nloc, unsigned& nx) {
    const unsigned G = gridDim.x * gridDim.y * gridDim.z;
    unsigned sum, cnt, mine, sp = 0u;
    for (;;) {
        sum = 0u; cnt = 0u; mine = 0u;
#pragma unroll
        for (unsigned j = 0; j < 16; ++j) { const unsigned c = xb_ld(&bar[XB_XCNT(j)]); sum += c; cnt += (c > 0u) ? 1u : 0u; mine = (j == x) ? c : mine; }
        if (sum == G) break;
        __builtin_amdgcn_s_sleep(1);
        if ((++sp & 255u) == 0u) { if (xb_ld(&bar[XB_TMO])) break; if (sp > XB_SPIN_CAP) { atomicAdd(&bar[XB_TMO], 1u); break; } }
    }
    nloc = mine > 0u ? mine : 1u; nx = cnt > 0u ? cnt : 1u;
}

__device__ __forceinline__ void xcd_barrier(const XcdBarrier& b) {
    asm volatile("s_waitcnt vmcnt(0)" ::: "memory");
    __syncthreads();
    if (threadIdx.x == 0) {
        unsigned* bar = b.bar;
        __builtin_amdgcn_s_waitcnt(0);
        unsigned nloc = b.st[0], nx = b.st[1];
        if (nloc == 0u) { xcd_barrier_complete(bar, b.x, nloc, nx); b.st[0] = nloc; b.st[1] = nx; }
        const unsigned old = xb_add(&bar[XB_XSUB(b.x)], 1u);
        const unsigned gen = old / nloc;
        if (old + 1u == (gen + 1u) * nloc) {
            __builtin_amdgcn_fence(__ATOMIC_RELEASE, "agent");
            asm volatile("s_waitcnt vmcnt(0)" ::: "memory");
            const unsigned og = xb_add(&bar[XB_TOP], 1u);
            const unsigned tg = og / nx;
            if (og + 1u == (tg + 1u) * nx) xb_add(&bar[XB_TOPGEN], 1u);
            else XB_SPIN(xb_ld(&bar[XB_TOPGEN]) == tg, bar);
            __builtin_amdgcn_fence(__ATOMIC_ACQUIRE, "agent");
            xb_add(&bar[XB_XGEN(b.x)], 1u);
            asm volatile("s_waitcnt vmcnt(0)" ::: "memory");
        } else {
            XB_SPIN(xb_ld(&bar[XB_XGEN(b.x)]) == gen, bar);
            __builtin_amdgcn_fence(__ATOMIC_ACQUIRE, "agent");
            asm volatile("s_waitcnt vmcnt(0)" ::: "memory");
        }
    }
    __syncthreads();
}

using pg8::bf16_t; using pg8::bf16x8; using pg8::f32x4; using pg8::u32x4; using pg8::Unit;
typedef unsigned u32x2 __attribute__((ext_vector_type(2)));
typedef unsigned short u16;
constexpr int MP_ROWS = 32768;
constexpr int DM = 1024, MP = 32768, MS = 512, MT = MP + MS, SEQ = 8192;
constexpr float EPS = 1e-5f, LOG2E = 1.4426950408889634f, C2 = 0.125f * 1.4426950408889634f;
constexpr size_t MiB = 1u << 20;
constexpr size_t WS_SS = 492 * MiB, SS_SLOT = (size_t)MT * 16;
constexpr size_t WS_CTL = 0, CTL_BYTES = 131072;
constexpr size_t WS_SPK = 166 * MiB;
constexpr size_t WS_ROPE = 2 * MiB;
constexpr size_t WS_DB = 3 * MiB;
constexpr size_t WS_W = 6 * MiB;
constexpr size_t WS_XB = 100 * MiB;
constexpr size_t WS_POOL = 232 * MiB;
constexpr size_t ACT = (size_t)MT * DM * 2;
constexpr size_t WS_END = WS_POOL + 4 * ACT;
constexpr size_t OY = 0, OKP = 34078720, OVP = 34340864, OSP = 34603008, OKS = 35651584, OVS = 36175872, OSS = 36700160;
constexpr size_t WM = 1048576;
#ifndef NHALF
#define NHALF 1
#endif
constexpr int HROWS = MP_ROWS / NHALF;
struct Params { const float* in[17]; float* out; unsigned char* ws; int ph_lo, ph_hi; };
typedef const __attribute__((address_space(4))) Params* KP;
__device__ __forceinline__ KP kargs() { KP k = (KP)__builtin_amdgcn_kernarg_segment_ptr(); asm volatile("" : "+s"(k)); return k; }

__device__ __forceinline__ unsigned pkbf(float lo, float hi) { typedef float f2 __attribute__((ext_vector_type(2))); typedef __bf16 b2 __attribute__((ext_vector_type(2))); f2 v = {lo, hi}; b2 b = __builtin_convertvector(v, b2); return __builtin_bit_cast(unsigned, b); }
__device__ __forceinline__ float bflo(unsigned u) { return __uint_as_float(u << 16); }
__device__ __forceinline__ float bfhi(unsigned u) { return __uint_as_float(u & 0xffff0000u); }
__device__ __forceinline__ float bf2f(u16 u) { return __uint_as_float((unsigned)u << 16); }
__device__ __forceinline__ u16 f2bf(float f) { return (u16)(pkbf(f, 0.f) & 0xffffu); }
__device__ __forceinline__ unsigned pkh(float lo, float hi) { _Float16 a = (_Float16)lo, b = (_Float16)hi; return (unsigned)__builtin_bit_cast(u16, a) | ((unsigned)__builtin_bit_cast(u16, b) << 16); }
__device__ __forceinline__ f32x4 mfma16(bf16x8 a, bf16x8 b, f32x4 c) { return __builtin_amdgcn_mfma_f32_16x16x32_bf16(a, b, c, 0, 0, 0); }
__device__ __forceinline__ int row_pos(int r) { return r < MP ? (r & (SEQ - 1)) : 2048 + ((r - MP) & 63); }
__device__ __forceinline__ float row_rs(const float* ss, int r) { const f32x4* q = (const f32x4*)(ss + (size_t)r * 16); f32x4 a = q[0], b = q[1], c = q[2], d = q[3]; a = (a + b) + (c + d); return rsqrtf(((a[0] + a[1]) + (a[2] + a[3])) * (1.f / 1024.f) + EPS); }
__device__ __forceinline__ float silu(float v) { return v * __builtin_amdgcn_rcpf(1.f + __builtin_amdgcn_exp2f(-1.4426950408889634f * v)); }

#ifndef COLPERM
#define COLPERM 1
#endif
#ifndef NT_STORE
#define NT_STORE 0
#endif
#if NT_STORE == 2
__device__ __forceinline__ void st16_wt(void* p, u32x4 v) { asm volatile("global_store_dwordx4 %0, %1, off sc0 sc1" :: "v"(p), "v"(v) : "memory"); }
#define ST16(p, v) st16_wt((void*)(p), (v))
#define ST8(p, v) (*(u32x2*)(p) = (v))
#define STF4(p, v) (*(f32x4*)(p) = (v))
#elif NT_STORE
#define ST16(p, v) __builtin_nontemporal_store((v), (u32x4*)(p))
#define ST8(p, v) __builtin_nontemporal_store((v), (u32x2*)(p))
#define STF4(p, v) __builtin_nontemporal_store((v), (f32x4*)(p))
#else
#define ST16(p, v) (*(u32x4*)(p) = (v))
#define ST8(p, v) (*(u32x2*)(p) = (v))
#define STF4(p, v) (*(f32x4*)(p) = (v))
#endif
#define EPI_ROW(idx) (u.pm * 256 + ((idx) >> 2) * 128 + wr * 64 + ((idx) & 3) * 16 + fr)
#define EPI_LOAD_RS(rsv, ss) float rsv[8]; { f32x4 pv_[8]; \
    _Pragma("unroll") for (int idx = 0; idx < 8; ++idx) pv_[idx] = *(const f32x4*)((ss) + (size_t)EPI_ROW(idx) * 16 + fq * 4); \
    _Pragma("unroll") for (int idx = 0; idx < 8; ++idx) { float s_ = (pv_[idx][0] + pv_[idx][1]) + (pv_[idx][2] + pv_[idx][3]); s_ += __shfl_xor(s_, 16); s_ += __shfl_xor(s_, 32); rsv[idx] = rsqrtf(s_ * (1.f / 1024.f) + EPS); } }
struct EpiQKV {
    static constexpr bool PERM = true, AFTER_DRAIN = false;
    unsigned char* ws; float* out; int j, slot;
    __device__ __forceinline__ void operator()(const f32x4 (&acc)[2][2][4][2], const Unit& u, int wr, int wc, int fr, int fq, unsigned mask) const {
        const float* ss = (const float*)(ws + WS_SS) + (size_t)slot * SS_SLOT; const float* rope = (const float*)(ws + WS_ROPE);
        const int pn = u.pn; const bool rot = (pn <= 4) && ((wc & 1) == 0); const float qs = pn < 4 ? C2 : 1.f; const bool rl_ = rot && fq < 2;
        EPI_LOAD_RS(rsv, ss)
        const f32x4 one4 = {1.f, 1.f, 1.f, 1.f}, zero4 = {0.f, 0.f, 0.f, 0.f};
        f32x4 c0 = one4, c1 = one4, s0 = zero4, s1 = zero4, dc0 = one4, dc1 = one4, ds0 = zero4, ds1 = zero4;
        if (rl_) { const float* t = rope + row_pos(EPI_ROW(0)) * 16; c0 = *(const f32x4*)t; c1 = *(const f32x4*)(t + 4); s0 = *(const f32x4*)(t + 8); s1 = *(const f32x4*)(t + 12);
            const float* d = rope + 16 * 16; dc0 = *(const f32x4*)d; dc1 = *(const f32x4*)(d + 4); ds0 = *(const f32x4*)(d + 8); ds1 = *(const f32x4*)(d + 12); }
        const float sgn = fq == 0 ? -1.f : 1.f;
#pragma unroll
        for (int idx = 0; idx < 8; ++idx) {
            const int ai = idx >> 2, m = idx & 3;
            if (idx > 0) {
                const bool back = (idx == 4) && (u.pm >= 128);
                const float dsg = back ? -1.f : 1.f;
#pragma unroll 1
                for (int st_ = (idx == 4 ? (back ? 3 : 5) : 1); st_ > 0; --st_) { const f32x4 e0 = ds0 * dsg, e1 = ds1 * dsg; const f32x4 a0 = c0 * dc0 - s0 * e0, b0 = s0 * dc0 + c0 * e0, a1 = c1 * dc1 - s1 * e1, b1 = s1 * dc1 + c1 * e1; c0 = a0; s0 = b0; c1 = a1; s1 = b1; }
            }
            if (!((mask >> idx) & 1u)) continue;
            int rl = ai * 128 + wr * 64 + m * 16 + fr; asm volatile("" : "+v"(rl)); const int r = u.pm * 256 + rl;
            const float rs = rsv[idx];
            const f32x4 sn0 = s0 * sgn, sn1 = s1 * sgn;
            float* nk = nullptr;
            if (pn >= 4) {
                if (u.pm < 128) { const int t = (u.pm & 31) * 256 + rl; if (t >= 8064) nk = out + (pn == 4 ? OKP : OVP) + ((size_t)((j * 4 + (u.pm >> 5)) * 128 + (t - 8064))) * 256; }
                else { const int rr = r - MP; nk = out + (pn == 4 ? OKS : OVS) + ((size_t)((j * 8 + (rr >> 6)) * 128 + 64 + (rr & 63))) * 256; }
            }
#pragma unroll
            for (int bj = 0; bj < 2; ++bj) {
                f32x4 v0 = acc[ai][bj][m][0] * rs, v1 = acc[ai][bj][m][1] * rs;
                if (rot) {
                    f32x4 p0, p1;
#pragma unroll
                    for (int e = 0; e < 4; ++e) { p0[e] = __shfl_xor(v0[e], 16); p1[e] = __shfl_xor(v1[e], 16); }
                    v0 = v0 * c0 + p0 * sn0; v1 = v1 * c1 + p1 * sn1;
                }
                v0 = v0 * qs; v1 = v1 * qs;
                const int cw = bj * 128 + wc * 32 + 8 * fq;
                bf16_t* dst = pn < 4 ? (bf16_t*)(ws + WS_POOL) + (size_t)r * 1024 + pn * 256 + cw : (bf16_t*)(ws + WS_POOL + 2 * ACT) + (pn == 4 ? (size_t)0 : (size_t)MT * 256) + (size_t)r * 256 + cw;
                u32x4 w; w.x = pkbf(v0[0], v0[1]); w.y = pkbf(v0[2], v0[3]); w.z = pkbf(v1[0], v1[1]); w.w = pkbf(v1[2], v1[3]);
                ST16(dst, w);
                if (nk) { *(f32x4*)(nk + cw) = v0; *(f32x4*)(nk + cw + 4) = v1; }
            }
        }
    }
};
struct EpiRes {
    static constexpr bool PERM = true, AFTER_DRAIN = false;
    bf16_t* XB; float* ssn;
    __device__ __forceinline__ void operator()(const f32x4 (&acc)[2][2][4][2], const Unit& u, int wr, int wc, int fr, int fq, unsigned mask) const {
        const int col0 = u.pn * 256 + wc * 32 + 8 * fq;
        u32x4 xin[8][2];
#pragma unroll
        for (int idx = 0; idx < 8; ++idx) { const bf16_t* xp = XB + (size_t)EPI_ROW(idx) * 1024 + col0; xin[idx][0] = *(const u32x4*)xp; xin[idx][1] = *(const u32x4*)(xp + 128); }
#pragma unroll
        for (int idx = 0; idx < 8; ++idx) {
            const int ai = idx >> 2, m = idx & 3;
            if (!((mask >> idx) & 1u)) continue;
            int r = EPI_ROW(idx); asm volatile("" : "+v"(r)); bf16_t* xo = XB + (size_t)r * 1024 + col0; float sq = 0.f;
#pragma unroll
            for (int bj = 0; bj < 2; ++bj) { const u32x4 cx = xin[idx][bj]; const f32x4 a0 = acc[ai][bj][m][0], a1 = acc[ai][bj][m][1]; u32x4 w;
                w.x = pkbf(bflo(cx.x) + a0[0], bfhi(cx.x) + a0[1]); w.y = pkbf(bflo(cx.y) + a0[2], bfhi(cx.y) + a0[3]); w.z = pkbf(bflo(cx.z) + a1[0], bfhi(cx.z) + a1[1]); w.w = pkbf(bflo(cx.w) + a1[2], bfhi(cx.w) + a1[3]);
                ST16(xo + bj * 128, w);
#pragma unroll
                for (int e = 0; e < 4; ++e) { const float lo = bflo(w[e]), hi = bfhi(w[e]); sq += lo * lo + hi * hi; } }
            sq += __shfl_xor(sq, 16); sq += __shfl_xor(sq, 32);
            if (fq == 0) ssn[(size_t)r * 16 + u.pn * 4 + wc] = sq;
        }
    }
};
struct EpiUp {
    static constexpr bool PERM = true, AFTER_DRAIN = false;
    const float* ss; bf16_t* H; int rowmask;
    __device__ __forceinline__ void operator()(const f32x4 (&acc)[2][2][4][2], const Unit& u, int wr, int wc, int fr, int fq, unsigned mask) const {
        EPI_LOAD_RS(rsv, ss)
#pragma unroll
        for (int idx = 0; idx < 8; ++idx) {
            const int ai = idx >> 2, m = idx & 3;
            if (!((mask >> idx) & 1u)) continue;
            int r = EPI_ROW(idx); asm volatile("" : "+v"(r)); const float rs = rsv[idx];
#pragma unroll
            for (int bj = 0; bj < 2; ++bj) {
                f32x4 v0 = acc[ai][bj][m][0] * rs, v1 = acc[ai][bj][m][1] * rs;
#pragma unroll
                for (int e = 0; e < 4; ++e) { const float a = fmaxf(v0[e], 0.f), b = fmaxf(v1[e], 0.f); v0[e] = a * a; v1[e] = b * b; }
                u32x4 w; w.x = pkbf(v0[0], v0[1]); w.y = pkbf(v0[2], v0[3]); w.z = pkbf(v1[0], v1[1]); w.w = pkbf(v1[2], v1[3]);
                if (rowmask == 0x7ffffffe) ST16(H + ((size_t)(u.pm * 16 + u.pn) * 65536 + (size_t)(r & 255) * 256) + (COLPERM ? wc * 64 + bj * 32 : bj * 128 + wc * 32) + 8 * fq, w);
                else ST16(H + (size_t)(r & rowmask) * 4096 + u.pn * 256 + (COLPERM ? wc * 64 + bj * 32 : bj * 128 + wc * 32) + 8 * fq, w);
            }
        }
    }
};
struct EpiHin {
    static constexpr bool PERM = true, AFTER_DRAIN = false;
    const float* ss; u16* base;
    __device__ __forceinline__ void operator()(const f32x4 (&acc)[2][2][4][2], const Unit& u, int wr, int wc, int fr, int fq, unsigned mask) const {
        const int sel = u.pn >> 2; u16* ob = base + (size_t)sel * (ACT / 2);
        EPI_LOAD_RS(rsv, ss)
#pragma unroll
        for (int idx = 0; idx < 8; ++idx) {
            const int ai = idx >> 2, m = idx & 3;
            if (!((mask >> idx) & 1u)) continue;
            int r = EPI_ROW(idx); asm volatile("" : "+v"(r)); const float rs = rsv[idx];
#pragma unroll
            for (int bj = 0; bj < 2; ++bj) {
                f32x4 v0 = acc[ai][bj][m][0] * rs, v1 = acc[ai][bj][m][1] * rs; u32x4 w;
                if (sel == 1) { w.x = pkh(v0[0], v0[1]); w.y = pkh(v0[2], v0[3]); w.z = pkh(v1[0], v1[1]); w.w = pkh(v1[2], v1[3]); }
                else {
                    if (sel != 2) {
#pragma unroll
                        for (int e = 0; e < 4; ++e) { v0[e] = silu(v0[e]); v1[e] = silu(v1[e]); }
                    }
                    w.x = pkbf(v0[0], v0[1]); w.y = pkbf(v0[2], v0[3]); w.z = pkbf(v1[0], v1[1]); w.w = pkbf(v1[2], v1[3]);
                }
                ST16(ob + (size_t)r * 1024 + (u.pn & 3) * 256 + (COLPERM ? wc * 64 + bj * 32 : bj * 128 + wc * 32) + 8 * fq, w);
            }
        }
    }
};

template <class Epi> struct EpiMix {
    static constexpr bool PERM = Epi::PERM, AFTER_DRAIN = false;
    Epi E; float* P; unsigned* cnt; int S, m0, nm; unsigned pmask;
    __device__ __forceinline__ void operator()(f32x4 (&acc)[2][2][4][2], const Unit& u, int wr, int wc, int fr, int fq) const {
        unsigned mask = pmask;
        if (u.sp >= 0 && pmask == 0u) return;
        if (u.sp >= 0) {
            const int wid = wr * 4 + wc, lane = fq * 16 + fr, tile = (u.pm - m0) + nm * u.pn;
            float* pw = P + ((size_t)(tile * S + u.sp) * 8 + wid) * 8192 + lane * 4;
#pragma unroll
            for (int i = 0; i < 32; ++i) *(f32x4*)(pw + i * 256) = acc[i >> 4][(i >> 3) & 1][(i >> 1) & 3][i & 1];
            __builtin_amdgcn_fence(__ATOMIC_RELEASE, "agent");
            unsigned* cw = cnt + tile * 8 + wid;
            if (lane == 0) (void)__hip_atomic_fetch_add(cw, 1u, __ATOMIC_RELAXED, __HIP_MEMORY_SCOPE_AGENT);
            { unsigned sp_ = 0; while ((unsigned)__builtin_amdgcn_readfirstlane((int)__hip_atomic_load(cw, __ATOMIC_RELAXED, __HIP_MEMORY_SCOPE_AGENT)) < (unsigned)S) { __builtin_amdgcn_s_sleep(2); if (++sp_ > (1u << 22)) break; } }
            __builtin_amdgcn_fence(__ATOMIC_ACQUIRE, "agent");
            mask = S == 8 ? (1u << u.sp) : (3u << (2 * u.sp));
            const float* pr = P + ((size_t)(tile * S) * 8 + wid) * 8192 + lane * 4;
#pragma unroll
            for (int c = 0; c < 8; ++c) if ((mask >> c) & 1u) {
                f32x4 t0 = {0.f, 0.f, 0.f, 0.f}, t1 = t0, t2 = t0, t3 = t0; const int i0 = (c >> 2) * 16 + (c & 3) * 2;
#pragma unroll 2
                for (int s = 0; s < S; ++s) { const float* ps = pr + (size_t)s * 8 * 8192 + i0 * 256;
                    t0 += *(const f32x4*)(ps); t1 += *(const f32x4*)(ps + 256); t2 += *(const f32x4*)(ps + 8 * 256); t3 += *(const f32x4*)(ps + 9 * 256); }
                acc[c >> 2][0][c & 3][0] = t0; acc[c >> 2][0][c & 3][1] = t1; acc[c >> 2][1][c & 3][0] = t2; acc[c >> 2][1][c & 3][1] = t3;
            }
        }
        E(acc, u, wr, wc, fr, fq, mask);
    }
};

__device__ __forceinline__ int colperm(int a) { return (a & ~255) | (((a >> 5) & 1) << 7) | (((a >> 6) & 3) << 5) | (a & 31); }
__device__ __forceinline__ void p0_transpose_item(const float* W, const float* g, int K, int N, bf16_t* WT, float* scr, int item, int lane, bool perm) {
    const int nblk = N / 32, kb = item / nblk, nb = item % nblk, k0 = 64 * kb, n0 = 32 * nb;
    float wv[32];
#pragma unroll
    for (int i = 0; i < 32; ++i) { const int kk = 2 * i + (lane >> 5); wv[i] = W[(size_t)(k0 + kk) * N + n0 + (lane & 31)]; }
#pragma unroll
    for (int i = 0; i < 32; ++i) { const int kk = 2 * i + (lane >> 5); const float gs = g ? g[k0 + kk] : 1.f; scr[kk * 33 + (lane & 31)] = wv[i] * gs; }
    asm volatile("s_waitcnt lgkmcnt(0)" ::: "memory");
    const int c = lane & 7;
#pragma unroll
    for (int jj = 0; jj < 4; ++jj) { const int n = (lane >> 3) + 8 * jj; const float* s = scr + (8 * c) * 33 + n;
        u32x4 o; o.x = pkbf(s[0 * 33], s[1 * 33]); o.y = pkbf(s[2 * 33], s[3 * 33]); o.z = pkbf(s[4 * 33], s[5 * 33]); o.w = pkbf(s[6 * 33], s[7 * 33]);
        *(u32x4*)(WT + (size_t)(perm ? colperm(n0 + n) : n0 + n) * K + k0 + 8 * c) = o; }
    asm volatile("s_waitcnt lgkmcnt(0)" ::: "memory");
}
__device__ __forceinline__ size_t wlayer_base(int layer) { return layer == 0 ? 0 : layer == 1 ? (size_t)(10.5 * WM) : layer == 2 ? (size_t)(23.5 * WM) : (size_t)(34 * WM); }
__device__ __forceinline__ size_t wmat_off(int layer, int which) {
    const size_t b = wlayer_base(layer);
    if (layer & 1) return b + (which == 0 ? 0 : which == 1 ? 4 * WM : which == 2 ? 5 * WM : 9 * WM);
    return b + (which == 0 ? 0 : which == 1 ? (size_t)(1.5 * WM) : which == 2 ? (size_t)(2.5 * WM) : (size_t)(6.5 * WM));
}
__device__ __forceinline__ void prologue(KP pk, char* lds, int vcu, int G) {
    int tid_ = threadIdx.x; asm volatile("" : "+v"(tid_)); const int tid = tid_, lane = tid & 63, w = __builtin_amdgcn_readfirstlane(tid >> 6);
    const int gw = vcu * 8 + w, NGW = G * 8, gt = vcu * 512 + tid, NTH = G * 512;
    float* scr = (float*)(lds + w * 16384);
    bf16_t* WB = (bf16_t*)(pk->ws + WS_W);
    for (int it = gw; it < 24064; it += NGW) {
        int layer, r;
        if (it < 5376) { layer = 0; r = it; } else if (it < 12032) { layer = 1; r = it - 5376; } else if (it < 17408) { layer = 2; r = it - 12032; } else { layer = 3; r = it - 17408; }
        const int j = layer >> 1; const int n0 = (layer & 1) ? 2048 : 768; int which;
        if (r < n0) which = 0; else if (r < n0 + 512) { which = 1; r -= n0; } else if (r < n0 + 2560) { which = 2; r -= n0 + 512; } else { which = 3; r -= n0 + 2560; }
        const float* W; const float* g = nullptr; int K = 1024, N = 1024;
        if (which == 0) { g = pk->in[5] + layer * 1024; if (layer & 1) { W = pk->in[10] + (size_t)j * 4 * WM; N = 4096; } else { W = pk->in[7] + (size_t)j * 1536 * 1024; N = 1536; } }
        else if (which == 1) { W = ((layer & 1) ? pk->in[13] : pk->in[8]) + (size_t)j * WM; }
        else if (which == 2) { W = pk->in[14] + (size_t)layer * 4 * WM; g = pk->in[6] + layer * 1024; N = 4096; }
        else { W = pk->in[15] + (size_t)layer * 4 * WM; K = 4096; }
        p0_transpose_item(W, g, K, N, WB + wmat_off(layer, which), scr, r, lane, COLPERM && (which == 2 || (which == 0 && (layer & 1))));
    }
    bf16_t* XB = (bf16_t*)(pk->ws + WS_XB); float* ss0 = (float*)(pk->ws + WS_SS);
    for (int r0 = gw; r0 < MT; r0 += 2 * NGW) {
        const int r1 = r0 + NGW; const bool has1 = r1 < MT; const int rr[2] = {r0, has1 ? r1 : r0};
        f32x4 v[2][4];
#pragma unroll
        for (int t = 0; t < 2; ++t) { const int r = rr[t]; const float* src = r < MP ? pk->in[0] + (size_t)r * 1024 : pk->in[1] + (size_t)(r - MP) * 1024;
#pragma unroll
            for (int q = 0; q < 4; ++q) v[t][q] = *(const f32x4*)(src + 256 * q + 4 * lane); }
#pragma unroll
        for (int t = 0; t < 2; ++t) { const int r = rr[t]; float s = 0.f;
            if (t == 1 && !has1) break;
#pragma unroll
            for (int q = 0; q < 4; ++q) { u32x2 o; o.x = pkbf(v[t][q][0], v[t][q][1]); o.y = pkbf(v[t][q][2], v[t][q][3]); *(u32x2*)(XB + (size_t)r * 1024 + 256 * q + 4 * lane) = o;
                const float a = bflo(o.x), b = bfhi(o.x), c = bflo(o.y), d = bfhi(o.y); s += (a * a + b * b) + (c * c + d * d); }
#pragma unroll
            for (int o = 1; o < 64; o <<= 1) s += __shfl_xor(s, o);
            if (lane < 16) ss0[(size_t)r * 16 + lane] = lane == 0 ? s : 0.f; }
    }
    { u32x4* ctl = (u32x4*)(pk->ws + WS_CTL); const u32x4 z = {0u, 0u, 0u, 0u}; for (int e = gt; e < (int)(CTL_BYTES / 16); e += NTH) ctl[e] = z; }
    float* rope = (float*)(pk->ws + WS_ROPE);
    for (int e = gt; e < 65536; e += NTH) { const int pos = e >> 3, i = e & 7; const float inv = exp2f(-(float)i * 2.3664460711655217f); const float ang = (float)pos * inv;
        const double rev = (double)ang * 0.15915494309189535; const float fr = (float)(rev - __builtin_rint(rev));
        rope[pos * 16 + i] = __builtin_amdgcn_cosf(fr); rope[pos * 16 + 8 + i] = __builtin_amdgcn_sinf(fr); }
    for (int e = gt; e < 65536; e += NTH) { const int jj = e >> 15, rem = e & 32767, sb = rem >> 12, row = (rem >> 6) & 63, c4 = rem & 63;
        const size_t so = ((size_t)((jj * 8 + sb) * 128 + 64 + row)) * 256 + 4 * c4, dof = ((size_t)((jj * 8 + sb) * 128 + row)) * 256 + 4 * c4;
        *(f32x4*)(pk->out + OKS + dof) = *(const f32x4*)(pk->in[2] + so); *(f32x4*)(pk->out + OVS + dof) = *(const f32x4*)(pk->in[3] + so); }
}

__device__ __forceinline__ void attn_phase(KP pk, char* lds, int j, int vcu, int G) {
    int tid_ = threadIdx.x; asm volatile("" : "+v"(tid_)); const int tid = tid_, lane = tid & 63, w = __builtin_amdgcn_readfirstlane(tid >> 6), l15 = lane & 15, q4 = lane >> 4;
    bf16_t* Ks = (bf16_t*)lds; bf16_t* Vt = (bf16_t*)(lds + 27648);
    const bf16_t* Qb = (const bf16_t*)(pk->ws + WS_POOL); bf16_t* Ob = (bf16_t*)(pk->ws + WS_POOL + ACT);
    const bf16_t* Kb = (const bf16_t*)(pk->ws + WS_POOL + 2 * ACT); const bf16_t* Vb = Kb + (size_t)MT * 256;
    const float* ck = pk->in[2] + (size_t)j * 8 * 128 * 256; const float* cv = pk->in[3] + (size_t)j * 8 * 128 * 256; const float* sinks = pk->in[9] + j * 16;
    for (int unit = vcu; unit < 2080; unit += G) {
        int qrow0, kvh, kt0, sb = -1;
        if (unit < 2048) { const int b = unit >> 9, c = (unit >> 2) & 127; kvh = unit & 3; qrow0 = b * 8192 + c * 64; kt0 = c >= 2 ? 0 : (c == 1 ? 4 : 8); }
        else { const int u2 = unit - 2048; sb = u2 >> 2; kvh = u2 & 3; qrow0 = MP + sb * 64; kt0 = 0; }
        __syncthreads();
#pragma unroll
        for (int i = 0; i < 3; ++i) { const int ch = tid + 512 * i, key = ch >> 3, dc = ch & 7; u32x4 kv = {0u, 0u, 0u, 0u}, vv = kv;
            if (key >= 16 * kt0) {
                if (sb >= 0 && key < 128) { const size_t so = ((size_t)(sb * 128 + key) * 4 + kvh) * 64 + 8 * dc;
                    const f32x4 a = *(const f32x4*)(ck + so), b = *(const f32x4*)(ck + so + 4), c = *(const f32x4*)(cv + so), d = *(const f32x4*)(cv + so + 4);
                    kv.x = pkbf(a[0], a[1]); kv.y = pkbf(a[2], a[3]); kv.z = pkbf(b[0], b[1]); kv.w = pkbf(b[2], b[3]);
                    vv.x = pkbf(c[0], c[1]); vv.y = pkbf(c[2], c[3]); vv.z = pkbf(d[0], d[1]); vv.w = pkbf(d[2], d[3]); }
                else { const size_t so = (size_t)(qrow0 - 128 + key) * 256 + kvh * 64 + 8 * dc; kv = *(const u32x4*)(Kb + so); vv = *(const u32x4*)(Vb + so); }
            }
            *(u32x4*)(Ks + key * 72 + 8 * dc) = kv;
#pragma unroll
            for (int e = 0; e < 8; ++e) Vt[(8 * dc + e) * 200 + ((((key >> 3) ^ dc) << 3) | (key & 7))] = (u16)(vv[e >> 1] >> (16 * (e & 1)));
        }
        __syncthreads();
#pragma unroll 1
        for (int qt = 0; qt < 2; ++qt) {
            const int qi = 2 * w + qt, g = qi >> 2, t0 = 16 * (qi & 3), head = kvh * 4 + g;
            const bf16_t* qp = Qb + (size_t)(qrow0 + t0 + l15) * 1024 + head * 64 + 8 * q4;
            const bf16x8 qf0 = *(const bf16x8*)qp, qf1 = *(const bf16x8*)(qp + 32);
            f32x4 s[12]; const float sink2 = sinks[head] * LOG2E; float mx = sink2;
#pragma unroll
            for (int kt = 0; kt < 12; ++kt) { const bf16_t* kp = Ks + (16 * kt + l15) * 72 + 8 * q4;
                f32x4 a = {0.f, 0.f, 0.f, 0.f}; a = mfma16(*(const bf16x8*)kp, qf0, a); a = mfma16(*(const bf16x8*)(kp + 32), qf1, a);
                if (kt < kt0) a = (f32x4){-INFINITY, -INFINITY, -INFINITY, -INFINITY};
                s[kt] = a; mx = fmaxf(fmaxf(mx, fmaxf(a[0], a[1])), fmaxf(a[2], a[3])); if ((kt & 3) == 3) asm volatile("" ::: "memory"); }
            mx = fmaxf(mx, __shfl_xor(mx, 16)); mx = fmaxf(mx, __shfl_xor(mx, 32));
            float ls = 0.f;
#pragma unroll
            for (int kt = 0; kt < 12; ++kt)
#pragma unroll
                for (int e = 0; e < 4; ++e) { const float pe = __builtin_amdgcn_exp2f(s[kt][e] - mx); s[kt][e] = pe; ls += pe; }
            ls += __shfl_xor(ls, 16); ls += __shfl_xor(ls, 32); ls += __builtin_amdgcn_exp2f(sink2 - mx);
            const float rl = 1.f / ls;
            f32x4 o[4];
#pragma unroll
            for (int dt = 0; dt < 4; ++dt) o[dt] = (f32x4){0.f, 0.f, 0.f, 0.f};
#pragma unroll
            for (int kp = 0; kp < 6; ++kp) { u32x4 pw; pw.x = pkbf(s[2 * kp][0], s[2 * kp][1]); pw.y = pkbf(s[2 * kp][2], s[2 * kp][3]); pw.z = pkbf(s[2 * kp + 1][0], s[2 * kp + 1][1]); pw.w = pkbf(s[2 * kp + 1][2], s[2 * kp + 1][3]);
                const bf16x8 pf = __builtin_bit_cast(bf16x8, pw);
#pragma unroll
                for (int dt = 0; dt < 4; ++dt) { const int vd = 16 * dt + l15, vsw = (vd >> 3) & 7, vc0 = 4 * kp + (q4 >> 1); const bf16_t* vrow = Vt + vd * 200 + 4 * (q4 & 1); const u32x2 lo = *(const u32x2*)(vrow + ((vc0 ^ vsw) << 3)), hi = *(const u32x2*)(vrow + (((vc0 + 2) ^ vsw) << 3));
                    u32x4 aw; aw.x = lo.x; aw.y = lo.y; aw.z = hi.x; aw.w = hi.y; o[dt] = mfma16(__builtin_bit_cast(bf16x8, aw), pf, o[dt]); } if (kp & 1) asm volatile("" ::: "memory"); }
            bf16_t* stg = (bf16_t*)(lds + 53248) + w * 1152;
#pragma unroll
            for (int dt = 0; dt < 4; ++dt) { u32x2 ow; ow.x = pkbf(o[dt][0] * rl, o[dt][1] * rl); ow.y = pkbf(o[dt][2] * rl, o[dt][3] * rl); *(u32x2*)(stg + l15 * 72 + 16 * dt + 4 * q4) = ow; }
            asm volatile("s_waitcnt lgkmcnt(0)" ::: "memory");
#pragma unroll
            for (int i = 0; i < 2; ++i) { const int row = 8 * i + (lane >> 3), chn = lane & 7; *(u32x4*)(Ob + (size_t)(qrow0 + t0 + row) * 1024 + head * 64 + 8 * chn) = *(const u32x4*)(stg + row * 72 + 8 * chn); }
            asm volatile("s_waitcnt lgkmcnt(0)" ::: "memory");
        }
    }
}

__device__ __forceinline__ void hgrn_item(int it, int& m0, int& h) { if (it < 4096) { h = it & 7; m0 = (it >> 10) * 8192 + ((it >> 3) & 127) * 64; } else { const int x = it - 4096; h = x & 7; m0 = MP + (x >> 3) * 64; } }
constexpr int HL_ZS = 0, HL_TOT = 16384, HL_KT = 18432, HL_VT = 36864, HL_QS = 55296, HL_KS = 72704, HL_ST = 90112, HL_SSQ = 124928;

#define HGRN_STAGE_ZV() \
    _Pragma("unroll") for (int i = 0; i < 2; ++i) { const int ch = tid + 512 * i, row = ch >> 4, cc = ch & 15; \
        *(u32x4*)(ZS + row * 128 + 8 * cc) = zfr[i]; const u32x4 vv = vr[i]; \
        _Pragma("unroll") for (int e = 0; e < 8; ++e) VT[(8 * cc + e) * 72 + ((((row >> 3) ^ (cc & 7)) << 3) | (row & 7))] = (u16)(vv[e >> 1] >> (16 * (e & 1))); }
#define HGRN_GATES() \
    float kk[16], bl[16]; float cum = 0.f; \
    _Pragma("unroll") for (int i = 0; i < 16; ++i) { const float z = fminf(fmaxf((float)ZS[(16 * seg + i) * 128 + k], -30.f), 30.f); const float ez = __builtin_amdgcn_exp2f(-1.4426950408889634f * z), sg = __builtin_amdgcn_rcpf(1.f + ez); cum += __builtin_amdgcn_logf(lbv + oml * sg); bl[i] = cum; kk[i] = oml * ez * sg; } \
    TOT[seg * 128 + k] = cum; \
    __syncthreads(); \
    const float t0_ = TOT[k], t1_ = TOT[128 + k], t2_ = TOT[256 + k], t3_ = TOT[384 + k]; \
    const float off = seg == 0 ? 0.f : seg == 1 ? t0_ : seg == 2 ? t0_ + t1_ : t0_ + t1_ + t2_; const float b31 = t0_ + t1_;

__device__ __forceinline__ void hgrn_passA(KP pk, char* lds, int j, int vcu, int G, bool dost) {
    int tid_ = threadIdx.x; asm volatile("" : "+v"(tid_)); const int tid = tid_, lane = tid & 63, w = __builtin_amdgcn_readfirstlane(tid >> 6), l15 = lane & 15, q4 = lane >> 4, k = tid & 127, seg = tid >> 7;
    _Float16* ZS = (_Float16*)(lds + HL_ZS); float* TOT = (float*)(lds + HL_TOT); bf16_t* KT = (bf16_t*)(lds + HL_KT); bf16_t* VT = (bf16_t*)(lds + HL_VT);
    const u16* ZF = (const u16*)(pk->ws + WS_POOL + ACT); const u16* VH = (const u16*)(pk->ws + WS_POOL + 2 * ACT);
    bf16_t* UB = (bf16_t*)(pk->out + OY); float* DB = (float*)(pk->ws + WS_DB);
    float lbv = 0.f, oml = 1.f; int hprev = -1;
    u32x4 zfr[2], vr[2];
#define PA_LOAD(itx) { int m0_, h_; hgrn_item(itx, m0_, h_); _Pragma("unroll") for (int i = 0; i < 2; ++i) { const int ch = tid + 512 * i; const size_t go = (size_t)(m0_ + (ch >> 4)) * 1024 + h_ * 128 + 8 * (ch & 15); zfr[i] = *(const u32x4*)(ZF + go); vr[i] = *(const u32x4*)(VH + go); } }
    if (vcu < 4160) PA_LOAD(vcu)
    for (int it = vcu; it < 4160; it += G) {
        int m0, h; hgrn_item(it, m0, h);
        if (j == 1 && h != hprev) { const float a = pk->in[11][h * 128 + k], b = pk->in[11][1024 + h * 128 + k]; lbv = 1.f / (1.f + __expf(a - b)); oml = 1.f - lbv; hprev = h; }
        __syncthreads();
        HGRN_STAGE_ZV()
        if (it + G < 4160) PA_LOAD(it + G)
        __syncthreads();
        HGRN_GATES()
        { u32x4 w0, w1; unsigned wk[8];
#pragma unroll
          for (int i = 0; i < 8; ++i) wk[i] = pkbf(kk[2 * i] * __builtin_amdgcn_exp2f(b31 - (off + bl[2 * i])), kk[2 * i + 1] * __builtin_amdgcn_exp2f(b31 - (off + bl[2 * i + 1])));
          w0.x = wk[0]; w0.y = wk[1]; w0.z = wk[2]; w0.w = wk[3]; w1.x = wk[4]; w1.y = wk[5]; w1.z = wk[6]; w1.w = wk[7];
          *(u32x4*)(KT + k * 72 + 16 * seg) = w0; *(u32x4*)(KT + k * 72 + 16 * seg + 8) = w1; }
        if (seg == 0) DB[(size_t)it * 128 + k] = __builtin_amdgcn_exp2f(b31 + t2_ + t3_);
        __syncthreads();
        const int kr = 16 * w + l15;
        const bf16x8 b0 = *(const bf16x8*)(KT + kr * 72 + 8 * q4), b1 = *(const bf16x8*)(KT + kr * 72 + 32 + 8 * q4);
        const float sc = __builtin_amdgcn_exp2f(TOT[256 + kr] + TOT[384 + kr]);
        bf16_t* stg = (bf16_t*)(lds + HL_QS) + w * 2176;
#pragma unroll
        for (int vt = 0; vt < 8; ++vt) { const int vv_ = 16 * vt + l15, vsw = (vv_ >> 3) & 7; const bf16_t* vp = VT + vv_ * 72; f32x4 a = {0.f, 0.f, 0.f, 0.f};
            a = mfma16(*(const bf16x8*)(vp + ((q4 ^ vsw) << 3)), b0, a); a = mfma16(*(const bf16x8*)(vp + (((4 + q4) ^ vsw) << 3)), b1, a);
            u32x2 ow; ow.x = pkbf(a[0] * sc, a[1] * sc); ow.y = pkbf(a[2] * sc, a[3] * sc); *(u32x2*)(stg + l15 * 136 + 16 * vt + 4 * q4) = ow; }
        asm volatile("s_waitcnt lgkmcnt(0)" ::: "memory");
        { bf16_t* up = UB + (size_t)it * 16384 + (16 * w) * 128;
#pragma unroll
          for (int i = 0; i < 4; ++i) { const int row = 4 * i + (lane >> 4), chn = lane & 15; if (dost) *(u32x4*)(up + row * 128 + 8 * chn) = *(const u32x4*)(stg + row * 136 + 8 * chn); } }
    }
#undef PA_LOAD
}
__device__ __forceinline__ void hgrn_passB(KP pk, int j, int G, bool dost) {
    int tid_ = threadIdx.x; asm volatile("" : "+v"(tid_)); const int gt = blockIdx.x * 512 + tid_, NTH = G * 512;
    bf16_t* UB = (bf16_t*)(pk->out + OY); const float* DB = (const float*)(pk->ws + WS_DB);
    for (int e = gt; e < 131072; e += NTH) {
        const int bh = e >> 12, k = (e >> 5) & 127, v4 = e & 31, b = bh >> 3, h = bh & 7;
        f32x4 S = {0.f, 0.f, 0.f, 0.f};
        bf16_t* ub = UB + (size_t)(b * 1024 + h) * 16384 + k * 128 + 4 * v4; const float* db = DB + (size_t)(b * 1024 + h) * 128 + k;
#pragma unroll 1
        for (int c0 = 0; c0 < 128; c0 += 8) {
            u32x2 uu[8]; float d[8];
#pragma unroll
            for (int i = 0; i < 8; ++i) { uu[i] = *(const u32x2*)(ub + (size_t)(c0 + i) * 8 * 16384); d[i] = db[(size_t)(c0 + i) * 1024]; }
#pragma unroll
            for (int i = 0; i < 8; ++i) { u32x2 sw; sw.x = pkbf(S[0], S[1]); sw.y = pkbf(S[2], S[3]); if (dost) *(u32x2*)(ub + (size_t)(c0 + i) * 8 * 16384) = sw;
                S[0] = d[i] * S[0] + bflo(uu[i].x); S[1] = d[i] * S[1] + bfhi(uu[i].x); S[2] = d[i] * S[2] + bflo(uu[i].y); S[3] = d[i] * S[3] + bfhi(uu[i].y); }
        }
        if (dost) *(f32x4*)(pk->out + OSP + (size_t)(j * 32 + bh) * 16384 + k * 128 + 4 * v4) = S;
    }
    for (int e = gt; e < 262144; e += NTH) {
        const int sbh = e >> 12, k = (e >> 5) & 127, v4 = e & 31, it = 4096 + sbh; const size_t eo = (size_t)k * 128 + 4 * v4;
        const f32x4 S0 = *(const f32x4*)(pk->in[4] + (size_t)(j * 64 + sbh) * 16384 + eo);
        bf16_t* ub = UB + (size_t)it * 16384 + eo; const u32x2 uu = *(const u32x2*)ub; const float d = DB[(size_t)it * 128 + k];
        u32x2 sw; sw.x = pkbf(S0[0], S0[1]); sw.y = pkbf(S0[2], S0[3]); if (dost) *(u32x2*)ub = sw;
        f32x4 S; S[0] = d * S0[0] + bflo(uu.x); S[1] = d * S0[1] + bfhi(uu.x); S[2] = d * S0[2] + bflo(uu.y); S[3] = d * S0[3] + bfhi(uu.y);
        if (dost) *(f32x4*)(pk->out + OSS + (size_t)(j * 64 + sbh) * 16384 + eo) = S;
    }
}
__device__ __forceinline__ void hgrn_passC(KP pk, char* lds, int j, int vcu, int G, bool dost) {
    int tid_ = threadIdx.x; asm volatile("" : "+v"(tid_)); const int tid = tid_, lane = tid & 63, w = __builtin_amdgcn_readfirstlane(tid >> 6), l15 = lane & 15, q4 = lane >> 4, k = tid & 127, seg = tid >> 7;
    _Float16* ZS = (_Float16*)(lds + HL_ZS); float* TOT = (float*)(lds + HL_TOT); bf16_t* VT = (bf16_t*)(lds + HL_VT);
    u16* QG = (u16*)(lds + HL_KT); bf16_t* QS = (bf16_t*)(lds + HL_QS); bf16_t* KS = (bf16_t*)(lds + HL_KS); bf16_t* ST = (bf16_t*)(lds + HL_ST); float* SSQ = (float*)(lds + HL_SSQ);
    u16* QH = (u16*)(pk->ws + WS_POOL); const u16* ZF = (const u16*)(pk->ws + WS_POOL + ACT); const u16* VH = (const u16*)(pk->ws + WS_POOL + 2 * ACT); const u16* GH = (const u16*)(pk->ws + WS_POOL + 3 * ACT);
    const bf16_t* UB = (const bf16_t*)(pk->out + OY); const float* onorm = pk->in[12] + j * 128;
    const int tt = w & 3, vh = w >> 2;
    float lbv = 0.f, oml = 1.f; int hprev = -1;
    float* ONL = (float*)(lds + HL_SSQ + 512); if (tid < 128) ONL[tid] = onorm[tid];
    u32x4 zfr[2], vr[2], qr[2], sr[4];
#define PC_LOAD(itx) { int m0_, h_; hgrn_item(itx, m0_, h_); _Pragma("unroll") for (int i = 0; i < 2; ++i) { const int ch = tid + 512 * i; const size_t go = (size_t)(m0_ + (ch >> 4)) * 1024 + h_ * 128 + 8 * (ch & 15); \
        zfr[i] = *(const u32x4*)(ZF + go); vr[i] = *(const u32x4*)(VH + go); qr[i] = *(const u32x4*)(QH + go); } \
        _Pragma("unroll") for (int i = 0; i < 4; ++i) { const int ch = tid + 512 * i; sr[i] = *(const u32x4*)(UB + (size_t)(itx) * 16384 + (ch >> 4) * 128 + 8 * (ch & 15)); } }
    if (vcu < 4160) PC_LOAD(vcu)
    for (int it = vcu; it < 4160; it += G) {
        int m0, h; hgrn_item(it, m0, h);
        if (j == 1 && h != hprev) { const float a = pk->in[11][h * 128 + k], b = pk->in[11][1024 + h * 128 + k]; lbv = 1.f / (1.f + __expf(a - b)); oml = 1.f - lbv; hprev = h; }
        __syncthreads();
        HGRN_STAGE_ZV()
#pragma unroll
        for (int i = 0; i < 2; ++i) { const int ch = tid + 512 * i; *(u32x4*)(QG + (ch >> 4) * 128 + 8 * (ch & 15)) = qr[i]; }
        u32x4 sc_[4];
#pragma unroll
        for (int i = 0; i < 4; ++i) sc_[i] = sr[i];
        u32x4 gr[2];
#pragma unroll
        for (int i = 0; i < 2; ++i) { const int ch = tid + 512 * i; gr[i] = *(const u32x4*)(GH + (size_t)(m0 + (ch >> 4)) * 1024 + h * 128 + 8 * (ch & 15)); }
        if (it + G < 4160) PC_LOAD(it + G)
        __syncthreads();
        HGRN_GATES()
        { u16* GS = (u16*)(lds + HL_ZS);
#pragma unroll
          for (int i = 0; i < 2; ++i) { const int ch = tid + 512 * i; *(u32x4*)(GS + (ch >> 4) * 128 + 8 * (ch & 15)) = gr[i]; } }
        float qv[16];
#pragma unroll
        for (int i = 0; i < 16; ++i) qv[i] = bf2f(QG[(16 * seg + i) * 128 + k]);
#pragma unroll
        for (int i = 0; i < 16; ++i) { const float bt = off + bl[i]; KS[(16 * seg + i) * 136 + k] = f2bf(kk[i] * __builtin_amdgcn_exp2f(b31 - bt)); QS[(16 * seg + i) * 136 + k] = f2bf(qv[i] * __builtin_amdgcn_exp2f(bt - b31)); }
#pragma unroll
        for (int i = 0; i < 4; ++i) { const int ch = tid + 512 * i, kr = ch >> 4, vc = ch & 15; const float sc = __builtin_amdgcn_exp2f(TOT[kr] + TOT[128 + kr]);
            const u32x4 sv = sc_[i];
#pragma unroll
            for (int e = 0; e < 8; ++e) { const unsigned wv = sv[e >> 1]; const float f = (e & 1) ? bfhi(wv) : bflo(wv); ST[(8 * vc + e) * 136 + ((((kr >> 3) ^ vc) << 3) | (kr & 7))] = f2bf(f * sc); } }
        __syncthreads();
        bf16x8 qf[4];
#pragma unroll
        for (int ks = 0; ks < 4; ++ks) qf[ks] = *(const bf16x8*)(QS + (16 * tt + l15) * 136 + 32 * ks + 8 * q4);
        f32x4 sc4[4];
#pragma unroll
        for (int st = 0; st < 4; ++st) { f32x4 a = {0.f, 0.f, 0.f, 0.f};
            if (st <= tt) {
#pragma unroll
                for (int ks = 0; ks < 4; ++ks) a = mfma16(*(const bf16x8*)(KS + (16 * st + l15) * 136 + 32 * ks + 8 * q4), qf[ks], a);
                if (st == tt) {
#pragma unroll
                    for (int r = 0; r < 4; ++r) if (4 * q4 + r > l15) a[r] = 0.f;
                }
            }
            sc4[st] = a; }
        f32x4 o[4];
#pragma unroll
        for (int vi = 0; vi < 4; ++vi) { const int vt = 4 * vh + vi; f32x4 a = {0.f, 0.f, 0.f, 0.f};
#pragma unroll
            for (int kp = 0; kp < 2; ++kp) if (2 * kp <= tt) {
                u32x4 pw; pw.x = pkbf(sc4[2 * kp][0], sc4[2 * kp][1]); pw.y = pkbf(sc4[2 * kp][2], sc4[2 * kp][3]); pw.z = pkbf(sc4[2 * kp + 1][0], sc4[2 * kp + 1][1]); pw.w = pkbf(sc4[2 * kp + 1][2], sc4[2 * kp + 1][3]);
                const int vv_ = 16 * vt + l15, vsw = (vv_ >> 3) & 7, vc0 = 4 * kp + (q4 >> 1); const bf16_t* vrow = VT + vv_ * 72 + 4 * (q4 & 1); const u32x2 lo = *(const u32x2*)(vrow + ((vc0 ^ vsw) << 3)), hi = *(const u32x2*)(vrow + (((vc0 + 2) ^ vsw) << 3));
                u32x4 aw; aw.x = lo.x; aw.y = lo.y; aw.z = hi.x; aw.w = hi.y; a = mfma16(__builtin_bit_cast(bf16x8, aw), __builtin_bit_cast(bf16x8, pw), a); }
#pragma unroll
            for (int ks = 0; ks < 4; ++ks) a = mfma16(*(const bf16x8*)(ST + (16 * vt + l15) * 136 + (((4 * ks + q4) ^ (((16 * vt + l15) >> 3) & 15)) << 3)), qf[ks], a);
            o[vi] = a; }
        float sq = 0.f;
#pragma unroll
        for (int vi = 0; vi < 4; ++vi) sq += (o[vi][0] * o[vi][0] + o[vi][1] * o[vi][1]) + (o[vi][2] * o[vi][2] + o[vi][3] * o[vi][3]);
        sq += __shfl_xor(sq, 16); sq += __shfl_xor(sq, 32);
        if (q4 == 0) SSQ[vh * 64 + 16 * tt + l15] = sq;
        __syncthreads();
        const float rn = rsqrtf((SSQ[16 * tt + l15] + SSQ[64 + 16 * tt + l15]) * (1.f / 128.f) + EPS);
        bf16_t* stg = (bf16_t*)(lds + HL_QS) + w * 1152;
#pragma unroll
        for (int vi = 0; vi < 4; ++vi) { const int v0 = 16 * (4 * vh + vi) + 4 * q4; const f32x4 gn = *(const f32x4*)(ONL + v0);
            const u32x2 g2 = *(const u32x2*)((const u16*)(lds + HL_ZS) + (16 * tt + l15) * 128 + v0); u32x2 ow;
            ow.x = pkbf(o[vi][0] * rn * gn[0] * bflo(g2.x), o[vi][1] * rn * gn[1] * bfhi(g2.x)); ow.y = pkbf(o[vi][2] * rn * gn[2] * bflo(g2.y), o[vi][3] * rn * gn[3] * bfhi(g2.y));
            *(u32x2*)(stg + l15 * 72 + 16 * vi + 4 * q4) = ow; }
        asm volatile("s_waitcnt lgkmcnt(0)" ::: "memory");
        if (dost) {
#pragma unroll
            for (int i = 0; i < 2; ++i) { const int row = 8 * i + (lane >> 3), chn = lane & 7; *(u32x4*)(QH + (size_t)(m0 + 16 * tt + row) * 1024 + h * 128 + 64 * vh + 8 * chn) = *(const u32x4*)(stg + row * 72 + 8 * chn); } }
    }
#undef PC_LOAD
}
__device__ __forceinline__ void final_phase(KP pk, int vcu, int G) {
    int tid_ = threadIdx.x; asm volatile("" : "+v"(tid_)); const int tid = tid_, lane = tid & 63, w = tid >> 6; const int gw = vcu * 8 + w, NGW = G * 8;
    float* Y = pk->out + OY; const bf16_t* XB = (const bf16_t*)(pk->ws + WS_XB); const float* ss = (const float*)(pk->ws + WS_SS) + (size_t)(8 % 3) * SS_SLOT; const float* fn = pk->in[16];
    f32x4 g[4];
#pragma unroll
    for (int q = 0; q < 4; ++q) g[q] = *(const f32x4*)(fn + 256 * q + 4 * lane);
    for (int r0 = gw; r0 < MT; r0 += 4 * NGW) {
        u32x2 xv[4][4]; float pv[4];
#pragma unroll
        for (int t = 0; t < 4; ++t) { const int r = r0 + t * NGW < MT ? r0 + t * NGW : r0;
            pv[t] = lane < 16 ? ss[(size_t)r * 16 + lane] : 0.f;
#pragma unroll
            for (int q = 0; q < 4; ++q) xv[t][q] = *(const u32x2*)(XB + (size_t)r * 1024 + 256 * q + 4 * lane); }
#pragma unroll
        for (int t = 0; t < 4; ++t) { const int r = r0 + t * NGW; if (r >= MT) break;
            float s = pv[t];
#pragma unroll
            for (int o = 1; o < 16; o <<= 1) s += __shfl_xor(s, o);
            s = __shfl(s, 0); const float rs = rsqrtf(s * (1.f / 1024.f) + EPS);
#pragma unroll
            for (int q = 0; q < 4; ++q) { f32x4 y; y[0] = bflo(xv[t][q].x) * rs * g[q][0]; y[1] = bfhi(xv[t][q].x) * rs * g[q][1]; y[2] = bflo(xv[t][q].y) * rs * g[q][2]; y[3] = bfhi(xv[t][q].y) * rs * g[q][3];
                *(f32x4*)(Y + (size_t)r * 1024 + 256 * q + 4 * lane) = y; } }
    }
}

#ifndef STAG_MODE
#define STAG_MODE 0
#endif
#ifndef STAG_T
#define STAG_T 26
#endif
__device__ __forceinline__ void stagger(int bx, int usec_total) {
    if (STAG_MODE == 0) return;
    const int grp = STAG_MODE == 1 ? (bx & 7) : ((bx >> 3) & 7);
    const unsigned long long t0 = __builtin_amdgcn_s_memrealtime(); const unsigned long long dt = (unsigned long long)(grp * usec_total * 100 / 8);
    while (__builtin_amdgcn_s_memrealtime() - t0 < dt) __builtin_amdgcn_s_sleep(8);
}

constexpr int LDS_BYTES = 147456;
constexpr int PH_A = 3 + 2 * NHALF, PH_H = 5 + 2 * NHALF, NPHASE = 2 + 2 * (PH_A + PH_H);
#ifndef SKIPMASK
#define SKIPMASK 0
#endif
#ifndef PROBE_KIND
#define PROBE_KIND -1
#endif
#ifndef PROBE_REP
#define PROBE_REP 1
#endif
#ifndef PROBE_NOEPI
#define PROBE_NOEPI 0
#endif
__global__ void __launch_bounds__(512, 2) fwd_kernel(Params p_unused) {
    extern __shared__ __attribute__((aligned(16))) unsigned char lds[];
    cg::grid_group grid = cg::this_grid();
    const int G = gridDim.x, bx = blockIdx.x; const int vcu = (G % 8 == 0) ? (bx % 8) * (G / 8) + bx / 8 : bx;
    volatile LAS unsigned* misc = (volatile LAS unsigned*)((LAS unsigned char*)lds + 131072 + 320);
    if (threadIdx.x < 64) misc[threadIdx.x] = 0u;
    __syncthreads();
    int ph, ph_hi; XcdBarrier bar; { KP k0 = kargs(); ph = k0->ph_lo; ph_hi = k0->ph_hi; bar.bar = (unsigned*)(k0->ws + WS_CTL) + 4096; bar.x = 0u; bar.st = misc + 8; }
    for (; ph < ph_hi; ++ph) {
        int layer = 0, kind, half = 0;
        if (ph == 0) kind = 0; else if (ph == NPHASE - 1) kind = 10;
        else { int q = ph - 1; if (q < PH_A) { layer = 0; } else if (q < PH_A + PH_H) { layer = 1; q -= PH_A; } else if (q < 2 * PH_A + PH_H) { layer = 2; q -= PH_A + PH_H; } else { layer = 3; q -= 2 * PH_A + PH_H; }
            if (layer & 1) { if (q < 4) kind = 6 + q; else if (q == 4) kind = 3; else { kind = 4 + ((q - 5) & 1); half = (q - 5) >> 1; } }
            else { if (q < 3) kind = 1 + q; else { kind = 4 + ((q - 3) & 1); half = (q - 3) >> 1; } } }
        const int j = layer >> 1;
        int nrep = 1; if (kind == PROBE_KIND) nrep = PROBE_REP;
        for (int rep = 0; rep < nrep; ++rep) {
        if (rep) xcd_barrier(bar);
        KP pk = kargs();
        if (kind == 0) { if (!(SKIPMASK & 1)) prologue(pk, (char*)lds, vcu, G); }
        else if (kind == 1 && !(SKIPMASK & 2)) {
            stagger(bx, STAG_T);
            unsigned char* ws = pk->ws; float* out = pk->out; bf16_t* WB = (bf16_t*)(ws + WS_W); float* ssb = (float*)(ws + WS_SS);
            pg8::Gemm g{(bf16_t*)(ws + WS_XB), WB + wmat_off(layer, 0), MT, 1536, 1024}; pg8::StaticOrder S; S.init(MP, 1536, 1024, G, bx); S.split(128, 2, 4);
            EpiQKV E{ws, out, j, (2 * layer) % 3};
            EpiMix<EpiQKV> EM{E, (float*)(ws + WS_SPK), (unsigned*)(ws + WS_CTL + 32768) + ph * 256, 4, 128, 2, (PROBE_NOEPI && rep + 1 < nrep) ? 0u : 0xffu};
            pg8::gemm_phase<EpiMix<EpiQKV>, pg8::StaticOrder, PG_ALIGN, PG_SP2>((PG8_LAS unsigned char*)lds, g, S, EM);
        } else if (kind == 2) { if (!(SKIPMASK & 4)) attn_phase(pk, (char*)lds, j, vcu, G); }
        else if ((kind == 3 || kind == 5) && !(SKIPMASK & 8)) {
            unsigned char* ws = pk->ws; bf16_t* WB = (bf16_t*)(ws + WS_W); float* ssb = (float*)(ws + WS_SS);
            const bool dn = kind == 5; const int K = dn ? 4096 : 1024;
            const bf16_t* A = dn ? (const bf16_t*)(ws + WS_POOL) - (size_t)(half * HROWS) * 4096 : ((layer & 1) ? (const bf16_t*)(ws + WS_POOL) : (const bf16_t*)(ws + WS_POOL + ACT));
            pg8::Gemm g{A, WB + wmat_off(layer, dn ? 3 : 1), MT, 1024, K}; pg8::StaticOrder S;
            if (dn) { S.init(HROWS, 1024, K, G, bx, half * (HROWS / 256)); if (half == NHALF - 1) S.split(128, 2, 8); } else { S.init(MP, 1024, K, G, bx); S.split(128, 2, 4); }
            EpiRes E{(bf16_t*)(ws + WS_XB), ssb + (size_t)((2 * layer + (dn ? 2 : 1)) % 3) * SS_SLOT};
            EpiMix<EpiRes> EM{E, (float*)(ws + WS_SPK), (unsigned*)(ws + WS_CTL + 32768) + ph * 256, dn ? 8 : 4, 128, 2, (PROBE_NOEPI && rep + 1 < nrep) ? 0u : 0xffu};
            pg8::gemm_phase<EpiMix<EpiRes>, pg8::StaticOrder, PG_ALIGN, PG_SP2>((PG8_LAS unsigned char*)lds, g, S, EM);
        } else if (kind == 4 && !(SKIPMASK & 16)) {
            unsigned char* ws = pk->ws; bf16_t* WB = (bf16_t*)(ws + WS_W); float* ssb = (float*)(ws + WS_SS);
            pg8::Gemm g{(bf16_t*)(ws + WS_XB), WB + wmat_off(layer, 2), MT, 4096, 1024}; pg8::StaticOrder S; S.init(HROWS, 4096, 1024, G, bx, half * (HROWS / 256)); if (half == NHALF - 1) S.split(128, 2, 4);
            EpiUp E{ssb + (size_t)((2 * layer + 1) % 3) * SS_SLOT, (bf16_t*)(ws + WS_POOL) - (size_t)(half * HROWS) * 4096, (PROBE_NOEPI == 2 && rep + 1 < nrep) ? 255 : (PROBE_NOEPI == 3 && rep + 1 < nrep) ? 0x7ffffffe : 0x7fffffff};
            EpiMix<EpiUp> EM{E, (float*)(ws + WS_SPK), (unsigned*)(ws + WS_CTL + 32768) + ph * 256, 4, 128, 2, 0xffu};
            pg8::gemm_phase<EpiMix<EpiUp>, pg8::StaticOrder, PG_ALIGN, PG_SP2>((PG8_LAS unsigned char*)lds, g, S, EM);
        } else if (kind == 6 && !(SKIPMASK & 32)) {
            stagger(bx, STAG_T);
            unsigned char* ws = pk->ws; bf16_t* WB = (bf16_t*)(ws + WS_W); float* ssb = (float*)(ws + WS_SS);
            pg8::Gemm g{(bf16_t*)(ws + WS_XB), WB + wmat_off(layer, 0), MT, 4096, 1024}; pg8::StaticOrder S; S.init(MP, 4096, 1024, G, bx); S.split(128, 2, 4);
            EpiHin E{ssb + (size_t)((2 * layer) % 3) * SS_SLOT, (u16*)(ws + WS_POOL)};
            EpiMix<EpiHin> EM{E, (float*)(ws + WS_SPK), (unsigned*)(ws + WS_CTL + 32768) + ph * 256, 4, 128, 2, (PROBE_NOEPI && rep + 1 < nrep) ? 0u : 0xffu};
            pg8::gemm_phase<EpiMix<EpiHin>, pg8::StaticOrder, PG_ALIGN, PG_SP2>((PG8_LAS unsigned char*)lds, g, S, EM);
        } else if (kind == 7) { if (!(SKIPMASK & 64)) hgrn_passA(pk, (char*)lds, j, vcu, G, !(PROBE_NOEPI && rep + 1 < nrep)); }
        else if (kind == 8) { if (!(SKIPMASK & 128)) hgrn_passB(pk, j, G, !(PROBE_NOEPI && rep + 1 < nrep)); }
        else if (kind == 9) { if (!(SKIPMASK & 256)) hgrn_passC(pk, (char*)lds, j, vcu, G, !(PROBE_NOEPI && rep + 1 < nrep)); }
        else if (kind == 10) { if (!(SKIPMASK & 512)) final_phase(pk, vcu, G); }
        }
        if (PROBE_KIND == 99 && ph == 3) for (int e = 0; e < PROBE_REP; ++e) xcd_barrier(bar);
        if (ph + 1 < ph_hi) { if (ph == 0) { grid.sync(); KP k1 = kargs(); bar = xcd_barrier_post((unsigned*)(k1->ws + WS_CTL) + 4096, misc + 8); } else xcd_barrier(bar); }
    }
}

#ifndef MK_PER_PHASE
#define MK_PER_PHASE 0
#endif
extern "C" void kernel_launch(void* const* d_in, const int* in_sizes, int n_in, void* d_out, int out_size, void* d_ws, size_t ws_size, hipStream_t stream) {
    static int grid = 0;
    if (grid == 0) {
        int dev = 0, cus = 0, per_cu = 0;
        hipGetDevice(&dev); hipDeviceGetAttribute(&cus, hipDeviceAttributeMultiprocessorCount, dev);
        hipFuncSetAttribute((const void*)fwd_kernel, hipFuncAttributeMaxDynamicSharedMemorySize, LDS_BYTES);
        hipOccupancyMaxActiveBlocksPerMultiprocessor(&per_cu, (const void*)fwd_kernel, 512, LDS_BYTES);
        (void)hipGetLastError();
        if (per_cu < 1) { fprintf(stderr, "kernel_launch: occupancy query says %d blocks/CU\n", per_cu); per_cu = 1; }
        grid = cus;
        if (n_in != 17 || ws_size < WS_SS + 3 * SS_SLOT * 4) { fprintf(stderr, "kernel_launch: unexpected n_in %d / ws_size %zu (need %zu)\n", n_in, ws_size, (size_t)WS_END); }
    }
    Params p{};
    for (int i = 0; i < 17; ++i) p.in[i] = (const float*)d_in[i];
    p.out = (float*)d_out; p.ws = (unsigned char*)d_ws;
#if MK_PER_PHASE
    for (int ph = 0; ph < NPHASE; ++ph) { p.ph_lo = ph; p.ph_hi = ph + 1; hipLaunchKernelGGL(fwd_kernel, dim3(grid), dim3(512), LDS_BYTES, stream, p); }
#else
    p.ph_lo = 0; p.ph_hi = NPHASE;
    void* args[] = {&p};
    hipError_t e = hipLaunchCooperativeKernel((const void*)fwd_kernel, dim3(grid), dim3(512), args, LDS_BYTES, stream);
    if (e != hipSuccess) fprintf(stderr, "cooperative launch failed: %s (grid %d)\n", hipGetErrorString(e), grid);
#endif
}
```

```cpp
#include <hip/hip_runtime.h>
#include <hip/hip_cooperative_groups.h>
#include <cstdio>
#include <cstdint>
namespace cg = cooperative_groups;
#ifndef PG_WGM
#define PG_WGM 8
#endif
#ifndef PG_ALIGN
#define PG_ALIGN true
#endif
#ifndef PG_SP2
#define PG_SP2 true
#endif
namespace pg8 {
#define PG8_LAS __attribute__((address_space(3)))
typedef unsigned short bf16_t;
typedef short bf16x8 __attribute__((ext_vector_type(8)));
typedef float f32x4 __attribute__((ext_vector_type(4)));
typedef unsigned u32x4 __attribute__((ext_vector_type(4)));
constexpr int BM = 256, BK = 64, HALF = 128, HTB = HALF * BK * 2  , STAGE_BYTES = 8 * HTB, NXCD = 8, WGM = PG_WGM;

__host__ __device__ __forceinline__ int lds_byte(int r, int c) { const int st = (r >> 4) * 2 + (c >> 5), rr = r & 15, cc = c & 31, ob = rr * 64 + cc * 2; return st * 1024 + (ob ^ (((ob >> 9) & 1) << 5)); }
__host__ __device__ __forceinline__ void stage_rc(int b, int& R, int& C) { const int st = b / 1024, sb = b % 1024, swz = sb ^ (((sb >> 9) & 1) << 5); R = (st >> 1) * 16 + swz / 64; C = (st & 1) * 32 + (swz % 64) / 2; }
__host__ __device__ __forceinline__ int perm32(int rho) { const int n = rho >> 4, i = rho & 15; return 8 * (i >> 2) + 4 * n + (i & 3); }

struct Unit { int pm, pn, k0, nt, sp; };
struct Gemm { const bf16_t* A; const bf16_t* Bt; int M, N, K; };

struct StaticOrder {
    int nM, nN, nwg, G, c, ntK, pm0;
    int sM0, sNM, sS, sKs, nsp;
    __host__ __device__ void init(int M, int N, int K, int G_, int c_, int pm0_ = 0) { pm0 = pm0_; nM = M / BM; nN = N / BM; nwg = nM * nN; G = G_; c = c_; ntK = K / BK; sM0 = 0; sNM = 0; sS = 1; sKs = K; nsp = 0; }
    __host__ __device__ void split(int m0, int nm, int S) { sM0 = m0; sNM = nm; sS = S; sKs = (ntK / S) * BK; nsp = nm * nN * S; }
    __host__ __device__ bool next(int i, Unit& u) const {
        const long L = (long)i * G + c;
        if (L >= nwg) { const long L2 = L - (long)((nwg + G - 1) / G) * G; if (L2 < 0 || L2 >= nsp) return false;
            const int ks = (int)(L2 % sS), un = (int)(L2 / sS); u.pm = sM0 + un % sNM; u.pn = un / sNM; u.k0 = ks * sKs; u.nt = sKs / BK; u.sp = ks; return true; }
        int wgid = (int)L; { const int q = nwg / NXCD, r = nwg % NXCD, xcd = wgid % NXCD, off = wgid / NXCD; wgid = (xcd < r ? xcd * (q + 1) : r * (q + 1) + (xcd - r) * q) + off; }
        const int nig = WGM * nN, gid = wgid / nig, fm = gid * WGM, wi = wgid - gid * nig;
        if (nM % WGM == 0) { u.pm = pm0 + fm + (wi & (WGM - 1)); u.pn = wi / WGM; }
        else { const int gsz = (nM - fm) < WGM ? (nM - fm) : WGM; u.pm = pm0 + fm + (wi % gsz); u.pn = wi / gsz; }
        u.k0 = 0; u.nt = ntK; u.sp = -1; return true;
    }
    __device__ __forceinline__ void a_ready(const Unit&) const {}
    __device__ __forceinline__ void done(const Unit&) const {}
};

__device__ __forceinline__ unsigned cvt_pk_bf16(float lo, float hi) { unsigned r; asm volatile("v_cvt_pk_bf16_f32 %0, %1, %2" : "=v"(r) : "v"(lo), "v"(hi)); return r; }
typedef float f32x2 __attribute__((ext_vector_type(2)));
template <class Epi, class Sched, bool ALIGN_EPI = false, bool SP2 = false>
__device__ __forceinline__ void gemm_phase(PG8_LAS unsigned char* lds, const Gemm g, const Sched& S, const Epi& E) {
    int tid_ = threadIdx.x; asm volatile("" : "+v"(tid_)); const int tid = tid_, wid = __builtin_amdgcn_readfirstlane(tid >> 6), lane = tid & 63, wr = wid >> 2, wc = wid & 3, fr = lane & 15, fq = lane >> 4;
    const int K = g.K;
    unsigned voffA[2], voffB[2];
#pragma unroll
    for (int i = 0; i < 2; ++i) { int R, C; stage_rc(tid * 16 + i * 8192, R, C); const int Rb = Epi::PERM ? ((R & ~31) + perm32(R & 31)) : R;
        voffA[i] = (unsigned)(R * K + C) * 2u; voffB[i] = (unsigned)(Rb * K + C) * 2u; }
    const size_t kstep = (size_t)(BK * 2);
    const size_t hstep = (size_t)HALF * K * 2;
    const size_t tstep = 2 * hstep;
    const unsigned ldsw = (unsigned)wid * 1024u;
    const int aoff = lds_byte(wr * 64 + fr, fq * 8), boff = lds_byte(wc * 32 + fr, fq * 8);
#define PG8_SA(b, h) (((b) * 2 + (h)) * HTB)
#define PG8_SB(b, h) ((4 + (b) * 2 + (h)) * HTB)
#define PG8_STAGE(bufoff, gbase, voff) do { _Pragma("unroll") for (int _i = 0; _i < 2; ++_i) \
        __builtin_amdgcn_global_load_lds((const unsigned*)((const char*)(gbase) + (voff)[_i]), (PG8_LAS unsigned*)(lds + (bufoff) + ldsw + _i * 8192), 16, 0, 0); } while (0)
#define PG8_LDA(dst, b, h) do { _Pragma("unroll") for (int m = 0; m < 4; ++m) _Pragma("unroll") for (int k = 0; k < 2; ++k) dst[m][k] = *(const PG8_LAS bf16x8*)(lds + PG8_SA(b, h) + aoff + m * 2048 + k * 1024); } while (0)
#define PG8_LDB(dst, b, h) do { _Pragma("unroll") for (int n = 0; n < 2; ++n) _Pragma("unroll") for (int k = 0; k < 2; ++k) dst[n][k] = *(const PG8_LAS bf16x8*)(lds + PG8_SB(b, h) + boff + n * 2048 + k * 1024); } while (0)
#define PG8_MMA(ai, bj, At, Bt) do { __builtin_amdgcn_s_setprio(1); _Pragma("unroll") for (int m = 0; m < 4; ++m) _Pragma("unroll") for (int n = 0; n < 2; ++n) _Pragma("unroll") for (int k = 0; k < 2; ++k) \
        acc[ai][bj][m][n] = __builtin_amdgcn_mfma_f32_16x16x32_bf16(Bt[n][k], At[m][k], acc[ai][bj][m][n], 0, 0, 0); __builtin_amdgcn_s_setprio(0); } while (0)
#define PG8_WAIT_V(n) asm volatile("s_waitcnt vmcnt(" #n ")" ::: "memory")
#define PG8_WAIT_L(n) asm volatile("s_waitcnt lgkmcnt(" #n ")" ::: "memory")
#define PG8_BAR __builtin_amdgcn_s_barrier()
#define PG8_SCHED __builtin_amdgcn_sched_barrier(0)
    Unit cur, nxt; int ui = 0;
    if (!S.next(0, cur)) return;
    f32x4 acc[2][2][4][2];
#pragma unroll
    for (int a = 0; a < 2; ++a)
#pragma unroll
        for (int b = 0; b < 2; ++b)
#pragma unroll
            for (int m = 0; m < 4; ++m)
#pragma unroll
                for (int n = 0; n < 2; ++n) acc[a][b][m][n] = (f32x4){0.f, 0.f, 0.f, 0.f};
    bf16x8 At[4][2], B0[2][2], B1[2][2];
    const char* cA = (const char*)g.A + (size_t)cur.pm * tstep + (size_t)cur.k0 * 2; const char* cB = (const char*)g.Bt + (size_t)cur.pn * tstep + (size_t)cur.k0 * 2;
    S.a_ready(cur);
    if constexpr (SP2) {
        PG8_STAGE(PG8_SB(0, 0), cB, voffB); PG8_STAGE(PG8_SB(0, 1), cB + hstep, voffB); PG8_STAGE(PG8_SA(0, 0), cA, voffA); PG8_STAGE(PG8_SA(0, 1), cA + hstep, voffA);
        if (wr == 1) PG8_BAR;
        PG8_WAIT_V(2); PG8_BAR;
        PG8_STAGE(PG8_SB(1, 0), cB + kstep, voffB); PG8_STAGE(PG8_SA(1, 0), cA + kstep, voffA); PG8_STAGE(PG8_SB(1, 1), cB + hstep + kstep, voffB);
        PG8_WAIT_V(6); PG8_BAR;
    } else {
        PG8_STAGE(PG8_SB(0, 0), cB, voffB); PG8_STAGE(PG8_SA(0, 0), cA, voffA); PG8_STAGE(PG8_SB(0, 1), cB + hstep, voffB); PG8_STAGE(PG8_SA(0, 1), cA + hstep, voffA);
        if (wr == 1) PG8_BAR;
        PG8_WAIT_V(4); PG8_BAR;
        PG8_STAGE(PG8_SB(1, 0), cB + kstep, voffB); PG8_STAGE(PG8_SA(1, 0), cA + kstep, voffA); PG8_STAGE(PG8_SB(1, 1), cB + hstep + kstep, voffB);
        PG8_WAIT_V(6); PG8_BAR;
    }
    for (;;) {
        const bool has_next = S.next(ui + 1, nxt);
        const char* nA = has_next ? (const char*)g.A + (size_t)nxt.pm * tstep + (size_t)nxt.k0 * 2 : cA; const char* nB = has_next ? (const char*)g.Bt + (size_t)nxt.pn * tstep + (size_t)nxt.k0 * 2 : cB;
        const int nt = cur.nt;
        for (int t = 0; t < nt; t += 2) {
            const bool last = (t == nt - 2);
            const char* a1 = cA + (size_t)(t + 1) * kstep;
            const char* a2 = last ? nA : cA + (size_t)(t + 2) * kstep; const char* b2 = last ? nB : cB + (size_t)(t + 2) * kstep;
            const char* a3 = a2 + kstep; const char* b3 = b2 + kstep;
            if (last && has_next) S.a_ready(nxt);
            if constexpr (SP2) {
            PG8_LDB(B0, 0, 0); PG8_LDB(B1, 0, 1); PG8_SCHED; PG8_LDA(At, 0, 0); PG8_STAGE(PG8_SA(1, 1), a1 + hstep, voffA);
            PG8_WAIT_V(8); PG8_WAIT_L(0); PG8_BAR; PG8_MMA(0, 0, At, B0); PG8_MMA(0, 1, At, B1); PG8_BAR; PG8_SCHED;
            PG8_LDA(At, 0, 1); PG8_STAGE(PG8_SB(0, 0), b2, voffB); PG8_STAGE(PG8_SB(0, 1), b2 + hstep, voffB); PG8_STAGE(PG8_SA(0, 0), a2, voffA);
            PG8_WAIT_V(8); PG8_WAIT_L(0); PG8_BAR; PG8_MMA(1, 0, At, B0); PG8_MMA(1, 1, At, B1); PG8_BAR; PG8_SCHED;
            PG8_LDB(B0, 1, 0); PG8_LDB(B1, 1, 1); PG8_SCHED; PG8_LDA(At, 1, 0); PG8_STAGE(PG8_SA(0, 1), a2 + hstep, voffA);
            PG8_WAIT_V(8); PG8_WAIT_L(0); PG8_BAR; PG8_MMA(0, 0, At, B0); PG8_MMA(0, 1, At, B1); PG8_BAR; PG8_SCHED;
            PG8_LDA(At, 1, 1); PG8_STAGE(PG8_SB(1, 0), b3, voffB); PG8_STAGE(PG8_SB(1, 1), b3 + hstep, voffB); PG8_STAGE(PG8_SA(1, 0), a3, voffA);
            PG8_WAIT_V(8); PG8_WAIT_L(0); PG8_BAR; PG8_MMA(1, 0, At, B0); PG8_MMA(1, 1, At, B1); PG8_BAR; PG8_SCHED;
            } else {
            PG8_LDB(B0, 0, 0); PG8_SCHED; PG8_LDA(At, 0, 0); PG8_STAGE(PG8_SA(1, 1), a1 + hstep, voffA);
            PG8_WAIT_L(8); PG8_BAR; PG8_WAIT_L(0); PG8_MMA(0, 0, At, B0); PG8_BAR; PG8_SCHED;
            PG8_LDB(B1, 0, 1); PG8_STAGE(PG8_SB(0, 0), b2, voffB);
            PG8_BAR; PG8_WAIT_L(0); PG8_MMA(0, 1, At, B1); PG8_BAR;
            PG8_LDA(At, 0, 1); PG8_STAGE(PG8_SA(0, 0), a2, voffA);
            PG8_BAR; PG8_WAIT_L(0); PG8_MMA(1, 0, At, B0); PG8_BAR; PG8_SCHED;
            PG8_STAGE(PG8_SB(0, 1), b2 + hstep, voffB);
            PG8_WAIT_V(6); PG8_BAR; PG8_MMA(1, 1, At, B1); PG8_BAR;
            PG8_LDB(B0, 1, 0); PG8_SCHED; PG8_LDA(At, 1, 0); PG8_STAGE(PG8_SA(0, 1), a2 + hstep, voffA);
            PG8_WAIT_L(8); PG8_BAR; PG8_WAIT_L(0); PG8_MMA(0, 0, At, B0); PG8_BAR; PG8_SCHED;
            PG8_LDB(B1, 1, 1); PG8_STAGE(PG8_SB(1, 0), b3, voffB);
            PG8_BAR; PG8_WAIT_L(0); PG8_MMA(0, 1, At, B1); PG8_BAR;
            PG8_LDA(At, 1, 1); PG8_STAGE(PG8_SA(1, 0), a3, voffA);
            PG8_BAR; PG8_WAIT_L(0); PG8_MMA(1, 0, At, B0); PG8_BAR; PG8_SCHED;
            PG8_STAGE(PG8_SB(1, 1), b3 + hstep, voffB);
            PG8_WAIT_V(6); PG8_BAR; PG8_MMA(1, 1, At, B1); PG8_BAR;
            }
        }
        if constexpr (ALIGN_EPI) { if (wr == 0) PG8_BAR; }
        if constexpr (!Epi::AFTER_DRAIN) { E(acc, cur, wr, wc, fr, fq); S.done(cur); }
        if (!has_next) break;
#pragma unroll
        for (int a = 0; a < 2; ++a)
#pragma unroll
            for (int b = 0; b < 2; ++b)
#pragma unroll
                for (int m = 0; m < 4; ++m)
#pragma unroll
                    for (int n = 0; n < 2; ++n) acc[a][b][m][n] = (f32x4){0.f, 0.f, 0.f, 0.f};
        cur = nxt; cA = nA; cB = nB; ++ui;
        if constexpr (ALIGN_EPI) { if (wr == 1) PG8_BAR; }
    }
    PG8_WAIT_V(0);
    if constexpr (!ALIGN_EPI) { if (wr == 0) PG8_BAR; }
    PG8_BAR;
    if constexpr (Epi::AFTER_DRAIN) { E.fused(acc, cur, wr, wc, fr, fq, lds, wid, lane); S.done(cur); }
#undef PG8_SA
#undef PG8_SB
#undef PG8_STAGE
#undef PG8_LDA
#undef PG8_LDB
#undef PG8_MMA
#undef PG8_WAIT_V
#undef PG8_WAIT_L
#undef PG8_BAR
#undef PG8_SCHED
}
}
#define LAS __attribute__((address_space(3)))
#define XB_TMO      128
#define XB_XCNT(j)  (256  + 64 * (j))
#define XB_XSUB(j)  (1280 + 64 * (j))
#define XB_XGEN(j)  (2304 + 64 * (j))
#define XB_TOP      3328
#define XB_TOPGEN   3392
#define XCD_BAR_WORDS 3456
#define XB_SPIN_CAP (1u << 18)

__device__ __forceinline__ unsigned xb_ld(unsigned* p)              { return __hip_atomic_load(p, __ATOMIC_RELAXED, __HIP_MEMORY_SCOPE_AGENT); }
__device__ __forceinline__ unsigned xb_add(unsigned* p, unsigned v) { return __hip_atomic_fetch_add(p, v, __ATOMIC_RELAXED, __HIP_MEMORY_SCOPE_AGENT); }
__device__ __forceinline__ unsigned xb_xcc_id() { return (unsigned)__builtin_amdgcn_s_getreg((3 << 11) | 20) & 0xFu; }
#define XB_SPIN(cond, bar) do { unsigned _sp = 0; while (cond) { __builtin_amdgcn_s_sleep(1); \
    if ((++_sp & 255u) == 0u) { if (xb_ld(&(bar)[XB_TMO])) break; if (_sp > XB_SPIN_CAP) { atomicAdd(&(bar)[XB_TMO], 1u); break; } } } } while (0)

struct XcdBarrier {
    unsigned* bar; unsigned x;
    volatile LAS unsigned* st;
};

__device__ __forceinline__ XcdBarrier xcd_barrier_post(unsigned* bar, volatile LAS unsigned* st) {
    XcdBarrier b; b.bar = bar; b.x = xb_xcc_id(); b.st = st;
    if (threadIdx.x == 0) (void)xb_add(&bar[XB_XCNT(b.x)], 1u);
    return b;
}
__device__ __forceinline__ void xcd_barrier_complete(unsigned* bar, unsigned x, unsigned& nloc, unsigned& nx) {
    const unsigned G = gridDim.x * gridDim.y * gridDim.z;
    unsigned sum, cnt, mine, sp = 0u;
    for (;;) {
        sum = 0u; cnt = 0u; mine = 0u;
#pragma unroll
        for (unsigned j = 0; j < 16; ++j) { const unsigned c = xb_ld(&bar[XB_XCNT(j)]); sum += c; cnt += (c > 0u) ? 1u : 0u; mine = (j == x) ? c : mine; }
        if (sum == G) break;
        __builtin_amdgcn_s_sleep(1);
        if ((++sp & 255u) == 0u) { if (xb_ld(&bar[XB_TMO])) break; if (sp > XB_SPIN_CAP) { atomicAdd(&bar[XB_TMO], 1u); break; } }
    }
    nloc = mine > 0u ? mine : 1u; nx = cnt > 0u ? cnt : 1u;
}

__device__ __forceinline__ void xcd_barrier(const XcdBarrier& b) {
    asm volatile("s_waitcnt vmcnt(0)" ::: "memory");
    __syncthreads();
    if (threadIdx.x == 0) {
        unsigned* bar = b.bar;
        __builtin_amdgcn_s_waitcnt(0);
        unsigned nloc = b.st[0], nx = b.st[1];
        if (nloc == 0u) { xcd_barrier_complete(bar, b.x, nloc, nx); b.st[0] = nloc; b.st[1] = nx; }
        const unsigned old = xb_add(&bar[XB_XSUB(b.x)], 1u);
        const unsigned gen = old / nloc;
        if (old + 1u == (gen + 1u) * nloc) {
            __builtin_amdgcn_fence(__ATOMIC_RELEASE, "agent");
            asm volatile("s_waitcnt vmcnt(0)" ::: "memory");
            const unsigned og = xb_add(&bar[XB_TOP], 1u);
            const unsigned tg = og / nx;
            if (og + 1u == (tg + 1u) * nx) xb_add(&bar[XB_TOPGEN], 1u);
            else XB_SPIN(xb_ld(&bar[XB_TOPGEN]) == tg, bar);
            __builtin_amdgcn_fence(__ATOMIC_ACQUIRE, "agent");
            xb_add(&bar[XB_XGEN(b.x)], 1u);
            asm volatile("s_waitcnt vmcnt(0)" ::: "memory");
        } else {
            XB_SPIN(xb_ld(&bar[XB_XGEN(b.x)]) == gen, bar);
            __builtin_amdgcn_fence(__ATOMIC_ACQUIRE, "agent");
            asm volatile("s_waitcnt vmcnt(0)" ::: "memory");
        }
    }
    __syncthreads();
}

using pg8::bf16_t; using pg8::bf16x8; using pg8::f32x4; using pg8::u32x4; using pg8::Unit;
typedef unsigned u32x2 __attribute__((ext_vector_type(2)));
typedef unsigned short u16;
constexpr int MP_ROWS = 32768;
constexpr int DM = 1024, MP = 32768, MS = 512, MT = MP + MS, SEQ = 8192;
constexpr float EPS = 1e-5f, LOG2E = 1.4426950408889634f, C2 = 0.125f * 1.4426950408889634f;
constexpr size_t MiB = 1u << 20;
constexpr size_t WS_SS = 492 * MiB, SS_SLOT = (size_t)MT * 16;
constexpr size_t WS_CTL = 0, CTL_BYTES = 131072;
constexpr size_t WS_SPK = 166 * MiB;
constexpr size_t WS_ROPE = 2 * MiB;
constexpr size_t WS_DB = 3 * MiB;
constexpr size_t WS_W = 6 * MiB;
constexpr size_t WS_XB = 100 * MiB;
constexpr size_t WS_POOL = 232 * MiB;
constexpr size_t ACT = (size_t)MT * DM * 2;
constexpr size_t WS_END = WS_POOL + 4 * ACT;
constexpr size_t OY = 0, OKP = 34078720, OVP = 34340864, OSP = 34603008, OKS = 35651584, OVS = 36175872, OSS = 36700160;
constexpr size_t WM = 1048576;
#ifndef NHALF
#define NHALF 1
#endif
constexpr int HROWS = MP_ROWS / NHALF;
struct Params { const float* in[17]; float* out; unsigned char* ws; int ph_lo, ph_hi; };
typedef const __attribute__((address_space(4))) Params* KP;
__device__ __forceinline__ KP kargs() { KP k = (KP)__builtin_amdgcn_kernarg_segment_ptr(); asm volatile("" : "+s"(k)); return k; }

__device__ __forceinline__ unsigned pkbf(float lo, float hi) { typedef float f2 __attribute__((ext_vector_type(2))); typedef __bf16 b2 __attribute__((ext_vector_type(2))); f2 v = {lo, hi}; b2 b = __builtin_convertvector(v, b2); return __builtin_bit_cast(unsigned, b); }
__device__ __forceinline__ float bflo(unsigned u) { return __uint_as_float(u << 16); }
__device__ __forceinline__ float bfhi(unsigned u) { return __uint_as_float(u & 0xffff0000u); }
__device__ __forceinline__ float bf2f(u16 u) { return __uint_as_float((unsigned)u << 16); }
__device__ __forceinline__ u16 f2bf(float f) { return (u16)(pkbf(f, 0.f) & 0xffffu); }
__device__ __forceinline__ unsigned pkh(float lo, float hi) { _Float16 a = (_Float16)lo, b = (_Float16)hi; return (unsigned)__builtin_bit_cast(u16, a) | ((unsigned)__builtin_bit_cast(u16, b) << 16); }
__device__ __forceinline__ f32x4 mfma16(bf16x8 a, bf16x8 b, f32x4 c) { return __builtin_amdgcn_mfma_f32_16x16x32_bf16(a, b, c, 0, 0, 0); }
__device__ __forceinline__ int row_pos(int r) { return r < MP ? (r & (SEQ - 1)) : 2048 + ((r - MP) & 63); }
__device__ __forceinline__ float row_rs(const float* ss, int r) { const f32x4* q = (const f32x4*)(ss + (size_t)r * 16); f32x4 a = q[0], b = q[1], c = q[2], d = q[3]; a = (a + b) + (c + d); return __builtin_amdgcn_rsqf(((a[0] + a[1]) + (a[2] + a[3])) * (1.f / 1024.f) + EPS); }
__device__ __forceinline__ float silu(float v) { return v * __builtin_amdgcn_rcpf(1.f + __builtin_amdgcn_exp2f(-1.4426950408889634f * v)); }

#ifndef COLPERM
#define COLPERM 1
#endif
#ifndef NT_STORE
#define NT_STORE 0
#endif
#if NT_STORE == 2
__device__ __forceinline__ void st16_wt(void* p, u32x4 v) { asm volatile("global_store_dwordx4 %0, %1, off sc0 sc1" :: "v"(p), "v"(v) : "memory"); }
#define ST16(p, v) st16_wt((void*)(p), (v))
#define ST8(p, v) (*(u32x2*)(p) = (v))
#define STF4(p, v) (*(f32x4*)(p) = (v))
#elif NT_STORE
#define ST16(p, v) __builtin_nontemporal_store((v), (u32x4*)(p))
#define ST8(p, v) __builtin_nontemporal_store((v), (u32x2*)(p))
#define STF4(p, v) __builtin_nontemporal_store((v), (f32x4*)(p))
#else
#define ST16(p, v) (*(u32x4*)(p) = (v))
#define ST8(p, v) (*(u32x2*)(p) = (v))
#define STF4(p, v) (*(f32x4*)(p) = (v))
#endif
#define EPI_ROW(idx) (u.pm * 256 + ((idx) >> 2) * 128 + wr * 64 + ((idx) & 3) * 16 + fr)
#define EPI_LOAD_RS(rsv, ss) float rsv[8]; { f32x4 pv_[8]; \
    _Pragma("unroll") for (int idx = 0; idx < 8; ++idx) pv_[idx] = *(const f32x4*)((ss) + (size_t)EPI_ROW(idx) * 16 + fq * 4); \
    _Pragma("unroll") for (int idx = 0; idx < 8; ++idx) { float s_ = (pv_[idx][0] + pv_[idx][1]) + (pv_[idx][2] + pv_[idx][3]); s_ += __shfl_xor(s_, 16); s_ += __shfl_xor(s_, 32); rsv[idx] = __builtin_amdgcn_rsqf(s_ * (1.f / 1024.f) + EPS); } }
struct EpiQKV {
    static constexpr bool PERM = true, AFTER_DRAIN = false;
    unsigned char* ws; float* out; int j, slot;
    __device__ __forceinline__ void operator()(const f32x4 (&acc)[2][2][4][2], const Unit& u, int wr, int wc, int fr, int fq, unsigned mask) const {
        const float* ss = (const float*)(ws + WS_SS) + (size_t)slot * SS_SLOT; const float* rope = (const float*)(ws + WS_ROPE);
        const int pn = u.pn; const bool rot = (pn <= 4) && ((wc & 1) == 0); const float qs = pn < 4 ? C2 : 1.f; const bool rl_ = rot && fq < 2;
        EPI_LOAD_RS(rsv, ss)
        const f32x4 one4 = {1.f, 1.f, 1.f, 1.f}, zero4 = {0.f, 0.f, 0.f, 0.f};
        f32x4 c0 = one4, c1 = one4, s0 = zero4, s1 = zero4, dc0 = one4, dc1 = one4, ds0 = zero4, ds1 = zero4;
        if (rl_) { const float* t = rope + row_pos(EPI_ROW(0)) * 16; c0 = *(const f32x4*)t; c1 = *(const f32x4*)(t + 4); s0 = *(const f32x4*)(t + 8); s1 = *(const f32x4*)(t + 12);
            const float* d = rope + 16 * 16; dc0 = *(const f32x4*)d; dc1 = *(const f32x4*)(d + 4); ds0 = *(const f32x4*)(d + 8); ds1 = *(const f32x4*)(d + 12); }
        const float sgn = fq == 0 ? -1.f : 1.f;
#pragma unroll
        for (int idx = 0; idx < 8; ++idx) {
            const int ai = idx >> 2, m = idx & 3;
            if (idx > 0) {
                const bool back = (idx == 4) && (u.pm >= 128);
                const float dsg = back ? -1.f : 1.f;
#pragma unroll 1
                for (int st_ = (idx == 4 ? (back ? 3 : 5) : 1); st_ > 0; --st_) { const f32x4 e0 = ds0 * dsg, e1 = ds1 * dsg; const f32x4 a0 = c0 * dc0 - s0 * e0, b0 = s0 * dc0 + c0 * e0, a1 = c1 * dc1 - s1 * e1, b1 = s1 * dc1 + c1 * e1; c0 = a0; s0 = b0; c1 = a1; s1 = b1; }
            }
            if (!((mask >> idx) & 1u)) continue;
            int rl = ai * 128 + wr * 64 + m * 16 + fr; asm volatile("" : "+v"(rl)); const int r = u.pm * 256 + rl;
            const float rs = rsv[idx];
            const f32x4 sn0 = s0 * sgn, sn1 = s1 * sgn;
            float* nk = nullptr;
            if (pn >= 4) {
                if (u.pm < 128) { const int t = (u.pm & 31) * 256 + rl; if (t >= 8064) nk = out + (pn == 4 ? OKP : OVP) + ((size_t)((j * 4 + (u.pm >> 5)) * 128 + (t - 8064))) * 256; }
                else { const int rr = r - MP; nk = out + (pn == 4 ? OKS : OVS) + ((size_t)((j * 8 + (rr >> 6)) * 128 + 64 + (rr & 63))) * 256; }
            }
#pragma unroll
            for (int bj = 0; bj < 2; ++bj) {
                f32x4 v0 = acc[ai][bj][m][0] * rs, v1 = acc[ai][bj][m][1] * rs;
                if (rot) {
                    f32x4 p0, p1;
#pragma unroll
                    for (int e = 0; e < 4; ++e) { p0[e] = __shfl_xor(v0[e], 16); p1[e] = __shfl_xor(v1[e], 16); }
                    v0 = v0 * c0 + p0 * sn0; v1 = v1 * c1 + p1 * sn1;
                }
                v0 = v0 * qs; v1 = v1 * qs;
                const int cw = bj * 128 + wc * 32 + 8 * fq;
                bf16_t* dst = pn < 4 ? (bf16_t*)(ws + WS_POOL) + (size_t)r * 1024 + pn * 256 + cw : (bf16_t*)(ws + WS_POOL + 2 * ACT) + (pn == 4 ? (size_t)0 : (size_t)MT * 256) + (size_t)r * 256 + cw;
                u32x4 w; w.x = pkbf(v0[0], v0[1]); w.y = pkbf(v0[2], v0[3]); w.z = pkbf(v1[0], v1[1]); w.w = pkbf(v1[2], v1[3]);
                ST16(dst, w);
                if (nk) { *(f32x4*)(nk + cw) = v0; *(f32x4*)(nk + cw + 4) = v1; }
            }
        }
    }
};
struct EpiRes {
    static constexpr bool PERM = true, AFTER_DRAIN = false;
    bf16_t* XB; float* ssn;
    __device__ __forceinline__ void operator()(const f32x4 (&acc)[2][2][4][2], const Unit& u, int wr, int wc, int fr, int fq, unsigned mask) const {
        const int col0 = u.pn * 256 + wc * 32 + 8 * fq;
        u32x4 xin[8][2];
#pragma unroll
        for (int idx = 0; idx < 8; ++idx) { const bf16_t* xp = XB + (size_t)EPI_ROW(idx) * 1024 + col0; xin[idx][0] = *(const u32x4*)xp; xin[idx][1] = *(const u32x4*)(xp + 128); }
#pragma unroll
        for (int idx = 0; idx < 8; ++idx) {
            const int ai = idx >> 2, m = idx & 3;
            if (!((mask >> idx) & 1u)) continue;
            int r = EPI_ROW(idx); asm volatile("" : "+v"(r)); bf16_t* xo = XB + (size_t)r * 1024 + col0; float sq = 0.f;
#pragma unroll
            for (int bj = 0; bj < 2; ++bj) { const u32x4 cx = xin[idx][bj]; const f32x4 a0 = acc[ai][bj][m][0], a1 = acc[ai][bj][m][1]; u32x4 w;
                w.x = pkbf(bflo(cx.x) + a0[0], bfhi(cx.x) + a0[1]); w.y = pkbf(bflo(cx.y) + a0[2], bfhi(cx.y) + a0[3]); w.z = pkbf(bflo(cx.z) + a1[0], bfhi(cx.z) + a1[1]); w.w = pkbf(bflo(cx.w) + a1[2], bfhi(cx.w) + a1[3]);
                ST16(xo + bj * 128, w);
#pragma unroll
                for (int e = 0; e < 4; ++e) { const float lo = bflo(w[e]), hi = bfhi(w[e]); sq += lo * lo + hi * hi; } }
            sq += __shfl_xor(sq, 16); sq += __shfl_xor(sq, 32);
            if (fq == 0) ssn[(size_t)r * 16 + u.pn * 4 + wc] = sq;
        }
    }
};
struct EpiUp {
    static constexpr bool PERM = true, AFTER_DRAIN = false;
    const float* ss; bf16_t* H; int rowmask;
    __device__ __forceinline__ void operator()(const f32x4 (&acc)[2][2][4][2], const Unit& u, int wr, int wc, int fr, int fq, unsigned mask) const {
        EPI_LOAD_RS(rsv, ss)
#pragma unroll
        for (int idx = 0; idx < 8; ++idx) {
            const int ai = idx >> 2, m = idx & 3;
            if (!((mask >> idx) & 1u)) continue;
            int r = EPI_ROW(idx); asm volatile("" : "+v"(r)); const float rs = rsv[idx];
#pragma unroll
            for (int bj = 0; bj < 2; ++bj) {
                f32x4 v0 = acc[ai][bj][m][0] * rs, v1 = acc[ai][bj][m][1] * rs;
#pragma unroll
                for (int e = 0; e < 4; ++e) { const float a = fmaxf(v0[e], 0.f), b = fmaxf(v1[e], 0.f); v0[e] = a * a; v1[e] = b * b; }
                u32x4 w; w.x = pkbf(v0[0], v0[1]); w.y = pkbf(v0[2], v0[3]); w.z = pkbf(v1[0], v1[1]); w.w = pkbf(v1[2], v1[3]);
                if (rowmask == 0x7ffffffe) ST16(H + ((size_t)(u.pm * 16 + u.pn) * 65536 + (size_t)(r & 255) * 256) + (COLPERM ? wc * 64 + bj * 32 : bj * 128 + wc * 32) + 8 * fq, w);
                else ST16(H + (size_t)(r & rowmask) * 4096 + u.pn * 256 + (COLPERM ? wc * 64 + bj * 32 : bj * 128 + wc * 32) + 8 * fq, w);
            }
        }
    }
};
struct EpiHin {
    static constexpr bool PERM = true, AFTER_DRAIN = false;
    const float* ss; u16* base;
    __device__ __forceinline__ void operator()(const f32x4 (&acc)[2][2][4][2], const Unit& u, int wr, int wc, int fr, int fq, unsigned mask) const {
        const int sel = u.pn >> 2; u16* ob = base + (size_t)sel * (ACT / 2);
        EPI_LOAD_RS(rsv, ss)
#pragma unroll
        for (int idx = 0; idx < 8; ++idx) {
            const int ai = idx >> 2, m = idx & 3;
            if (!((mask >> idx) & 1u)) continue;
            int r = EPI_ROW(idx); asm volatile("" : "+v"(r)); const float rs = rsv[idx];
#pragma unroll
            for (int bj = 0; bj < 2; ++bj) {
                f32x4 v0 = acc[ai][bj][m][0] * rs, v1 = acc[ai][bj][m][1] * rs; u32x4 w;
                if (sel == 1) { w.x = pkh(v0[0], v0[1]); w.y = pkh(v0[2], v0[3]); w.z = pkh(v1[0], v1[1]); w.w = pkh(v1[2], v1[3]); }
                else {
                    if (sel != 2) {
#pragma unroll
                        for (int e = 0; e < 4; ++e) { v0[e] = silu(v0[e]); v1[e] = silu(v1[e]); }
                    }
                    w.x = pkbf(v0[0], v0[1]); w.y = pkbf(v0[2], v0[3]); w.z = pkbf(v1[0], v1[1]); w.w = pkbf(v1[2], v1[3]);
                }
                ST16(ob + (size_t)r * 1024 + (u.pn & 3) * 256 + (COLPERM ? wc * 64 + bj * 32 : bj * 128 + wc * 32) + 8 * fq, w);
            }
        }
    }
};

template <class Epi> struct EpiMix {
    static constexpr bool PERM = Epi::PERM, AFTER_DRAIN = false;
    Epi E; float* P; unsigned* cnt; int S, m0, nm; unsigned pmask;
    __device__ __forceinline__ void operator()(f32x4 (&acc)[2][2][4][2], const Unit& u, int wr, int wc, int fr, int fq) const {
        unsigned mask = pmask;
        if (u.sp >= 0 && pmask == 0u) return;
        if (u.sp >= 0) {
            const int wid = wr * 4 + wc, lane = fq * 16 + fr, tile = (u.pm - m0) + nm * u.pn;
            float* pw = P + ((size_t)(tile * S + u.sp) * 8 + wid) * 8192 + lane * 4;
#pragma unroll
            for (int i = 0; i < 32; ++i) *(f32x4*)(pw + i * 256) = acc[i >> 4][(i >> 3) & 1][(i >> 1) & 3][i & 1];
            __builtin_amdgcn_fence(__ATOMIC_RELEASE, "agent");
            unsigned* cw = cnt + tile * 8 + wid;
            if (lane == 0) (void)__hip_atomic_fetch_add(cw, 1u, __ATOMIC_RELAXED, __HIP_MEMORY_SCOPE_AGENT);
            { unsigned sp_ = 0; while ((unsigned)__builtin_amdgcn_readfirstlane((int)__hip_atomic_load(cw, __ATOMIC_RELAXED, __HIP_MEMORY_SCOPE_AGENT)) < (unsigned)S) { __builtin_amdgcn_s_sleep(2); if (++sp_ > (1u << 22)) break; } }
            __builtin_amdgcn_fence(__ATOMIC_ACQUIRE, "agent");
            mask = S == 8 ? (1u << u.sp) : (3u << (2 * u.sp));
            const float* pr = P + ((size_t)(tile * S) * 8 + wid) * 8192 + lane * 4;
#pragma unroll
            for (int c = 0; c < 8; ++c) if ((mask >> c) & 1u) {
                f32x4 t0 = {0.f, 0.f, 0.f, 0.f}, t1 = t0, t2 = t0, t3 = t0; const int i0 = (c >> 2) * 16 + (c & 3) * 2;
#pragma unroll 2
                for (int s = 0; s < S; ++s) { const float* ps = pr + (size_t)s * 8 * 8192 + i0 * 256;
                    t0 += *(const f32x4*)(ps); t1 += *(const f32x4*)(ps + 256); t2 += *(const f32x4*)(ps + 8 * 256); t3 += *(const f32x4*)(ps + 9 * 256); }
                acc[c >> 2][0][c & 3][0] = t0; acc[c >> 2][0][c & 3][1] = t1; acc[c >> 2][1][c & 3][0] = t2; acc[c >> 2][1][c & 3][1] = t3;
            }
        }
        E(acc, u, wr, wc, fr, fq, mask);
    }
};

__device__ __forceinline__ int colperm(int a) { return (a & ~255) | (((a >> 5) & 1) << 7) | (((a >> 6) & 3) << 5) | (a & 31); }
__device__ __forceinline__ void p0_transpose_item(const float* W, const float* g, int K, int N, bf16_t* WT, float* scr, int item, int lane, bool perm) {
    const int nblk = N / 32, kb = item / nblk, nb = item % nblk, k0 = 64 * kb, n0 = 32 * nb;
    float wv[32];
#pragma unroll
    for (int i = 0; i < 32; ++i) { const int kk = 2 * i + (lane >> 5); wv[i] = W[(size_t)(k0 + kk) * N + n0 + (lane & 31)]; }
#pragma unroll
    for (int i = 0; i < 32; ++i) { const int kk = 2 * i + (lane >> 5); const float gs = g ? g[k0 + kk] : 1.f; scr[kk * 33 + (lane & 31)] = wv[i] * gs; }
    asm volatile("s_waitcnt lgkmcnt(0)" ::: "memory");
    const int c = lane & 7;
#pragma unroll
    for (int jj = 0; jj < 4; ++jj) { const int n = (lane >> 3) + 8 * jj; const float* s = scr + (8 * c) * 33 + n;
        u32x4 o; o.x = pkbf(s[0 * 33], s[1 * 33]); o.y = pkbf(s[2 * 33], s[3 * 33]); o.z = pkbf(s[4 * 33], s[5 * 33]); o.w = pkbf(s[6 * 33], s[7 * 33]);
        *(u32x4*)(WT + (size_t)(perm ? colperm(n0 + n) : n0 + n) * K + k0 + 8 * c) = o; }
    asm volatile("s_waitcnt lgkmcnt(0)" ::: "memory");
}
__device__ __forceinline__ size_t wlayer_base(int layer) { return layer == 0 ? 0 : layer == 1 ? (size_t)(10.5 * WM) : layer == 2 ? (size_t)(23.5 * WM) : (size_t)(34 * WM); }
__device__ __forceinline__ size_t wmat_off(int layer, int which) {
    const size_t b = wlayer_base(layer);
    if (layer & 1) return b + (which == 0 ? 0 : which == 1 ? 4 * WM : which == 2 ? 5 * WM : 9 * WM);
    return b + (which == 0 ? 0 : which == 1 ? (size_t)(1.5 * WM) : which == 2 ? (size_t)(2.5 * WM) : (size_t)(6.5 * WM));
}
__device__ __forceinline__ void prologue(KP pk, char* lds, int vcu, int G) {
    int tid_ = threadIdx.x; asm volatile("" : "+v"(tid_)); const int tid = tid_, lane = tid & 63, w = __builtin_amdgcn_readfirstlane(tid >> 6);
    const int gw = vcu * 8 + w, NGW = G * 8, gt = vcu * 512 + tid, NTH = G * 512;
    float* scr = (float*)(lds + w * 16384);
    bf16_t* WB = (bf16_t*)(pk->ws + WS_W);
    for (int it = gw; it < 24064; it += NGW) {
        int layer, r;
        if (it < 5376) { layer = 0; r = it; } else if (it < 12032) { layer = 1; r = it - 5376; } else if (it < 17408) { layer = 2; r = it - 12032; } else { layer = 3; r = it - 17408; }
        const int j = layer >> 1; const int n0 = (layer & 1) ? 2048 : 768; int which;
        if (r < n0) which = 0; else if (r < n0 + 512) { which = 1; r -= n0; } else if (r < n0 + 2560) { which = 2; r -= n0 + 512; } else { which = 3; r -= n0 + 2560; }
        const float* W; const float* g = nullptr; int K = 1024, N = 1024;
        if (which == 0) { g = pk->in[5] + layer * 1024; if (layer & 1) { W = pk->in[10] + (size_t)j * 4 * WM; N = 4096; } else { W = pk->in[7] + (size_t)j * 1536 * 1024; N = 1536; } }
        else if (which == 1) { W = ((layer & 1) ? pk->in[13] : pk->in[8]) + (size_t)j * WM; }
        else if (which == 2) { W = pk->in[14] + (size_t)layer * 4 * WM; g = pk->in[6] + layer * 1024; N = 4096; }
        else { W = pk->in[15] + (size_t)layer * 4 * WM; K = 4096; }
        p0_transpose_item(W, g, K, N, WB + wmat_off(layer, which), scr, r, lane, COLPERM && (which == 2 || (which == 0 && (layer & 1))));
    }
    bf16_t* XB = (bf16_t*)(pk->ws + WS_XB); float* ss0 = (float*)(pk->ws + WS_SS);
    for (int r0 = gw; r0 < MT; r0 += 2 * NGW) {
        const int r1 = r0 + NGW; const bool has1 = r1 < MT; const int rr[2] = {r0, has1 ? r1 : r0};
        f32x4 v[2][4];
#pragma unroll
        for (int t = 0; t < 2; ++t) { const int r = rr[t]; const float* src = r < MP ? pk->in[0] + (size_t)r * 1024 : pk->in[1] + (size_t)(r - MP) * 1024;
#pragma unroll
            for (int q = 0; q < 4; ++q) v[t][q] = *(const f32x4*)(src + 256 * q + 4 * lane); }
#pragma unroll
        for (int t = 0; t < 2; ++t) { const int r = rr[t]; float s = 0.f;
            if (t == 1 && !has1) break;
#pragma unroll
            for (int q = 0; q < 4; ++q) { u32x2 o; o.x = pkbf(v[t][q][0], v[t][q][1]); o.y = pkbf(v[t][q][2], v[t][q][3]); *(u32x2*)(XB + (size_t)r * 1024 + 256 * q + 4 * lane) = o;
                const float a = bflo(o.x), b = bfhi(o.x), c = bflo(o.y), d = bfhi(o.y); s += (a * a + b * b) + (c * c + d * d); }
#pragma unroll
            for (int o = 1; o < 64; o <<= 1) s += __shfl_xor(s, o);
            if (lane < 16) ss0[(size_t)r * 16 + lane] = lane == 0 ? s : 0.f; }
    }
    { u32x4* ctl = (u32x4*)(pk->ws + WS_CTL); const u32x4 z = {0u, 0u, 0u, 0u}; for (int e = gt; e < (int)(CTL_BYTES / 16); e += NTH) ctl[e] = z; }
    float* rope = (float*)(pk->ws + WS_ROPE);
    for (int e = gt; e < 65536; e += NTH) { const int pos = e >> 3, i = e & 7; const float inv = exp2f(-(float)i * 2.3664460711655217f); const float ang = (float)pos * inv;
        const double rev = (double)ang * 0.15915494309189535; const float fr = (float)(rev - __builtin_rint(rev));
        rope[pos * 16 + i] = __builtin_amdgcn_cosf(fr); rope[pos * 16 + 8 + i] = __builtin_amdgcn_sinf(fr); }
    for (int e = gt; e < 65536; e += NTH) { const int jj = e >> 15, rem = e & 32767, sb = rem >> 12, row = (rem >> 6) & 63, c4 = rem & 63;
        const size_t so = ((size_t)((jj * 8 + sb) * 128 + 64 + row)) * 256 + 4 * c4, dof = ((size_t)((jj * 8 + sb) * 128 + row)) * 256 + 4 * c4;
        *(f32x4*)(pk->out + OKS + dof) = *(const f32x4*)(pk->in[2] + so); *(f32x4*)(pk->out + OVS + dof) = *(const f32x4*)(pk->in[3] + so); }
}

__device__ __forceinline__ void attn_phase(KP pk, char* lds, int j, int vcu, int G) {
    int tid_ = threadIdx.x; asm volatile("" : "+v"(tid_)); const int tid = tid_, lane = tid & 63, w = __builtin_amdgcn_readfirstlane(tid >> 6), l15 = lane & 15, q4 = lane >> 4;
    bf16_t* Ks = (bf16_t*)lds; bf16_t* Vt = (bf16_t*)(lds + 27648);
    const bf16_t* Qb = (const bf16_t*)(pk->ws + WS_POOL); bf16_t* Ob = (bf16_t*)(pk->ws + WS_POOL + ACT);
    const bf16_t* Kb = (const bf16_t*)(pk->ws + WS_POOL + 2 * ACT); const bf16_t* Vb = Kb + (size_t)MT * 256;
    const float* ck = pk->in[2] + (size_t)j * 8 * 128 * 256; const float* cv = pk->in[3] + (size_t)j * 8 * 128 * 256; const float* sinks = pk->in[9] + j * 16;
    for (int unit = vcu; unit < 2080; unit += G) {
        int qrow0, kvh, kt0, sb = -1;
        if (unit < 2048) { const int b = unit >> 9, c = (unit >> 2) & 127; kvh = unit & 3; qrow0 = b * 8192 + c * 64; kt0 = c >= 2 ? 0 : (c == 1 ? 4 : 8); }
        else { const int u2 = unit - 2048; sb = u2 >> 2; kvh = u2 & 3; qrow0 = MP + sb * 64; kt0 = 0; }
        __syncthreads();
#pragma unroll
        for (int i = 0; i < 3; ++i) { const int ch = tid + 512 * i, key = ch >> 3, dc = ch & 7; u32x4 kv = {0u, 0u, 0u, 0u}, vv = kv;
            if (key >= 16 * kt0) {
                if (sb >= 0 && key < 128) { const size_t so = ((size_t)(sb * 128 + key) * 4 + kvh) * 64 + 8 * dc;
                    const f32x4 a = *(const f32x4*)(ck + so), b = *(const f32x4*)(ck + so + 4), c = *(const f32x4*)(cv + so), d = *(const f32x4*)(cv + so + 4);
                    kv.x = pkbf(a[0], a[1]); kv.y = pkbf(a[2], a[3]); kv.z = pkbf(b[0], b[1]); kv.w = pkbf(b[2], b[3]);
                    vv.x = pkbf(c[0], c[1]); vv.y = pkbf(c[2], c[3]); vv.z = pkbf(d[0], d[1]); vv.w = pkbf(d[2], d[3]); }
                else { const size_t so = (size_t)(qrow0 - 128 + key) * 256 + kvh * 64 + 8 * dc; kv = *(const u32x4*)(Kb + so); vv = *(const u32x4*)(Vb + so); }
            }
            *(u32x4*)(Ks + key * 72 + 8 * dc) = kv;
#pragma unroll
            for (int e = 0; e < 8; ++e) Vt[(8 * dc + e) * 200 + ((((key >> 3) ^ dc) << 3) | (key & 7))] = (u16)(vv[e >> 1] >> (16 * (e & 1)));
        }
        __syncthreads();
#pragma unroll 1
        for (int qt = 0; qt < 2; ++qt) {
            const int qi = 2 * w + qt, g = qi >> 2, t0 = 16 * (qi & 3), head = kvh * 4 + g;
            const bf16_t* qp = Qb + (size_t)(qrow0 + t0 + l15) * 1024 + head * 64 + 8 * q4;
            const bf16x8 qf0 = *(const bf16x8*)qp, qf1 = *(const bf16x8*)(qp + 32);
            f32x4 s[12]; const float sink2 = sinks[head] * LOG2E; float mx = sink2;
#pragma unroll
            for (int kt = 0; kt < 12; ++kt) { const bf16_t* kp = Ks + (16 * kt + l15) * 72 + 8 * q4;
                f32x4 a = {0.f, 0.f, 0.f, 0.f}; a = mfma16(*(const bf16x8*)kp, qf0, a); a = mfma16(*(const bf16x8*)(kp + 32), qf1, a);
                if (kt < kt0) a = (f32x4){-INFINITY, -INFINITY, -INFINITY, -INFINITY};
                s[kt] = a; mx = fmaxf(fmaxf(mx, fmaxf(a[0], a[1])), fmaxf(a[2], a[3])); if ((kt & 3) == 3) asm volatile("" ::: "memory"); }
            mx = fmaxf(mx, __shfl_xor(mx, 16)); mx = fmaxf(mx, __shfl_xor(mx, 32));
            float ls = 0.f;
#pragma unroll
            for (int kt = 0; kt < 12; ++kt)
#pragma unroll
                for (int e = 0; e < 4; ++e) { const float pe = __builtin_amdgcn_exp2f(s[kt][e] - mx); s[kt][e] = pe; ls += pe; }
            ls += __shfl_xor(ls, 16); ls += __shfl_xor(ls, 32); ls += __builtin_amdgcn_exp2f(sink2 - mx);
            const float rl = __builtin_amdgcn_rcpf(ls);
            f32x4 o[4];
#pragma unroll
            for (int dt = 0; dt < 4; ++dt) o[dt] = (f32x4){0.f, 0.f, 0.f, 0.f};
#pragma unroll
            for (int kp = 0; kp < 6; ++kp) { u32x4 pw; pw.x = pkbf(s[2 * kp][0], s[2 * kp][1]); pw.y = pkbf(s[2 * kp][2], s[2 * kp][3]); pw.z = pkbf(s[2 * kp + 1][0], s[2 * kp + 1][1]); pw.w = pkbf(s[2 * kp + 1][2], s[2 * kp + 1][3]);
                const bf16x8 pf = __builtin_bit_cast(bf16x8, pw);
#pragma unroll
                for (int dt = 0; dt < 4; ++dt) { const int vd = 16 * dt + l15, vsw = (vd >> 3) & 7, vc0 = 4 * kp + (q4 >> 1); const bf16_t* vrow = Vt + vd * 200 + 4 * (q4 & 1); const u32x2 lo = *(const u32x2*)(vrow + ((vc0 ^ vsw) << 3)), hi = *(const u32x2*)(vrow + (((vc0 + 2) ^ vsw) << 3));
                    u32x4 aw; aw.x = lo.x; aw.y = lo.y; aw.z = hi.x; aw.w = hi.y; o[dt] = mfma16(__builtin_bit_cast(bf16x8, aw), pf, o[dt]); } if (kp & 1) asm volatile("" ::: "memory"); }
            bf16_t* stg = (bf16_t*)(lds + 53248) + w * 1152;
#pragma unroll
            for (int dt = 0; dt < 4; ++dt) { u32x2 ow; ow.x = pkbf(o[dt][0] * rl, o[dt][1] * rl); ow.y = pkbf(o[dt][2] * rl, o[dt][3] * rl); *(u32x2*)(stg + l15 * 72 + 16 * dt + 4 * q4) = ow; }
            asm volatile("s_waitcnt lgkmcnt(0)" ::: "memory");
#pragma unroll
            for (int i = 0; i < 2; ++i) { const int row = 8 * i + (lane >> 3), chn = lane & 7; *(u32x4*)(Ob + (size_t)(qrow0 + t0 + row) * 1024 + head * 64 + 8 * chn) = *(const u32x4*)(stg + row * 72 + 8 * chn); }
            asm volatile("s_waitcnt lgkmcnt(0)" ::: "memory");
        }
    }
}

__device__ __forceinline__ void hgrn_item(int it, int& m0, int& h) { if (it < 4096) { h = it & 7; m0 = (it >> 10) * 8192 + ((it >> 3) & 127) * 64; } else { const int x = it - 4096; h = x & 7; m0 = MP + (x >> 3) * 64; } }
constexpr int HL_ZS = 0, HL_TOT = 16384, HL_KT = 18432, HL_VT = 36864, HL_QS = 55296, HL_KS = 72704, HL_ST = 90112, HL_SSQ = 124928;

#define HGRN_STAGE_ZV() \
    _Pragma("unroll") for (int i = 0; i < 2; ++i) { const int ch = tid + 512 * i, row = ch >> 4, cc = ch & 15; \
        *(u32x4*)(ZS + row * 128 + 8 * cc) = zfr[i]; const u32x4 vv = vr[i]; \
        _Pragma("unroll") for (int e = 0; e < 8; ++e) VT[(8 * cc + e) * 72 + ((((row >> 3) ^ (cc & 7)) << 3) | (row & 7))] = (u16)(vv[e >> 1] >> (16 * (e & 1))); }
#define HGRN_GATES() \
    float kk[16], bl[16]; float cum = 0.f; \
    _Pragma("unroll") for (int i = 0; i < 16; ++i) { const float z = fminf(fmaxf((float)ZS[(16 * seg + i) * 128 + k], -30.f), 30.f); const float ez = __builtin_amdgcn_exp2f(-1.4426950408889634f * z), sg = __builtin_amdgcn_rcpf(1.f + ez); cum += __builtin_amdgcn_logf(lbv + oml * sg); bl[i] = cum; kk[i] = oml * ez * sg; } \
    TOT[seg * 128 + k] = cum; \
    __syncthreads(); \
    const float t0_ = TOT[k], t1_ = TOT[128 + k], t2_ = TOT[256 + k], t3_ = TOT[384 + k]; \
    const float off = seg == 0 ? 0.f : seg == 1 ? t0_ : seg == 2 ? t0_ + t1_ : t0_ + t1_ + t2_; const float b31 = t0_ + t1_;

__device__ __forceinline__ void hgrn_passA(KP pk, char* lds, int j, int vcu, int G, bool dost) {
    int tid_ = threadIdx.x; asm volatile("" : "+v"(tid_)); const int tid = tid_, lane = tid & 63, w = __builtin_amdgcn_readfirstlane(tid >> 6), l15 = lane & 15, q4 = lane >> 4, k = tid & 127, seg = tid >> 7;
    _Float16* ZS = (_Float16*)(lds + HL_ZS); float* TOT = (float*)(lds + HL_TOT); bf16_t* KT = (bf16_t*)(lds + HL_KT); bf16_t* VT = (bf16_t*)(lds + HL_VT);
    const u16* ZF = (const u16*)(pk->ws + WS_POOL + ACT); const u16* VH = (const u16*)(pk->ws + WS_POOL + 2 * ACT);
    bf16_t* UB = (bf16_t*)(pk->out + OY); float* DB = (float*)(pk->ws + WS_DB);
    float lbv = 0.f, oml = 1.f; int hprev = -1;
    u32x4 zfr[2], vr[2];
#define PA_LOAD(itx) { int m0_, h_; hgrn_item(itx, m0_, h_); _Pragma("unroll") for (int i = 0; i < 2; ++i) { const int ch = tid + 512 * i; const size_t go = (size_t)(m0_ + (ch >> 4)) * 1024 + h_ * 128 + 8 * (ch & 15); zfr[i] = *(const u32x4*)(ZF + go); vr[i] = *(const u32x4*)(VH + go); } }
    if (vcu < 4160) PA_LOAD(vcu)
    for (int it = vcu; it < 4160; it += G) {
        int m0, h; hgrn_item(it, m0, h);
        if (j == 1 && h != hprev) { const float a = pk->in[11][h * 128 + k], b = pk->in[11][1024 + h * 128 + k]; lbv = 1.f / (1.f + __expf(a - b)); oml = 1.f - lbv; hprev = h; }
        __syncthreads();
        HGRN_STAGE_ZV()
        if (it + G < 4160) PA_LOAD(it + G)
        __syncthreads();
        HGRN_GATES()
        { u32x4 w0, w1; unsigned wk[8];
#pragma unroll
          for (int i = 0; i < 8; ++i) wk[i] = pkbf(kk[2 * i] * __builtin_amdgcn_exp2f(b31 - (off + bl[2 * i])), kk[2 * i + 1] * __builtin_amdgcn_exp2f(b31 - (off + bl[2 * i + 1])));
          w0.x = wk[0]; w0.y = wk[1]; w0.z = wk[2]; w0.w = wk[3]; w1.x = wk[4]; w1.y = wk[5]; w1.z = wk[6]; w1.w = wk[7];
          *(u32x4*)(KT + k * 72 + 16 * seg) = w0; *(u32x4*)(KT + k * 72 + 16 * seg + 8) = w1; }
        if (seg == 0) DB[(size_t)it * 128 + k] = __builtin_amdgcn_exp2f(b31 + t2_ + t3_);
        __syncthreads();
        const int kr = 16 * w + l15;
        const bf16x8 b0 = *(const bf16x8*)(KT + kr * 72 + 8 * q4), b1 = *(const bf16x8*)(KT + kr * 72 + 32 + 8 * q4);
        const float sc = __builtin_amdgcn_exp2f(TOT[256 + kr] + TOT[384 + kr]);
        bf16_t* stg = (bf16_t*)(lds + HL_QS) + w * 2176;
#pragma unroll
        for (int vt = 0; vt < 8; ++vt) { const int vv_ = 16 * vt + l15, vsw = (vv_ >> 3) & 7; const bf16_t* vp = VT + vv_ * 72; f32x4 a = {0.f, 0.f, 0.f, 0.f};
            a = mfma16(*(const bf16x8*)(vp + ((q4 ^ vsw) << 3)), b0, a); a = mfma16(*(const bf16x8*)(vp + (((4 + q4) ^ vsw) << 3)), b1, a);
            u32x2 ow; ow.x = pkbf(a[0] * sc, a[1] * sc); ow.y = pkbf(a[2] * sc, a[3] * sc); *(u32x2*)(stg + l15 * 136 + 16 * vt + 4 * q4) = ow; }
        asm volatile("s_waitcnt lgkmcnt(0)" ::: "memory");
        { bf16_t* up = UB + (size_t)it * 16384 + (16 * w) * 128;
#pragma unroll
          for (int i = 0; i < 4; ++i) { const int row = 4 * i + (lane >> 4), chn = lane & 15; if (dost) *(u32x4*)(up + row * 128 + 8 * chn) = *(const u32x4*)(stg + row * 136 + 8 * chn); } }
    }
#undef PA_LOAD
}
__device__ __forceinline__ void hgrn_passB(KP pk, int j, int G, bool dost) {
    int tid_ = threadIdx.x; asm volatile("" : "+v"(tid_)); const int gt = blockIdx.x * 512 + tid_, NTH = G * 512;
    bf16_t* UB = (bf16_t*)(pk->out + OY); const float* DB = (const float*)(pk->ws + WS_DB);
    for (int e = gt; e < 131072; e += NTH) {
        const int bh = e >> 12, k = (e >> 5) & 127, v4 = e & 31, b = bh >> 3, h = bh & 7;
        f32x4 S = {0.f, 0.f, 0.f, 0.f};
        bf16_t* ub = UB + (size_t)(b * 1024 + h) * 16384 + k * 128 + 4 * v4; const float* db = DB + (size_t)(b * 1024 + h) * 128 + k;
#pragma unroll 1
        for (int c0 = 0; c0 < 128; c0 += 8) {
            u32x2 uu[8]; float d[8];
#pragma unroll
            for (int i = 0; i < 8; ++i) { uu[i] = *(const u32x2*)(ub + (size_t)(c0 + i) * 8 * 16384); d[i] = db[(size_t)(c0 + i) * 1024]; }
#pragma unroll
            for (int i = 0; i < 8; ++i) { u32x2 sw; sw.x = pkbf(S[0], S[1]); sw.y = pkbf(S[2], S[3]); if (dost) *(u32x2*)(ub + (size_t)(c0 + i) * 8 * 16384) = sw;
                S[0] = d[i] * S[0] + bflo(uu[i].x); S[1] = d[i] * S[1] + bfhi(uu[i].x); S[2] = d[i] * S[2] + bflo(uu[i].y); S[3] = d[i] * S[3] + bfhi(uu[i].y); }
        }
        if (dost) *(f32x4*)(pk->out + OSP + (size_t)(j * 32 + bh) * 16384 + k * 128 + 4 * v4) = S;
    }
    for (int e = gt; e < 262144; e += NTH) {
        const int sbh = e >> 12, k = (e >> 5) & 127, v4 = e & 31, it = 4096 + sbh; const size_t eo = (size_t)k * 128 + 4 * v4;
        const f32x4 S0 = *(const f32x4*)(pk->in[4] + (size_t)(j * 64 + sbh) * 16384 + eo);
        bf16_t* ub = UB + (size_t)it * 16384 + eo; const u32x2 uu = *(const u32x2*)ub; const float d = DB[(size_t)it * 128 + k];
        u32x2 sw; sw.x = pkbf(S0[0], S0[1]); sw.y = pkbf(S0[2], S0[3]); if (dost) *(u32x2*)ub = sw;
        f32x4 S; S[0] = d * S0[0] + bflo(uu.x); S[1] = d * S0[1] + bfhi(uu.x); S[2] = d * S0[2] + bflo(uu.y); S[3] = d * S0[3] + bfhi(uu.y);
        if (dost) *(f32x4*)(pk->out + OSS + (size_t)(j * 64 + sbh) * 16384 + eo) = S;
    }
}
__device__ __forceinline__ void hgrn_passC(KP pk, char* lds, int j, int vcu, int G, bool dost) {
    int tid_ = threadIdx.x; asm volatile("" : "+v"(tid_)); const int tid = tid_, lane = tid & 63, w = __builtin_amdgcn_readfirstlane(tid >> 6), l15 = lane & 15, q4 = lane >> 4, k = tid & 127, seg = tid >> 7;
    _Float16* ZS = (_Float16*)(lds + HL_ZS); float* TOT = (float*)(lds + HL_TOT); bf16_t* VT = (bf16_t*)(lds + HL_VT);
    u16* QG = (u16*)(lds + HL_KT); bf16_t* QS = (bf16_t*)(lds + HL_QS); bf16_t* KS = (bf16_t*)(lds + HL_KS); bf16_t* ST = (bf16_t*)(lds + HL_ST); float* SSQ = (float*)(lds + HL_SSQ);
    u16* QH = (u16*)(pk->ws + WS_POOL); const u16* ZF = (const u16*)(pk->ws + WS_POOL + ACT); const u16* VH = (const u16*)(pk->ws + WS_POOL + 2 * ACT); const u16* GH = (const u16*)(pk->ws + WS_POOL + 3 * ACT);
    const bf16_t* UB = (const bf16_t*)(pk->out + OY); const float* onorm = pk->in[12] + j * 128;
    const int tt = w & 3, vh = w >> 2;
    float lbv = 0.f, oml = 1.f; int hprev = -1;
    float* ONL = (float*)(lds + HL_SSQ + 512); if (tid < 128) ONL[tid] = onorm[tid];
    u32x4 zfr[2], vr[2], qr[2], sr[4];
#define PC_LOAD(itx) { int m0_, h_; hgrn_item(itx, m0_, h_); _Pragma("unroll") for (int i = 0; i < 2; ++i) { const int ch = tid + 512 * i; const size_t go = (size_t)(m0_ + (ch >> 4)) * 1024 + h_ * 128 + 8 * (ch & 15); \
        zfr[i] = *(const u32x4*)(ZF + go); vr[i] = *(const u32x4*)(VH + go); qr[i] = *(const u32x4*)(QH + go); } \
        _Pragma("unroll") for (int i = 0; i < 4; ++i) { const int ch = tid + 512 * i; sr[i] = *(const u32x4*)(UB + (size_t)(itx) * 16384 + (ch >> 4) * 128 + 8 * (ch & 15)); } }
    if (vcu < 4160) PC_LOAD(vcu)
    for (int it = vcu; it < 4160; it += G) {
        int m0, h; hgrn_item(it, m0, h);
        if (j == 1 && h != hprev) { const float a = pk->in[11][h * 128 + k], b = pk->in[11][1024 + h * 128 + k]; lbv = 1.f / (1.f + __expf(a - b)); oml = 1.f - lbv; hprev = h; }
        __syncthreads();
        HGRN_STAGE_ZV()
#pragma unroll
        for (int i = 0; i < 2; ++i) { const int ch = tid + 512 * i; *(u32x4*)(QG + (ch >> 4) * 128 + 8 * (ch & 15)) = qr[i]; }
        u32x4 sc_[4];
#pragma unroll
        for (int i = 0; i < 4; ++i) sc_[i] = sr[i];
        u32x4 gr[2];
#pragma unroll
        for (int i = 0; i < 2; ++i) { const int ch = tid + 512 * i; gr[i] = *(const u32x4*)(GH + (size_t)(m0 + (ch >> 4)) * 1024 + h * 128 + 8 * (ch & 15)); }
        if (it + G < 4160) PC_LOAD(it + G)
        __syncthreads();
        HGRN_GATES()
        { u16* GS = (u16*)(lds + HL_ZS);
#pragma unroll
          for (int i = 0; i < 2; ++i) { const int ch = tid + 512 * i; *(u32x4*)(GS + (ch >> 4) * 128 + 8 * (ch & 15)) = gr[i]; } }
        float qv[16];
#pragma unroll
        for (int i = 0; i < 16; ++i) qv[i] = bf2f(QG[(16 * seg + i) * 128 + k]);
#pragma unroll
        for (int i = 0; i < 16; ++i) { const float bt = off + bl[i]; KS[(16 * seg + i) * 136 + k] = f2bf(kk[i] * __builtin_amdgcn_exp2f(b31 - bt)); QS[(16 * seg + i) * 136 + k] = f2bf(qv[i] * __builtin_amdgcn_exp2f(bt - b31)); }
#pragma unroll
        for (int i = 0; i < 4; ++i) { const int ch = tid + 512 * i, kr = ch >> 4, vc = ch & 15; const float sc = __builtin_amdgcn_exp2f(TOT[kr] + TOT[128 + kr]);
            const u32x4 sv = sc_[i];
#pragma unroll
            for (int e = 0; e < 8; ++e) { const unsigned wv = sv[e >> 1]; const float f = (e & 1) ? bfhi(wv) : bflo(wv); ST[(8 * vc + e) * 136 + ((((kr >> 3) ^ vc) << 3) | (kr & 7))] = f2bf(f * sc); } }
        __syncthreads();
        bf16x8 qf[4];
#pragma unroll
        for (int ks = 0; ks < 4; ++ks) qf[ks] = *(const bf16x8*)(QS + (16 * tt + l15) * 136 + 32 * ks + 8 * q4);
        f32x4 sc4[4];
#pragma unroll
        for (int st = 0; st < 4; ++st) { f32x4 a = {0.f, 0.f, 0.f, 0.f};
            if (st <= tt) {
#pragma unroll
                for (int ks = 0; ks < 4; ++ks) a = mfma16(*(const bf16x8*)(KS + (16 * st + l15) * 136 + 32 * ks + 8 * q4), qf[ks], a);
                if (st == tt) {
#pragma unroll
                    for (int r = 0; r < 4; ++r) if (4 * q4 + r > l15) a[r] = 0.f;
                }
            }
            sc4[st] = a; }
        f32x4 o[4];
#pragma unroll
        for (int vi = 0; vi < 4; ++vi) { const int vt = 4 * vh + vi; f32x4 a = {0.f, 0.f, 0.f, 0.f};
#pragma unroll
            for (int kp = 0; kp < 2; ++kp) if (2 * kp <= tt) {
                u32x4 pw; pw.x = pkbf(sc4[2 * kp][0], sc4[2 * kp][1]); pw.y = pkbf(sc4[2 * kp][2], sc4[2 * kp][3]); pw.z = pkbf(sc4[2 * kp + 1][0], sc4[2 * kp + 1][1]); pw.w = pkbf(sc4[2 * kp + 1][2], sc4[2 * kp + 1][3]);
                const int vv_ = 16 * vt + l15, vsw = (vv_ >> 3) & 7, vc0 = 4 * kp + (q4 >> 1); const bf16_t* vrow = VT + vv_ * 72 + 4 * (q4 & 1); const u32x2 lo = *(const u32x2*)(vrow + ((vc0 ^ vsw) << 3)), hi = *(const u32x2*)(vrow + (((vc0 + 2) ^ vsw) << 3));
                u32x4 aw; aw.x = lo.x; aw.y = lo.y; aw.z = hi.x; aw.w = hi.y; a = mfma16(__builtin_bit_cast(bf16x8, aw), __builtin_bit_cast(bf16x8, pw), a); }
#pragma unroll
            for (int ks = 0; ks < 4; ++ks) a = mfma16(*(const bf16x8*)(ST + (16 * vt + l15) * 136 + (((4 * ks + q4) ^ (((16 * vt + l15) >> 3) & 15)) << 3)), qf[ks], a);
            o[vi] = a; }
        float sq = 0.f;
#pragma unroll
        for (int vi = 0; vi < 4; ++vi) sq += (o[vi][0] * o[vi][0] + o[vi][1] * o[vi][1]) + (o[vi][2] * o[vi][2] + o[vi][3] * o[vi][3]);
        sq += __shfl_xor(sq, 16); sq += __shfl_xor(sq, 32);
        if (q4 == 0) SSQ[vh * 64 + 16 * tt + l15] = sq;
        __syncthreads();
        const float rn = __builtin_amdgcn_rsqf((SSQ[16 * tt + l15] + SSQ[64 + 16 * tt + l15]) * (1.f / 128.f) + EPS);
        bf16_t* stg = (bf16_t*)(lds + HL_QS) + w * 1152;
#pragma unroll
        for (int vi = 0; vi < 4; ++vi) { const int v0 = 16 * (4 * vh + vi) + 4 * q4; const f32x4 gn = *(const f32x4*)(ONL + v0);
            const u32x2 g2 = *(const u32x2*)((const u16*)(lds + HL_ZS) + (16 * tt + l15) * 128 + v0); u32x2 ow;
            ow.x = pkbf(o[vi][0] * rn * gn[0] * bflo(g2.x), o[vi][1] * rn * gn[1] * bfhi(g2.x)); ow.y = pkbf(o[vi][2] * rn * gn[2] * bflo(g2.y), o[vi][3] * rn * gn[3] * bfhi(g2.y));
            *(u32x2*)(stg + l15 * 72 + 16 * vi + 4 * q4) = ow; }
        asm volatile("s_waitcnt lgkmcnt(0)" ::: "memory");
        if (dost) {
#pragma unroll
            for (int i = 0; i < 2; ++i) { const int row = 8 * i + (lane >> 3), chn = lane & 7; *(u32x4*)(QH + (size_t)(m0 + 16 * tt + row) * 1024 + h * 128 + 64 * vh + 8 * chn) = *(const u32x4*)(stg + row * 72 + 8 * chn); } }
    }
#undef PC_LOAD
}
__device__ __forceinline__ void final_phase(KP pk, int vcu, int G) {
    int tid_ = threadIdx.x; asm volatile("" : "+v"(tid_)); const int tid = tid_, lane = tid & 63, w = tid >> 6; const int gw = vcu * 8 + w, NGW = G * 8;
    float* Y = pk->out + OY; const bf16_t* XB = (const bf16_t*)(pk->ws + WS_XB); const float* ss = (const float*)(pk->ws + WS_SS) + (size_t)(8 % 3) * SS_SLOT; const float* fn = pk->in[16];
    f32x4 g[4];
#pragma unroll
    for (int q = 0; q < 4; ++q) g[q] = *(const f32x4*)(fn + 256 * q + 4 * lane);
    for (int r0 = gw; r0 < MT; r0 += 4 * NGW) {
        u32x2 xv[4][4]; float pv[4];
#pragma unroll
        for (int t = 0; t < 4; ++t) { const int r = r0 + t * NGW < MT ? r0 + t * NGW : r0;
            pv[t] = lane < 16 ? ss[(size_t)r * 16 + lane] : 0.f;
#pragma unroll
            for (int q = 0; q < 4; ++q) xv[t][q] = *(const u32x2*)(XB + (size_t)r * 1024 + 256 * q + 4 * lane); }
#pragma unroll
        for (int t = 0; t < 4; ++t) { const int r = r0 + t * NGW; if (r >= MT) break;
            float s = pv[t];
#pragma unroll
            for (int o = 1; o < 16; o <<= 1) s += __shfl_xor(s, o);
            s = __shfl(s, 0); const float rs = __builtin_amdgcn_rsqf(s * (1.f / 1024.f) + EPS);
#pragma unroll
            for (int q = 0; q < 4; ++q) { f32x4 y; y[0] = bflo(xv[t][q].x) * rs * g[q][0]; y[1] = bfhi(xv[t][q].x) * rs * g[q][1]; y[2] = bflo(xv[t][q].y) * rs * g[q][2]; y[3] = bfhi(xv[t][q].y) * rs * g[q][3];
                *(f32x4*)(Y + (size_t)r * 1024 + 256 * q + 4 * lane) = y; } }
    }
}

#ifndef STAG_MODE
#define STAG_MODE 0
#endif
#ifndef STAG_T
#define STAG_T 26
#endif
__device__ __forceinline__ void stagger(int bx, int usec_total) {
    if (STAG_MODE == 0) return;
    const int grp = STAG_MODE == 1 ? (bx & 7) : ((bx >> 3) & 7);
    const unsigned long long t0 = __builtin_amdgcn_s_memrealtime(); const unsigned long long dt = (unsigned long long)(grp * usec_total * 100 / 8);
    while (__builtin_amdgcn_s_memrealtime() - t0 < dt) __builtin_amdgcn_s_sleep(8);
}

constexpr int LDS_BYTES = 147456;
constexpr int PH_A = 3 + 2 * NHALF, PH_H = 5 + 2 * NHALF, NPHASE = 2 + 2 * (PH_A + PH_H);
#ifndef SKIPMASK
#define SKIPMASK 0
#endif
#ifndef PROBE_KIND
#define PROBE_KIND -1
#endif
#ifndef PROBE_REP
#define PROBE_REP 1
#endif
#ifndef PROBE_NOEPI
#define PROBE_NOEPI 0
#endif
__global__ void __launch_bounds__(512, 2) fwd_kernel(Params p_unused) {
    extern __shared__ __attribute__((aligned(16))) unsigned char lds[];
    cg::grid_group grid = cg::this_grid();
    const int G = gridDim.x, bx = blockIdx.x; const int vcu = (G % 8 == 0) ? (bx % 8) * (G / 8) + bx / 8 : bx;
    volatile LAS unsigned* misc = (volatile LAS unsigned*)((LAS unsigned char*)lds + 131072 + 320);
    if (threadIdx.x < 64) misc[threadIdx.x] = 0u;
    __syncthreads();
    int ph, ph_hi; XcdBarrier bar; { KP k0 = kargs(); ph = k0->ph_lo; ph_hi = k0->ph_hi; bar.bar = (unsigned*)(k0->ws + WS_CTL) + 4096; bar.x = 0u; bar.st = misc + 8; }
    for (; ph < ph_hi; ++ph) {
        int layer = 0, kind, half = 0;
        if (ph == 0) kind = 0; else if (ph == NPHASE - 1) kind = 10;
        else { int q = ph - 1; if (q < PH_A) { layer = 0; } else if (q < PH_A + PH_H) { layer = 1; q -= PH_A; } else if (q < 2 * PH_A + PH_H) { layer = 2; q -= PH_A + PH_H; } else { layer = 3; q -= 2 * PH_A + PH_H; }
            if (layer & 1) { if (q < 4) kind = 6 + q; else if (q == 4) kind = 3; else { kind = 4 + ((q - 5) & 1); half = (q - 5) >> 1; } }
            else { if (q < 3) kind = 1 + q; else { kind = 4 + ((q - 3) & 1); half = (q - 3) >> 1; } } }
        const int j = layer >> 1;
        int nrep = 1; if (kind == PROBE_KIND) nrep = PROBE_REP;
        for (int rep = 0; rep < nrep; ++rep) {
        if (rep) xcd_barrier(bar);
        KP pk = kargs();
        if (kind == 0) { if (!(SKIPMASK & 1)) prologue(pk, (char*)lds, vcu, G); }
        else if (kind == 1 && !(SKIPMASK & 2)) {
            stagger(bx, STAG_T);
            unsigned char* ws = pk->ws; float* out = pk->out; bf16_t* WB = (bf16_t*)(ws + WS_W); float* ssb = (float*)(ws + WS_SS);
            pg8::Gemm g{(bf16_t*)(ws + WS_XB), WB + wmat_off(layer, 0), MT, 1536, 1024}; pg8::StaticOrder S; S.init(MP, 1536, 1024, G, bx); S.split(128, 2, 4);
            EpiQKV E{ws, out, j, (2 * layer) % 3};
            EpiMix<EpiQKV> EM{E, (float*)(ws + WS_SPK), (unsigned*)(ws + WS_CTL + 32768) + ph * 256, 4, 128, 2, (PROBE_NOEPI && rep + 1 < nrep) ? 0u : 0xffu};
            pg8::gemm_phase<EpiMix<EpiQKV>, pg8::StaticOrder, PG_ALIGN, PG_SP2>((PG8_LAS unsigned char*)lds, g, S, EM);
        } else if (kind == 2) { if (!(SKIPMASK & 4)) attn_phase(pk, (char*)lds, j, vcu, G); }
        else if ((kind == 3 || kind == 5) && !(SKIPMASK & 8)) {
            unsigned char* ws = pk->ws; bf16_t* WB = (bf16_t*)(ws + WS_W); float* ssb = (float*)(ws + WS_SS);
            const bool dn = kind == 5; const int K = dn ? 4096 : 1024;
            const bf16_t* A = dn ? (const bf16_t*)(ws + WS_POOL) - (size_t)(half * HROWS) * 4096 : ((layer & 1) ? (const bf16_t*)(ws + WS_POOL) : (const bf16_t*)(ws + WS_POOL + ACT));
            pg8::Gemm g{A, WB + wmat_off(layer, dn ? 3 : 1), MT, 1024, K}; pg8::StaticOrder S;
            if (dn) { S.init(HROWS, 1024, K, G, bx, half * (HROWS / 256)); if (half == NHALF - 1) S.split(128, 2, 8); } else { S.init(MP, 1024, K, G, bx); S.split(128, 2, 4); }
            EpiRes E{(bf16_t*)(ws + WS_XB), ssb + (size_t)((2 * layer + (dn ? 2 : 1)) % 3) * SS_SLOT};
            EpiMix<EpiRes> EM{E, (float*)(ws + WS_SPK), (unsigned*)(ws + WS_CTL + 32768) + ph * 256, dn ? 8 : 4, 128, 2, (PROBE_NOEPI && rep + 1 < nrep) ? 0u : 0xffu};
            pg8::gemm_phase<EpiMix<EpiRes>, pg8::StaticOrder, PG_ALIGN, PG_SP2>((PG8_LAS unsigned char*)lds, g, S, EM);
        } else if (kind == 4 && !(SKIPMASK & 16)) {
            unsigned char* ws = pk->ws; bf16_t* WB = (bf16_t*)(ws + WS_W); float* ssb = (float*)(ws + WS_SS);
            pg8::Gemm g{(bf16_t*)(ws + WS_XB), WB + wmat_off(layer, 2), MT, 4096, 1024}; pg8::StaticOrder S; S.init(HROWS, 4096, 1024, G, bx, half * (HROWS / 256)); if (half == NHALF - 1) S.split(128, 2, 4);
            EpiUp E{ssb + (size_t)((2 * layer + 1) % 3) * SS_SLOT, (bf16_t*)(ws + WS_POOL) - (size_t)(half * HROWS) * 4096, (PROBE_NOEPI == 2 && rep + 1 < nrep) ? 255 : (PROBE_NOEPI == 3 && rep + 1 < nrep) ? 0x7ffffffe : 0x7fffffff};
            EpiMix<EpiUp> EM{E, (float*)(ws + WS_SPK), (unsigned*)(ws + WS_CTL + 32768) + ph * 256, 4, 128, 2, 0xffu};
            pg8::gemm_phase<EpiMix<EpiUp>, pg8::StaticOrder, PG_ALIGN, PG_SP2>((PG8_LAS unsigned char*)lds, g, S, EM);
        } else if (kind == 6 && !(SKIPMASK & 32)) {
            stagger(bx, STAG_T);
            unsigned char* ws = pk->ws; bf16_t* WB = (bf16_t*)(ws + WS_W); float* ssb = (float*)(ws + WS_SS);
            pg8::Gemm g{(bf16_t*)(ws + WS_XB), WB + wmat_off(layer, 0), MT, 4096, 1024}; pg8::StaticOrder S; S.init(MP, 4096, 1024, G, bx); S.split(128, 2, 4);
            EpiHin E{ssb + (size_t)((2 * layer) % 3) * SS_SLOT, (u16*)(ws + WS_POOL)};
            EpiMix<EpiHin> EM{E, (float*)(ws + WS_SPK), (unsigned*)(ws + WS_CTL + 32768) + ph * 256, 4, 128, 2, (PROBE_NOEPI && rep + 1 < nrep) ? 0u : 0xffu};
            pg8::gemm_phase<EpiMix<EpiHin>, pg8::StaticOrder, PG_ALIGN, PG_SP2>((PG8_LAS unsigned char*)lds, g, S, EM);
        } else if (kind == 7) { if (!(SKIPMASK & 64)) hgrn_passA(pk, (char*)lds, j, vcu, G, !(PROBE_NOEPI && rep + 1 < nrep)); }
        else if (kind == 8) { if (!(SKIPMASK & 128)) hgrn_passB(pk, j, G, !(PROBE_NOEPI && rep + 1 < nrep)); }
        else if (kind == 9) { if (!(SKIPMASK & 256)) hgrn_passC(pk, (char*)lds, j, vcu, G, !(PROBE_NOEPI && rep + 1 < nrep)); }
        else if (kind == 10) { if (!(SKIPMASK & 512)) final_phase(pk, vcu, G); }
        }
        if (PROBE_KIND == 99 && ph == 3) for (int e = 0; e < PROBE_REP; ++e) xcd_barrier(bar);
        if (ph + 1 < ph_hi) { if (ph == 0) { grid.sync(); KP k1 = kargs(); bar = xcd_barrier_post((unsigned*)(k1->ws + WS_CTL) + 4096, misc + 8); } else xcd_barrier(bar); }
    }
}

#ifndef MK_PER_PHASE
#define MK_PER_PHASE 0
#endif
extern "C" void kernel_launch(void* const* d_in, const int* in_sizes, int n_in, void* d_out, int out_size, void* d_ws, size_t ws_size, hipStream_t stream) {
    static int grid = 0;
    if (grid == 0) {
        int dev = 0, cus = 0, per_cu = 0;
        hipGetDevice(&dev); hipDeviceGetAttribute(&cus, hipDeviceAttributeMultiprocessorCount, dev);
        hipFuncSetAttribute((const void*)fwd_kernel, hipFuncAttributeMaxDynamicSharedMemorySize, LDS_BYTES);
        hipOccupancyMaxActiveBlocksPerMultiprocessor(&per_cu, (const void*)fwd_kernel, 512, LDS_BYTES);
        (void)hipGetLastError();
        if (per_cu < 1) { fprintf(stderr, "kernel_launch: occupancy query says %d blocks/CU\n", per_cu); per_cu = 1; }
        grid = cus;
        if (n_in != 17 || ws_size < WS_SS + 3 * SS_SLOT * 4) { fprintf(stderr, "kernel_launch: unexpected n_in %d / ws_size %zu (need %zu)\n", n_in, ws_size, (size_t)WS_END); }
    }
    Params p{};
    for (int i = 0; i < 17; ++i) p.in[i] = (const float*)d_in[i];
    p.out = (float*)d_out; p.ws = (unsigned char*)d_ws;
#if MK_PER_PHASE
    for (int ph = 0; ph < NPHASE; ++ph) { p.ph_lo = ph; p.ph_hi = ph + 1; hipLaunchKernelGGL(fwd_kernel, dim3(grid), dim3(512), LDS_BYTES, stream, p); }
#else
    p.ph_lo = 0; p.ph_hi = NPHASE;
    void* args[] = {&p};
    hipError_t e = hipLaunchCooperativeKernel((const void*)fwd_kernel, dim3(grid), dim3(512), args, LDS_BYTES, stream);
    if (e != hipSuccess) fprintf(stderr, "cooperative launch failed: %s (grid %d)\n", hipGetErrorString(e), grid);
#endif
}
```
